# Optimizing an MI355X kernel written in HIP

```python
import jax, jax.numpy as jnp
from jax import lax
import numpy as np

D_MODEL = 2048
BATCH = 2
SEQ = 8192
DEPTH = 1

MEM_LEN = 256
NORM_EPS = 1e-6
NEG_INF = -1e30
Q_BLOCK = 128
ROPE_THETA = 500000.0
DIFF_HEADS = 8
DIFF_HEAD_DIM = 128
DIFF_V_DIM = 2 * DIFF_HEAD_DIM
DIL_HEADS = 8
DIL_HEAD_DIM = 128
DIL_CONFIGS = ((128, 1), (512, 4), (2048, 16))
DIL_PAD = 2048
MEM_HEADS = 4
MEM_HEAD_DIM = 256
N_BRANCH = 3
ROT_DIM = 128 // 4
DIFF_Q_COLS = DIFF_HEADS * 2 * DIFF_HEAD_DIM
DIFF_K_COLS = DIFF_HEADS * 2 * DIFF_HEAD_DIM
DIFF_V_COLS = DIFF_HEADS * DIFF_V_DIM
DIL_COLS = DIL_HEADS * DIL_HEAD_DIM
MEM_Q_COLS = MEM_HEADS * MEM_HEAD_DIM
GATE_COLS = N_BRANCH * D_MODEL
IN_SIZES = (DIFF_Q_COLS, DIFF_K_COLS, DIFF_V_COLS, DIL_COLS, DIL_COLS, DIL_COLS, MEM_Q_COLS, GATE_COLS)
IN_COLS = DIFF_Q_COLS + DIFF_K_COLS + DIFF_V_COLS + 3 * DIL_COLS + MEM_Q_COLS + GATE_COLS
N_EXPERTS = 32
TOP_K = 4
D_FF = 2048
SWIGLU_LIMIT = 7.0
SWIGLU_ALPHA = 1.702
EXPERT_BLOCK = 256

kernel_name = "hybrid_gated_diff_dilated_memory_moe"


def rms_norm(x, g, eps=NORM_EPS):
    xf = x.astype(jnp.float32)
    y = xf * lax.rsqrt(jnp.mean(xf * xf, axis=-1, keepdims=True) + eps)
    return (y * g.astype(jnp.float32)).astype(x.dtype)


def split_cols(x, sizes):
    out, start = [], 0
    for s in sizes:
        out.append(x[..., start:start + s])
        start += s
    return out


def rope_tables(positions):
    inv_freq = ROPE_THETA ** (-jnp.arange(0, ROT_DIM, 2, dtype=jnp.float32) / ROT_DIM)
    ang = positions.astype(jnp.float32)[..., None] * inv_freq
    return jnp.cos(ang)[:, :, None, :], jnp.sin(ang)[:, :, None, :]


def partial_rope(x, cos, sin):
    half = ROT_DIM // 2
    xr = x[..., :ROT_DIM].astype(jnp.float32)
    x1, x2 = xr[..., :half], xr[..., half:]
    rot = jnp.concatenate([x1 * cos - x2 * sin, x2 * cos + x1 * sin], axis=-1)
    return jnp.concatenate([rot.astype(x.dtype), x[..., ROT_DIM:]], axis=-1)


def diff_attention(q, k, v, lam):
    B, S = q.shape[0], q.shape[1]
    scale = DIFF_HEAD_DIM ** -0.5
    qc = jnp.transpose(q, (3, 0, 2, 1, 4))
    kc = jnp.transpose(k, (3, 0, 2, 1, 4))
    vh = jnp.transpose(v, (0, 2, 1, 3))
    key_pos = jnp.arange(S)

    def block(i):
        s0 = i * Q_BLOCK
        qb = lax.dynamic_slice_in_dim(qc, s0, Q_BLOCK, axis=3)
        s = jnp.einsum('cbhqd,cbhkd->cbhqk', qb, kc).astype(jnp.float32) * scale
        causal = (s0 + jnp.arange(Q_BLOCK))[:, None] >= key_pos[None, :]
        p = jax.nn.softmax(jnp.where(causal, s, NEG_INF), axis=-1)
        a = p[0] - lam * p[1]
        return jnp.einsum('bhqk,bhkd->bhqd', a.astype(v.dtype), vh)

    o = lax.map(block, jnp.arange(S // Q_BLOCK))
    return jnp.transpose(o, (1, 0, 3, 2, 4)).reshape(B, S, DIFF_HEADS, DIFF_V_DIM)


def dilated_attention(q, k, v):
    B, S = q.shape[0], q.shape[1]
    scale = DIL_HEAD_DIM ** -0.5
    qh = jnp.transpose(q, (0, 2, 1, 3))
    pad = ((0, 0), (0, 0), (DIL_PAD, 0), (0, 0))
    kp = jnp.pad(jnp.transpose(k, (0, 2, 1, 3)), pad)
    vp = jnp.pad(jnp.transpose(v, (0, 2, 1, 3)), pad)

    def block(i):
        s0 = i * Q_BLOCK
        qb = lax.dynamic_slice_in_dim(qh, s0, Q_BLOCK, axis=2)
        t = s0 + jnp.arange(Q_BLOCK)
        outs, lses = [], []
        for window, dil in DIL_CONFIGS:
            src = t[:, None] - dil * jnp.arange(window // dil + 1)[None, :]
            kg = kp[:, :, src + DIL_PAD]
            vg = vp[:, :, src + DIL_PAD]
            s = jnp.einsum('bhqd,bhqnd->bhqn', qb, kg).astype(jnp.float32) * scale
            s = jnp.where(src >= 0, s, NEG_INF)
            m = jnp.max(s, axis=-1, keepdims=True)
            e = jnp.exp(s - m)
            z = jnp.sum(e, axis=-1, keepdims=True)
            outs.append(jnp.einsum('bhqn,bhqnd->bhqd', (e / z).astype(v.dtype), vg))
            lses.append(m[..., 0] + jnp.log(z[..., 0]))
        wgt = jax.nn.softmax(jnp.stack(lses), axis=0)
        return jnp.einsum('gbhq,gbhqd->bhqd', wgt.astype(v.dtype), jnp.stack(outs))

    o = lax.map(block, jnp.arange(S // Q_BLOCK))
    return jnp.transpose(o, (1, 0, 3, 2, 4)).reshape(B, S, DIL_HEADS, DIL_HEAD_DIM)


def memory_attention(q, km, vm):
    s = jnp.einsum('bqhd,bkhd->bhqk', q, km).astype(jnp.float32) * (MEM_HEAD_DIM ** -0.5)
    p = jax.nn.softmax(s, axis=-1)
    return jnp.einsum('bhqk,bkhd->bqhd', p.astype(vm.dtype), vm)


def moe_ffn(h, w_router, b_router, w_gate_up, b_gate_up, w_down, b_down):
    T, D = h.shape
    logits = (h @ w_router + b_router).astype(jnp.float32)
    top_v, top_e = lax.top_k(logits, TOP_K)
    gates = jax.nn.softmax(top_v, axis=-1)
    A = T * TOP_K
    e_flat = top_e.reshape(A)
    tok_flat = jnp.repeat(jnp.arange(T, dtype=jnp.int32), TOP_K)
    w_flat = gates.reshape(A)
    order = jnp.argsort(e_flat)
    e_s, tok_s, w_s = e_flat[order], tok_flat[order], w_flat[order]
    counts = jnp.bincount(e_flat, length=N_EXPERTS)
    starts = jnp.cumsum(counts) - counts
    padded = (counts + EXPERT_BLOCK - 1) // EXPERT_BLOCK * EXPERT_BLOCK
    pend = jnp.cumsum(padded)
    pstart = pend - padded
    dest = pstart[e_s] + jnp.arange(A) - starts[e_s]
    n_blocks = (A + N_EXPERTS * EXPERT_BLOCK + EXPERT_BLOCK - 1) // EXPERT_BLOCK
    P = n_blocks * EXPERT_BLOCK
    slot_tok = jnp.full((P,), T, dtype=jnp.int32).at[dest].set(tok_s)
    slot_w = jnp.zeros((P,), jnp.float32).at[dest].set(w_s)
    block_e = jnp.clip(jnp.searchsorted(pend, jnp.arange(n_blocks) * EXPERT_BLOCK, side='right'),
                       0, N_EXPERTS - 1)
    h_pad = jnp.concatenate([h, jnp.zeros((1, D), h.dtype)], axis=0)
    xb = h_pad[slot_tok].reshape(n_blocks, EXPERT_BLOCK, D)

    def expert_block(args):
        xe, e = args
        gu = (xe @ w_gate_up[e] + b_gate_up[e]).astype(jnp.float32)
        gate, up = gu[:, :D_FF], gu[:, D_FF:]
        gate = jnp.minimum(gate, SWIGLU_LIMIT)
        up = jnp.clip(up, -SWIGLU_LIMIT, SWIGLU_LIMIT)
        act = (up + 1.0) * gate * jax.nn.sigmoid(SWIGLU_ALPHA * gate)
        return act.astype(xe.dtype) @ w_down[e] + b_down[e]

    yb = lax.map(expert_block, (xb, block_e)).reshape(P, D)
    contrib = (yb.astype(jnp.float32) * slot_w[:, None]).astype(h.dtype)
    return jnp.zeros((T + 1, D), h.dtype).at[slot_tok].add(contrib)[:T]


def hybrid_layer(x, mem, cos, sin, layer_idx, g_mix_norm, w_in, b_gate, diff_q_norm, diff_k_norm,
                 diff_lambda, diff_subln, dil_q_norm, dil_k_norm, g_mem_norm, w_mem_kv,
                 mem_q_norm, mem_k_norm, w_branch_diff, w_branch_dil, w_branch_mem, w_out,
                 g_ffn_norm, w_router, b_router, w_gate_up, b_gate_up, w_down, b_down):
    B, S, D = x.shape
    h = rms_norm(x, g_mix_norm)
    proj = h @ w_in
    dq, dk, dv, lq, lk, lv, mq, graw = split_cols(proj, IN_SIZES)

    dq = rms_norm(dq.reshape(B, S, DIFF_HEADS, 2, DIFF_HEAD_DIM), diff_q_norm)
    dk = rms_norm(dk.reshape(B, S, DIFF_HEADS, 2, DIFF_HEAD_DIM), diff_k_norm)
    dq = partial_rope(dq.reshape(B, S, 2 * DIFF_HEADS, DIFF_HEAD_DIM), cos, sin).reshape(B, S, DIFF_HEADS, 2, DIFF_HEAD_DIM)
    dk = partial_rope(dk.reshape(B, S, 2 * DIFF_HEADS, DIFF_HEAD_DIM), cos, sin).reshape(B, S, DIFF_HEADS, 2, DIFF_HEAD_DIM)
    lam_init = 0.8 - 0.6 * float(np.exp(-0.3 * layer_idx))
    lp = diff_lambda.astype(jnp.float32)
    lam = jnp.exp(jnp.sum(lp[0] * lp[1])) - jnp.exp(jnp.sum(lp[2] * lp[3])) + lam_init
    o_diff = diff_attention(dq, dk, dv.reshape(B, S, DIFF_HEADS, DIFF_V_DIM), lam)
    o_diff = rms_norm(o_diff, diff_subln) * (1.0 - lam_init)
    br_diff = o_diff.reshape(B, S, DIFF_V_COLS) @ w_branch_diff

    lq = partial_rope(rms_norm(lq.reshape(B, S, DIL_HEADS, DIL_HEAD_DIM), dil_q_norm), cos, sin)
    lk = partial_rope(rms_norm(lk.reshape(B, S, DIL_HEADS, DIL_HEAD_DIM), dil_k_norm), cos, sin)
    o_dil = dilated_attention(lq, lk, lv.reshape(B, S, DIL_HEADS, DIL_HEAD_DIM))
    br_dil = o_dil.reshape(B, S, DIL_COLS) @ w_branch_dil

    M = mem.shape[1]
    kvm = rms_norm(mem, g_mem_norm) @ w_mem_kv
    km = rms_norm(kvm[..., :MEM_Q_COLS].reshape(B, M, MEM_HEADS, MEM_HEAD_DIM), mem_k_norm)
    vm = kvm[..., MEM_Q_COLS:].reshape(B, M, MEM_HEADS, MEM_HEAD_DIM)
    mq = rms_norm(mq.reshape(B, S, MEM_HEADS, MEM_HEAD_DIM), mem_q_norm)
    o_mem = memory_attention(mq, km, vm)
    br_mem = o_mem.reshape(B, S, MEM_Q_COLS) @ w_branch_mem

    g = jax.nn.sigmoid((graw + b_gate).astype(jnp.float32)).reshape(B, S, N_BRANCH, D)
    merged = (g[:, :, 0] * br_diff.astype(jnp.float32) + g[:, :, 1] * br_dil.astype(jnp.float32)
              + g[:, :, 2] * br_mem.astype(jnp.float32)).astype(x.dtype)
    x = x + merged @ w_out

    h2 = rms_norm(x, g_ffn_norm).reshape(B * S, D)
    x = x + moe_ffn(h2, w_router, b_router, w_gate_up, b_gate_up, w_down, b_down).reshape(B, S, D)
    return x


def setup_inputs(seed: int = 0) -> dict:
    key = jax.random.key(seed)
    ks = jax.random.split(key, 32)
    f32 = jnp.float32
    L, D, E = DEPTH, D_MODEL, N_EXPERTS

    def w(k, shape, fan_in):
        return jax.random.normal(k, shape, f32) * fan_in ** -0.5

    def gain(k, shape):
        return 1.0 + 0.05 * jax.random.normal(k, shape, f32)

    def bias(k, shape, s=0.02):
        return s * jax.random.normal(k, shape, f32)

    return {
        "x": jax.random.normal(ks[0], (BATCH, SEQ, D), f32),
        "mem": jax.random.normal(ks[1], (BATCH, MEM_LEN, D), f32),
        "positions": jnp.broadcast_to(jnp.arange(SEQ, dtype=jnp.int32), (BATCH, SEQ)),
        "g_mix_norm": gain(ks[2], (L, D)),
        "w_in": w(ks[3], (L, D, IN_COLS), D),
        "b_gate": bias(ks[4], (L, GATE_COLS)),
        "diff_q_norm": gain(ks[5], (L, DIFF_HEAD_DIM)),
        "diff_k_norm": gain(ks[6], (L, DIFF_HEAD_DIM)),
        "diff_lambda": 0.1 * jax.random.normal(ks[7], (L, 4, DIFF_HEAD_DIM), f32),
        "diff_subln": gain(ks[8], (L, DIFF_V_DIM)),
        "dil_q_norm": gain(ks[9], (L, DIL_HEAD_DIM)),
        "dil_k_norm": gain(ks[10], (L, DIL_HEAD_DIM)),
        "g_mem_norm": gain(ks[11], (L, D)),
        "w_mem_kv": w(ks[12], (L, D, 2 * MEM_Q_COLS), D),
        "mem_q_norm": gain(ks[13], (L, MEM_HEAD_DIM)),
        "mem_k_norm": gain(ks[14], (L, MEM_HEAD_DIM)),
        "w_branch_diff": w(ks[15], (L, DIFF_V_COLS, D), DIFF_V_COLS),
        "w_branch_dil": w(ks[16], (L, DIL_COLS, D), DIL_COLS),
        "w_branch_mem": w(ks[17], (L, MEM_Q_COLS, D), MEM_Q_COLS),
        "w_out": w(ks[18], (L, D, D), D),
        "g_ffn_norm": gain(ks[19], (L, D)),
        "w_router": w(ks[20], (L, D, E), D),
        "b_router": bias(ks[21], (L, E), 0.01),
        "w_gate_up": w(ks[22], (L, E, D, 2 * D_FF), D),
        "b_gate_up": bias(ks[23], (L, E, 2 * D_FF)),
        "w_down": w(ks[24], (L, E, D_FF, D), D_FF),
        "b_down": bias(ks[25], (L, E, D)),
    }


def reference(x, mem, positions, g_mix_norm, w_in, b_gate, diff_q_norm, diff_k_norm, diff_lambda,
              diff_subln, dil_q_norm, dil_k_norm, g_mem_norm, w_mem_kv, mem_q_norm, mem_k_norm,
              w_branch_diff, w_branch_dil, w_branch_mem, w_out, g_ffn_norm, w_router, b_router,
              w_gate_up, b_gate_up, w_down, b_down):
    cos, sin = rope_tables(positions)
    for l in range(DEPTH):
        x = hybrid_layer(x, mem, cos, sin, l, g_mix_norm[l], w_in[l], b_gate[l], diff_q_norm[l],
                         diff_k_norm[l], diff_lambda[l], diff_subln[l], dil_q_norm[l], dil_k_norm[l],
                         g_mem_norm[l], w_mem_kv[l], mem_q_norm[l], mem_k_norm[l], w_branch_diff[l],
                         w_branch_dil[l], w_branch_mem[l], w_out[l], g_ffn_norm[l], w_router[l],
                         b_router[l], w_gate_up[l], b_gate_up[l], w_down[l], b_down[l])
    return x
```

```cpp
#include <hip/hip_runtime.h>
#include <cstdio>
#include <cstdint>
#include <type_traits>

#define GAS __attribute__((address_space(1)))
#define LAS __attribute__((address_space(3)))
typedef unsigned short bf16_t;
typedef short bf16x8 __attribute__((ext_vector_type(8)));
typedef short s16x4 __attribute__((ext_vector_type(4)));
typedef float f32x4 __attribute__((ext_vector_type(4)));
typedef float f32x2 __attribute__((ext_vector_type(2)));
typedef float f32x16 __attribute__((ext_vector_type(16)));
typedef unsigned u32x4 __attribute__((ext_vector_type(4)));
typedef unsigned u32x2 __attribute__((ext_vector_type(2)));
#define DI __device__ __forceinline__
#define VM_WAIT() asm volatile("s_waitcnt vmcnt(0)" ::: "memory")
#define LDS_WAIT() asm volatile("s_waitcnt lgkmcnt(0)" ::: "memory")
#define SBAR() __builtin_amdgcn_sched_barrier(0)

typedef __bf16 bf16x2_t __attribute__((ext_vector_type(2)));
DI unsigned cvt_pk_bf16(float lo, float hi) { const f32x2 v = {lo, hi}; return __builtin_bit_cast(unsigned, __builtin_convertvector(v, bf16x2_t)); }
DI unsigned cvt_pk_bf16_a(float lo, float hi) { unsigned r; asm volatile("s_nop 0\n\tv_cvt_pk_bf16_f32 %0, %1, %2" : "=v"(r) : "v"(lo), "v"(hi)); return r; }
DI float bf_lo(unsigned w) { return __uint_as_float(w << 16); }
DI float bf_hi(unsigned w) { return __uint_as_float(w & 0xffff0000u); }
DI float wave_sum(float v) {
#pragma unroll
    for (int o = 1; o < 64; o <<= 1) v += __shfl_xor(v, o);
    return v;
}

constexpr int BATCH = 2, SEQ = 8192, DM = 2048, T = BATCH * SEQ;
constexpr int MEML = 256, TM = BATCH * MEML;
constexpr int INC = 16384;
constexpr int C_DQ = 0, C_DK = 2048, C_DV = 4096, C_LQ = 6144, C_LK = 7168, C_LV = 8192, C_MQ = 9216, C_G = 10240;
constexpr int NE = 32, TOPK = 4, DFF = 2048;
constexpr int NASG = T * TOPK;
constexpr int ECAP = 16384;
constexpr int PSLOTS = NE * ECAP;
constexpr int MAXRB = PSLOTS / 256;
constexpr float EPS = 1e-6f;
constexpr float LAM_INIT = 0.2f;
constexpr int NWAVES = 8, NTHR = 512;
DI unsigned pack4_fp8(float a, float b, float c, float d) { int w = __builtin_amdgcn_cvt_pk_fp8_f32(a, b, 0, false); w = __builtin_amdgcn_cvt_pk_fp8_f32(c, d, w, true); return (unsigned)w; }
namespace pg8 {
typedef int i32x4 __attribute__((ext_vector_type(4)));
constexpr int WSH = 6; constexpr int WSCALE_E8M0 = (127 - WSH) * 0x01010101;
constexpr int BM = 256, BK = 64, HALF = 128, HTB = HALF * BK * 2  , STAGE_BYTES = 8 * HTB, NXCD = 8, WGM = 8;
__host__ __device__ __forceinline__ int lds_byte(int r, int c) { const int st = (r >> 4) * 2 + (c >> 5), rr = r & 15, cc = c & 31, ob = rr * 64 + cc * 2; return st * 1024 + (ob ^ (((ob >> 9) & 1) << 5)); }
__host__ __device__ __forceinline__ void stage_rc(int b, int& R, int& C) { const int st = b / 1024, sb = b % 1024, swz = sb ^ (((sb >> 9) & 1) << 5); R = (st >> 1) * 16 + swz / 64; C = (st & 1) * 32 + (swz % 64) / 2; }
__host__ __device__ __forceinline__ int perm32(int rho) { const int n = rho >> 4, i = rho & 15; return 8 * (i >> 2) + 4 * n + (i & 3); }

struct GU { const char* A; const char* B; int nt; int pm, pn, tag; int rows; };

DI void tile_order(int L, int nM, int nN, int& pm, int& pn) {
    const int nwg = nM * nN; int wgid = L;
    { const int q = nwg / NXCD, r = nwg % NXCD, xcd = wgid % NXCD, off = wgid / NXCD; wgid = (xcd < r ? xcd * (q + 1) : r * (q + 1) + (xcd - r) * q) + off; }
    const int nig = WGM * nN, gid = wgid / nig, fm = gid * WGM, gsz = (nM - fm) < WGM ? (nM - fm) : WGM;
    pm = fm + ((wgid % nig) % gsz); pn = (wgid % nig) / gsz;
}

template <class Epi, class Sched, bool FP8 = false, bool ALIGN_EPI = true, bool SP2 = true>
DI void gemm_phase(LAS unsigned char* lds, const int lda, const int ldb, const size_t hstepB, const Sched& S, const Epi& E) {
    int tid_ = threadIdx.x; asm volatile("" : "+v"(tid_));
    const int tid = tid_, wid = __builtin_amdgcn_readfirstlane(tid >> 6), lane = tid & 63, wr = wid >> 2, wc = (wid + wr) & 3  , fr = lane & 15, fq = lane >> 4;
    unsigned voffA[2], voffB[2];
#pragma unroll
    for (int i = 0; i < 2; ++i) { int R, C; stage_rc(tid * 16 + i * 8192, R, C); const int Rb = Epi::PERM ? ((R & ~31) + perm32(R & 31)) : R;
        voffA[i] = (unsigned)(R * lda + C) * 2u; voffB[i] = (unsigned)(Rb * ldb + C) * 2u; }
    const size_t kstep = (size_t)(BK * 2);
    const size_t hstepA = (size_t)HALF * lda * 2;
    const unsigned ldsw = (unsigned)wid * 1024u;
    const int aoff = lds_byte(wr * 64 + fr, fq * 8), boff = lds_byte(wc * 32 + fr, fq * 8);
#define PG8_SA(b, h) (((b) * 2 + (h)) * HTB)
#define PG8_SB(b, h) ((4 + (b) * 2 + (h)) * HTB)
#define PG8_STAGE(bufoff, gbase, voff) do { _Pragma("unroll") for (int _i = 0; _i < 2; ++_i) \
        __builtin_amdgcn_global_load_lds((const unsigned*)((const char*)(gbase) + (voff)[_i]), (LAS unsigned*)(lds + (bufoff) + ldsw + _i * 8192), 16, 0, 0); } while (0)
#define PG8_LD1(dst, i_, off) do { if constexpr (FP8) { const i32x4 _p0 = *(const LAS i32x4*)(lds + (off)), _p1 = *(const LAS i32x4*)(lds + (off) + 1024); dst##8[i_] = __builtin_shufflevector(_p0, _p1, 0, 1, 2, 3, 4, 5, 6, 7); } \
        else { dst[i_][0] = *(const LAS bf16x8*)(lds + (off)); dst[i_][1] = *(const LAS bf16x8*)(lds + (off) + 1024); } } while (0)
#define PG8_LDA(dst, b, h) do { _Pragma("unroll") for (int m = 0; m < 4; ++m) PG8_LD1(dst, m, PG8_SA(b, h) + aoff + m * 2048); } while (0)
#define PG8_LDB(dst, b, h) do { _Pragma("unroll") for (int n = 0; n < 2; ++n) PG8_LD1(dst, n, PG8_SB(b, h) + boff + n * 2048); } while (0)
#define PG8_CAT(x0, x1) __builtin_shufflevector(__builtin_bit_cast(i32x4, x0), __builtin_bit_cast(i32x4, x1), 0, 1, 2, 3, 4, 5, 6, 7)
#define PG8_MMA(ai, bj, At, Bt) do { __builtin_amdgcn_s_setprio(1); _Pragma("unroll") for (int m = 0; m < 4; ++m) _Pragma("unroll") for (int n = 0; n < 2; ++n) { \
        if constexpr (FP8) asm volatile("v_mfma_scale_f32_16x16x128_f8f6f4 %0, %1, %2, %0, %3, %4 op_sel_hi:[0,0,0]" : "+v"(acc[ai][bj][m][n]) : "v"(Bt##8[n]), "v"(At##8[m]), "v"(wscale), "v"(ascale)); \
        else { _Pragma("unroll") for (int k = 0; k < 2; ++k) acc[ai][bj][m][n] = __builtin_amdgcn_mfma_f32_16x16x32_bf16(Bt[n][k], At[m][k], acc[ai][bj][m][n], 0, 0, 0); } } __builtin_amdgcn_s_setprio(0); } while (0)
#define PG8_WAIT_V(n) asm volatile("s_waitcnt vmcnt(" #n ")" ::: "memory")
#define PG8_WAIT_L(n) asm volatile("s_waitcnt lgkmcnt(" #n ")" ::: "memory")
#define PG8_BAR __builtin_amdgcn_s_barrier()
#define PG8_SCHED __builtin_amdgcn_sched_barrier(0)
    typedef int i32x8 __attribute__((ext_vector_type(8)));
    int wscale = WSCALE_E8M0, ascale = 0x7f7f7f7f; if constexpr (FP8) asm volatile("" : "+v"(wscale), "+v"(ascale));
    GU cur, nxt; int ui = 0;
    if (!S.next(0, cur)) return;
    f32x4 acc[2][2][4][2];
#pragma unroll
    for (int a = 0; a < 2; ++a)
#pragma unroll
        for (int b = 0; b < 2; ++b)
#pragma unroll
            for (int m = 0; m < 4; ++m)
#pragma unroll
                for (int n = 0; n < 2; ++n) acc[a][b][m][n] = (f32x4){0.f, 0.f, 0.f, 0.f};
    bf16x8 At[4][2], B0[2][2], B1[2][2];
    i32x8 At8[4], B08[2], B18[2];
    const char* cA = cur.A; const char* cB = cur.B;
    if constexpr (SP2) {
        PG8_STAGE(PG8_SB(0, 0), cB, voffB); PG8_STAGE(PG8_SB(0, 1), cB + hstepB, voffB); PG8_STAGE(PG8_SA(0, 0), cA, voffA); PG8_STAGE(PG8_SA(0, 1), cA + hstepA, voffA);
        if (wr == 1) PG8_BAR;
        PG8_WAIT_V(2); PG8_BAR;
        PG8_STAGE(PG8_SB(1, 0), cB + kstep, voffB); PG8_STAGE(PG8_SA(1, 0), cA + kstep, voffA); PG8_STAGE(PG8_SB(1, 1), cB + hstepB + kstep, voffB);
        PG8_WAIT_V(6); PG8_BAR;
    } else {
        PG8_STAGE(PG8_SB(0, 0), cB, voffB); PG8_STAGE(PG8_SA(0, 0), cA, voffA); PG8_STAGE(PG8_SB(0, 1), cB + hstepB, voffB); PG8_STAGE(PG8_SA(0, 1), cA + hstepA, voffA);
        if (wr == 1) PG8_BAR;
        PG8_WAIT_V(4); PG8_BAR;
        PG8_STAGE(PG8_SB(1, 0), cB + kstep, voffB); PG8_STAGE(PG8_SA(1, 0), cA + kstep, voffA); PG8_STAGE(PG8_SB(1, 1), cB + hstepB + kstep, voffB);
        PG8_WAIT_V(6); PG8_BAR;
    }
    for (;;) {
        const bool has_next = S.next(ui + 1, nxt);
        const char* nA = has_next ? nxt.A : cA; const char* nB = has_next ? nxt.B : cB;
        const int nt = cur.nt; const bool half0 = FP8 && cur.rows <= wr * 64, half1 = FP8 && cur.rows <= 128 + wr * 64;
        for (int t = 0; t < nt; t += 2) {
            const bool last = (t == nt - 2);
            const char* a1 = cA + (size_t)(t + 1) * kstep;
            const char* a2 = last ? nA : cA + (size_t)(t + 2) * kstep; const char* b2 = last ? nB : cB + (size_t)(t + 2) * kstep;
            const char* a3 = a2 + kstep; const char* b3 = b2 + kstep;
            if constexpr (SP2) {
            PG8_LDB(B0, 0, 0); PG8_LDB(B1, 0, 1); PG8_SCHED; PG8_LDA(At, 0, 0); PG8_STAGE(PG8_SA(1, 1), a1 + hstepA, voffA);
            PG8_WAIT_V(8); PG8_WAIT_L(0); PG8_BAR; if (!half0) { PG8_MMA(0, 0, At, B0); PG8_MMA(0, 1, At, B1); } PG8_BAR; PG8_SCHED;
            if (!half1) PG8_LDA(At, 0, 1); PG8_STAGE(PG8_SB(0, 0), b2, voffB); PG8_STAGE(PG8_SB(0, 1), b2 + hstepB, voffB); PG8_STAGE(PG8_SA(0, 0), a2, voffA);
            PG8_WAIT_V(8); PG8_WAIT_L(0); PG8_BAR; if (!half1) { PG8_MMA(1, 0, At, B0); PG8_MMA(1, 1, At, B1); } PG8_BAR; PG8_SCHED;
            PG8_LDB(B0, 1, 0); PG8_LDB(B1, 1, 1); PG8_SCHED; PG8_LDA(At, 1, 0); PG8_STAGE(PG8_SA(0, 1), a2 + hstepA, voffA);
            PG8_WAIT_V(8); PG8_WAIT_L(0); PG8_BAR; if (!half0) { PG8_MMA(0, 0, At, B0); PG8_MMA(0, 1, At, B1); } PG8_BAR; PG8_SCHED;
            if (!half1) PG8_LDA(At, 1, 1); PG8_STAGE(PG8_SB(1, 0), b3, voffB); PG8_STAGE(PG8_SB(1, 1), b3 + hstepB, voffB); PG8_STAGE(PG8_SA(1, 0), a3, voffA);
            PG8_WAIT_V(8); PG8_WAIT_L(0); PG8_BAR; if (!half1) { PG8_MMA(1, 0, At, B0); PG8_MMA(1, 1, At, B1); } PG8_BAR; PG8_SCHED;
            } else {
            PG8_LDB(B0, 0, 0); PG8_SCHED; PG8_LDA(At, 0, 0); PG8_STAGE(PG8_SA(1, 1), a1 + hstepA, voffA);
            PG8_WAIT_L(8); PG8_BAR; PG8_WAIT_L(0); PG8_MMA(0, 0, At, B0); PG8_BAR; PG8_SCHED;
            PG8_LDB(B1, 0, 1); PG8_STAGE(PG8_SB(0, 0), b2, voffB);
            PG8_BAR; PG8_WAIT_L(0); PG8_MMA(0, 1, At, B1); PG8_BAR;
            PG8_LDA(At, 0, 1); PG8_STAGE(PG8_SA(0, 0), a2, voffA);
            PG8_BAR; PG8_WAIT_L(0); PG8_MMA(1, 0, At, B0); PG8_BAR; PG8_SCHED;
            PG8_STAGE(PG8_SB(0, 1), b2 + hstepB, voffB);
            PG8_WAIT_V(6); PG8_BAR; PG8_MMA(1, 1, At, B1); PG8_BAR;
            PG8_LDB(B0, 1, 0); PG8_SCHED; PG8_LDA(At, 1, 0); PG8_STAGE(PG8_SA(0, 1), a2 + hstepA, voffA);
            PG8_WAIT_L(8); PG8_BAR; PG8_WAIT_L(0); PG8_MMA(0, 0, At, B0); PG8_BAR; PG8_SCHED;
            PG8_LDB(B1, 1, 1); PG8_STAGE(PG8_SB(1, 0), b3, voffB);
            PG8_BAR; PG8_WAIT_L(0); PG8_MMA(0, 1, At, B1); PG8_BAR;
            PG8_LDA(At, 1, 1); PG8_STAGE(PG8_SA(1, 0), a3, voffA);
            PG8_BAR; PG8_WAIT_L(0); PG8_MMA(1, 0, At, B0); PG8_BAR; PG8_SCHED;
            PG8_STAGE(PG8_SB(1, 1), b3 + hstepB, voffB);
            PG8_WAIT_V(6); PG8_BAR; PG8_MMA(1, 1, At, B1); PG8_BAR;
            }
        }
        if constexpr (ALIGN_EPI) { if (wr == 0) PG8_BAR; }
        if constexpr (FP8) {
            asm volatile("s_nop 15\n\ts_nop 15" ::: "memory");
#pragma unroll
            for (int a = 0; a < 2; ++a)
#pragma unroll
                for (int b = 0; b < 2; ++b)
#pragma unroll
                    for (int m = 0; m < 4; ++m)
#pragma unroll
                        for (int n = 0; n < 2; ++n) asm volatile("" : "+v"(acc[a][b][m][n]));
        }
        const bool keep = E(acc, cur, wr, wc, fr, fq);
        if (!has_next) break;
        if (!keep) {
#pragma unroll
            for (int a = 0; a < 2; ++a)
#pragma unroll
                for (int b = 0; b < 2; ++b)
#pragma unroll
                    for (int m = 0; m < 4; ++m)
#pragma unroll
                        for (int n = 0; n < 2; ++n) acc[a][b][m][n] = (f32x4){0.f, 0.f, 0.f, 0.f};
        }
        cur = nxt; cA = nA; cB = nB; ++ui;
        if constexpr (ALIGN_EPI) { if (wr == 1) PG8_BAR; }
    }
    PG8_WAIT_V(0);
    if constexpr (!ALIGN_EPI) { if (wr == 0) PG8_BAR; }
    PG8_BAR;
#undef PG8_SA
#undef PG8_SB
#undef PG8_STAGE
#undef PG8_LD1
#undef PG8_LDA
#undef PG8_LDB
#undef PG8_MMA
#undef PG8_CAT
#undef PG8_WAIT_V
#undef PG8_WAIT_L
#undef PG8_BAR
#undef PG8_SCHED
}
}
constexpr int RING_OFF = 0, RING_BYTES = 131072;
constexpr int EPIP_OFF = RING_BYTES;
constexpr int TAB_OFF = EPIP_OFF + 8192;
constexpr int MISC_OFF = TAB_OFF + 2048;
constexpr int LDS_BYTES = 147456;
static_assert(MISC_OFF + 128 <= LDS_BYTES, "LDS map");

struct SchedGrid {
    const char* A; const char* B; int nM, nN, nt, G, c; size_t astep, bstep;
    int pn0, pn_a, pn_skip;
    DI bool next(int i, pg8::GU& u) const {
        const long L = (long)i * G + c; if (L >= (long)nM * nN) return false;
        int pm, pn; pg8::tile_order((int)L, nM, nN, pm, pn);
        pn = pn0 + pn + (pn >= pn_a ? pn_skip : 0);
        u.pm = pm; u.pn = pn; u.tag = 0; u.rows = 256; u.nt = nt; u.A = A + (size_t)pm * astep; u.B = B + (size_t)pn * bstep; return true;
    }
};
struct SchedBranch {
    const char* A; const char* B; int G, c;
    DI bool next(int i, pg8::GU& u) const {
        const int ti = i / 3, sub = i - ti * 3; const long L = (long)ti * G + c; if (L >= 64 * 8) return false;
        int pm, pn; pg8::tile_order((int)L, 64, 8, pm, pn);
        const int koff = sub == 0 ? 0 : (sub == 1 ? 2048 : 3072);
        u.pm = pm; u.pn = pn; u.tag = sub; u.rows = 256; u.nt = sub == 0 ? 32 : 16;
        u.A = A + ((size_t)pm * 256 * 4096 + koff) * 2; u.B = B + ((size_t)pn * 256 * 4096 + koff) * 2; return true;
    }
};
struct SchedMoE {
    const char* A; const char* B; const LAS int* rb2e; int nrb, NPN, G, c, nt; size_t apan, bexp, bpn;
    DI bool next(int i, pg8::GU& u) const {
        const long L = (long)i * G + c; if (L >= (long)nrb * NPN) return false;
        const int rb = (int)(L / NPN), pn = (int)(L - (long)rb * NPN); const int e = rb2e[rb];
        const int pm = e * (ECAP / 256) + (rb - rb2e[300 + e]);
        u.pm = pm; u.pn = pn; u.tag = e; u.nt = nt;
        u.rows = rb2e[340 + e] - (rb - rb2e[300 + e]) * 256;
        u.A = A + (size_t)pm * apan; u.B = B + (size_t)e * bexp + (size_t)pn * bpn; return true;
    }
};

typedef f32x4 AccT[2][2][4][2];
DI float sigmoidf_(float v) { v = fmaxf(v, -80.f); return __builtin_amdgcn_rcpf(1.f + __builtin_amdgcn_exp2f(-1.4426950408889634f * v)); }

template <int TYPE  > struct EpiProj {
    static constexpr bool PERM = true;
    bf16_t* out; int ldc; int memkv;
    const float *gt, *gmq, *gmk, *bgate; const float* cs;
    LAS float* P;
    DI bool operator()(AccT& acc, const pg8::GU& u, int wr, int wc, int fr, int fq) const {
        asm volatile("" : "+v"(fr), "+v"(fq));
        const float* gain = nullptr;
        const int pn = u.pn;
        if (TYPE == 2) gain = memkv ? gmk : gmq;
        if (TYPE == 1) gain = gt + (pn < 16 ? (pn >> 3) : 2 + ((pn - 24) >> 2)) * 128;
        const int rloc0 = wr * 64 + fr, cloc0 = wc * 32 + 8 * fq;
        if (TYPE == 1 || TYPE == 2) {
            const bool dorope = (TYPE == 1) && wc == 0;
            constexpr int NS = 3;
            f32x4 cc[NS][2], ss[NS][2];
            if (dorope) {
#pragma unroll
                for (int m = 0; m < NS; ++m) { const float* cp = cs + ((size_t)u.pm * 256 + rloc0 + m * 16) * 32 + 8 * (fq & 1);
#pragma unroll
                    for (int n = 0; n < 2; ++n) { cc[m][n] = *(const f32x4*)(cp + 4 * n); ss[m][n] = *(const f32x4*)(cp + 16 + 4 * n); } } }
            constexpr int NG = TYPE == 2 ? 2 : 1;
            f32x4 g[NG][2];
#pragma unroll
            for (int bj = 0; bj < NG; ++bj)
#pragma unroll
                for (int n = 0; n < 2; ++n) g[bj][n] = *(const f32x4*)(gain + bj * 128 + cloc0 + n * 4);
            asm volatile("" ::: "memory");
#pragma unroll
            for (int ai = 0; ai < 2; ++ai)
#pragma unroll
                for (int m = 0; m < 4; ++m)
#pragma unroll
                    for (int bj = 0; bj < 2; ++bj) { float s = 0.f;
#pragma unroll
                        for (int n = 0; n < 2; ++n) { const f32x4 x = acc[ai][bj][m][n]; s += (x[0] * x[0] + x[1] * x[1]) + (x[2] * x[2] + x[3] * x[3]); }
                        s += __shfl_xor(s, 16); s += __shfl_xor(s, 32);
                        if (fq == 0) P[(ai * 128 + rloc0 + m * 16) * 8 + bj * 4 + wc] = s; }
            LDS_WAIT(); __builtin_amdgcn_s_barrier(); asm volatile("" ::: "memory");
#pragma unroll
            for (int ai = 0; ai < 2; ++ai)
#pragma unroll
                for (int m = 0; m < 4; ++m) {
                    const LAS f32x4* pr = (const LAS f32x4*)(P + (ai * 128 + rloc0 + m * 16) * 8);
                    const f32x4 p0 = pr[0], p1 = pr[1];
                    const float t0 = (p0[0] + p0[1]) + (p0[2] + p0[3]), t1 = (p1[0] + p1[1]) + (p1[2] + p1[3]);
                    float r0, r1;
                    if (TYPE == 1) { r0 = __builtin_amdgcn_rsqf(t0 * (1.f / 128.f) + EPS); r1 = __builtin_amdgcn_rsqf(t1 * (1.f / 128.f) + EPS); }
                    else { r0 = r1 = __builtin_amdgcn_rsqf((t0 + t1) * (1.f / 256.f) + EPS); }
#pragma unroll
                    for (int n = 0; n < 2; ++n) { acc[ai][0][m][n] = acc[ai][0][m][n] * r0 * g[0][n]; acc[ai][1][m][n] = acc[ai][1][m][n] * r1 * g[NG - 1][n]; }
                    if (dorope) {
#pragma unroll
                        for (int n = 0; n < 2; ++n) { const f32x4 c = cc[(ai * 4 + m) % NS][n], s = ss[(ai * 4 + m) % NS][n];
#pragma unroll
                            for (int bj = 0; bj < 2; ++bj)
#pragma unroll
                                for (int jp = 0; jp < 4; jp += 2) {
                                    const float cs_ = fq < 2 ? c[jp] : c[jp + 1], sn_ = fq < 2 ? s[jp] : s[jp + 1];
                                    auto r1 = __builtin_amdgcn_permlane32_swap(__float_as_uint(acc[ai][bj][m][n][jp]), __float_as_uint(acc[ai][bj][m][n][jp + 1]), false, false);
                                    const float u1 = __uint_as_float(r1[0]), u2 = __uint_as_float(r1[1]);
                                    const float o1 = u1 * cs_ - u2 * sn_, o2 = u2 * cs_ + u1 * sn_;
                                    auto r2 = __builtin_amdgcn_permlane32_swap(__float_as_uint(o1), __float_as_uint(o2), false, false);
                                    acc[ai][bj][m][n][jp] = __uint_as_float(r2[0]); acc[ai][bj][m][n][jp + 1] = __uint_as_float(r2[1]); } }
                        if (ai * 4 + m + NS < 8) {
                            constexpr int dummy = 0; (void)dummy; const int rn = ai * 4 + m + NS;
                            const float* cp = cs + ((size_t)u.pm * 256 + (rn >> 2) * 128 + rloc0 + (rn & 3) * 16) * 32 + 8 * (fq & 1);
#pragma unroll
                            for (int n = 0; n < 2; ++n) { cc[(ai * 4 + m) % NS][n] = *(const f32x4*)(cp + 4 * n); ss[(ai * 4 + m) % NS][n] = *(const f32x4*)(cp + 16 + 4 * n); } }
                    }
                    asm volatile("" : "+v"(acc[ai][0][m][0]), "+v"(acc[ai][0][m][1]), "+v"(acc[ai][1][m][0]), "+v"(acc[ai][1][m][1]));
#pragma unroll
                    for (int bj = 0; bj < 2; ++bj) { const f32x4 v0 = acc[ai][bj][m][0], v1 = acc[ai][bj][m][1]; u32x4 w;
                        w.x = cvt_pk_bf16(v0[0], v0[1]); w.y = cvt_pk_bf16(v0[2], v0[3]); w.z = cvt_pk_bf16(v1[0], v1[1]); w.w = cvt_pk_bf16(v1[2], v1[3]);
                        *(u32x4*)(out + ((size_t)u.pm * 256 + ai * 128 + rloc0 + m * 16) * ldc + pn * 256 + cloc0 + bj * 128) = w; }
                    asm volatile("" ::: "memory");
                }
            return false;
        } else if (TYPE == 3) {
            const int cb = pn * 256 - C_G + cloc0;
            f32x4 bvv[2][2];
#pragma unroll
            for (int bj = 0; bj < 2; ++bj)
#pragma unroll
                for (int n = 0; n < 2; ++n) bvv[bj][n] = *(const f32x4*)(bgate + cb + bj * 128 + n * 4);
            asm volatile("" ::: "memory");
#pragma unroll
            for (int ai = 0; ai < 2; ++ai)
#pragma unroll
                for (int m = 0; m < 4; ++m) {
#pragma unroll
                    for (int bj = 0; bj < 2; ++bj)
#pragma unroll
                        for (int n = 0; n < 2; ++n) { f32x4 v = acc[ai][bj][m][n] + bvv[bj][n];
                            v[0] = sigmoidf_(v[0]); v[1] = sigmoidf_(v[1]); v[2] = sigmoidf_(v[2]); v[3] = sigmoidf_(v[3]); acc[ai][bj][m][n] = v; }
#pragma unroll
                    for (int bj = 0; bj < 2; ++bj) { const f32x4 v0 = acc[ai][bj][m][0], v1 = acc[ai][bj][m][1]; u32x4 w;
                        w.x = cvt_pk_bf16(v0[0], v0[1]); w.y = cvt_pk_bf16(v0[2], v0[3]); w.z = cvt_pk_bf16(v1[0], v1[1]); w.w = cvt_pk_bf16(v1[2], v1[3]);
                        *(u32x4*)(out + ((size_t)u.pm * 256 + ai * 128 + rloc0 + m * 16) * ldc + pn * 256 + cloc0 + bj * 128) = w; }
                    asm volatile("" ::: "memory");
                }
            return false;
        }
#pragma unroll
        for (int ai = 0; ai < 2; ++ai)
#pragma unroll
            for (int m = 0; m < 4; ++m) { bf16_t* rowp = out + ((size_t)u.pm * 256 + ai * 128 + rloc0 + m * 16) * ldc + pn * 256 + cloc0;
#pragma unroll
                for (int bj = 0; bj < 2; ++bj) { const f32x4 v0 = acc[ai][bj][m][0], v1 = acc[ai][bj][m][1]; u32x4 w;
                    w.x = cvt_pk_bf16(v0[0], v0[1]); w.y = cvt_pk_bf16(v0[2], v0[3]); w.z = cvt_pk_bf16(v1[0], v1[1]); w.w = cvt_pk_bf16(v1[2], v1[3]);
                    *(u32x4*)(rowp + bj * 128) = w; } }
        return false;
    }
};

struct EpiBranch {
    static constexpr bool PERM = true; static constexpr int EB_ROWS = 4;
    const bf16_t* proj; bf16_t* merged;
    DI bool operator()(AccT& acc, const pg8::GU& u, int wr, int wc, int fr, int fq) const {
        asm volatile("" : "+v"(fr), "+v"(fq));
        const int sub = u.tag; const int rloc0 = wr * 64 + fr, col0 = u.pn * 256 + wc * 32 + 8 * fq;
        const int oa = sub * 2048, ob = (sub < 2 ? sub + 1 : 2) * 2048;
        const bool ratio = sub < 2;
#pragma unroll
        for (int am = 0; am < 8; am += EB_ROWS) {
            u32x4 A[EB_ROWS][2], B[EB_ROWS][2];
#pragma unroll
            for (int q = 0; q < EB_ROWS; ++q)
#pragma unroll
                for (int bj = 0; bj < 2; ++bj) { const int ai = (am + q) >> 2, m = (am + q) & 3; const bf16_t* gp = proj + ((size_t)u.pm * 256 + ai * 128 + rloc0 + m * 16) * INC + C_G + col0 + bj * 128;
                    A[q][bj] = *(const u32x4*)(gp + oa); B[q][bj] = *(const u32x4*)(gp + ob); }
            asm volatile("" ::: "memory");
#pragma unroll
            for (int q = 0; q < EB_ROWS; ++q) { const int ai = (am + q) >> 2, m = (am + q) & 3;
#pragma unroll
                for (int bj = 0; bj < 2; ++bj) { const u32x4 a = A[q][bj], b = B[q][bj];
#define EB_F(av, bv) ((av) * (ratio ? __builtin_amdgcn_rcpf(bv) : 1.f))
                    const f32x4 f0 = {EB_F(bf_lo(a.x), bf_lo(b.x)), EB_F(bf_hi(a.x), bf_hi(b.x)), EB_F(bf_lo(a.y), bf_lo(b.y)), EB_F(bf_hi(a.y), bf_hi(b.y))};
                    const f32x4 f1 = {EB_F(bf_lo(a.z), bf_lo(b.z)), EB_F(bf_hi(a.z), bf_hi(b.z)), EB_F(bf_lo(a.w), bf_lo(b.w)), EB_F(bf_hi(a.w), bf_hi(b.w))};
#undef EB_F
                    acc[ai][bj][m][0] = acc[ai][bj][m][0] * f0; acc[ai][bj][m][1] = acc[ai][bj][m][1] * f1; } }
            asm volatile("" ::: "memory");
        }
        if (sub == 2) {
#pragma unroll
            for (int ai = 0; ai < 2; ++ai)
#pragma unroll
                for (int m = 0; m < 4; ++m) { const size_t row = (size_t)u.pm * 256 + ai * 128 + rloc0 + m * 16;
#pragma unroll
                    for (int bj = 0; bj < 2; ++bj) { const f32x4 v0 = acc[ai][bj][m][0], v1 = acc[ai][bj][m][1]; u32x4 w;
                        w.x = cvt_pk_bf16(v0[0], v0[1]); w.y = cvt_pk_bf16(v0[2], v0[3]); w.z = cvt_pk_bf16(v1[0], v1[1]); w.w = cvt_pk_bf16(v1[2], v1[3]);
                        *(u32x4*)(merged + row * DM + col0 + bj * 128) = w; } }
        }
        return sub < 2;
    }
};

struct EpiOut {
    static constexpr bool PERM = false;
    const float* x; float* x1;
    DI bool operator()(AccT& acc, const pg8::GU& u, int wr, int wc, int fr, int fq) const {
        const int rloc0 = wr * 64 + fr, col0 = u.pn * 256 + wc * 32 + 4 * fq;
#pragma unroll
        for (int ai = 0; ai < 2; ++ai)
            { f32x4 xv[4][2][2];
#pragma unroll
              for (int m = 0; m < 4; ++m) { const size_t off = ((size_t)u.pm * 256 + ai * 128 + rloc0 + m * 16) * DM + col0;
#pragma unroll
                for (int bj = 0; bj < 2; ++bj)
#pragma unroll
                    for (int n = 0; n < 2; ++n) xv[m][bj][n] = __builtin_nontemporal_load((const f32x4*)(x + off + bj * 128 + n * 16)); }
              asm volatile("" ::: "memory");
#pragma unroll
              for (int m = 0; m < 4; ++m) { const size_t off = ((size_t)u.pm * 256 + ai * 128 + rloc0 + m * 16) * DM + col0;
#pragma unroll
                for (int bj = 0; bj < 2; ++bj)
#pragma unroll
                    for (int n = 0; n < 2; ++n) *(f32x4*)(x1 + off + bj * 128 + n * 16) = xv[m][bj][n] + acc[ai][bj][m][n]; }
              asm volatile("" ::: "memory"); }
        return false;
    }
};

struct EpiSwiglu {
    static constexpr bool PERM = true;
    const float* bgu; unsigned char* act;
    DI bool operator()(AccT& acc, const pg8::GU& u, int wr, int wc, int fr, int fq) const {
        const int rloc0 = wr * 64 + fr, cc = wc * 32 + 8 * fq, gcol = u.pn * 128 + cc; const float* bp = bgu + (size_t)u.tag * 4096 + gcol;
        const f32x4 bg0 = *(const f32x4*)bp, bg1 = *(const f32x4*)(bp + 4), bu0 = *(const f32x4*)(bp + 2048), bu1 = *(const f32x4*)(bp + 2052);
#pragma unroll
        for (int ai = 0; ai < 2; ++ai)
#pragma unroll
            for (int m = 0; m < 4; ++m) { const size_t row = (size_t)u.pm * 256 + ai * 128 + rloc0 + m * 16;
                f32x4 r[2];
#pragma unroll
                for (int n = 0; n < 2; ++n) { const f32x4 gt = acc[ai][0][m][n] + (n ? bg1 : bg0), up = acc[ai][1][m][n] + (n ? bu1 : bu0);
#pragma unroll
                    for (int j = 0; j < 4; ++j) { const float g = fminf(gt[j], 7.f), uu = fminf(fmaxf(up[j], -7.f), 7.f);
                        r[n][j] = (uu + 1.f) * g * __builtin_amdgcn_rcpf(1.f + __builtin_amdgcn_exp2f(-1.702f * 1.4426950408889634f * g)); } }
                u32x2 w; w.x = pack4_fp8(r[0][0], r[0][1], r[0][2], r[0][3]); w.y = pack4_fp8(r[1][0], r[1][1], r[1][2], r[1][3]);
                *(u32x2*)(act + row * DFF + gcol) = w; }
        return false;
    }
};

struct EpiDown {
    static constexpr bool PERM = true;
    const float* bd; const int* slot_asg; const float* slot_w; bf16_t* ybuf;
    DI bool operator()(AccT& acc, const pg8::GU& u, int wr, int wc, int fr, int fq) const {
        const int rloc0 = wr * 64 + fr, col0 = u.pn * 256 + wc * 32 + 8 * fq; const float* bp = bd + (size_t)u.tag * DM + col0;
        f32x4 bv[2][2];
#pragma unroll
        for (int bj = 0; bj < 2; ++bj)
#pragma unroll
            for (int n = 0; n < 2; ++n) bv[bj][n] = *(const f32x4*)(bp + bj * 128 + 4 * n);
        int av[2][4]; float wv[2][4];
#pragma unroll
        for (int ai = 0; ai < 2; ++ai)
#pragma unroll
            for (int m = 0; m < 4; ++m) { const size_t slot = (size_t)u.pm * 256 + ai * 128 + rloc0 + m * 16; av[ai][m] = slot_asg[slot]; wv[ai][m] = slot_w[slot]; }
        asm volatile("" ::: "memory");
#pragma unroll
        for (int ai = 0; ai < 2; ++ai)
#pragma unroll
            for (int m = 0; m < 4; ++m) { const int a = av[ai][m]; const float wgt = wv[ai][m];
                if (a >= 0) {
#pragma unroll
                    for (int bj = 0; bj < 2; ++bj) { const f32x4 v0 = (acc[ai][bj][m][0] + bv[bj][0]) * wgt, v1 = (acc[ai][bj][m][1] + bv[bj][1]) * wgt; u32x4 w;
                        w.x = cvt_pk_bf16(v0[0], v0[1]); w.y = cvt_pk_bf16(v0[2], v0[3]); w.z = cvt_pk_bf16(v1[0], v1[1]); w.w = cvt_pk_bf16(v1[2], v1[3]);
                        *(u32x4*)(ybuf + (size_t)a * DM + col0 + bj * 128) = w; } } }
        return false;
    }
};
namespace att {
constexpr int SHM_K = 64 * 128 * 2, SHM_V = 64 * 256 * 2, STG = 2 * SHM_K + SHM_V;
#define KSWZ(row, colB) ((row) * 256 + ((colB) ^ (((row) & 7) << 4)))
DI int swap23(int k) { return (k & ~0xC) | ((k & 4) << 1) | ((k & 8) >> 1); }
DI int v_rd_base(int lane) { return ((lane & 3) << 3) | (((lane >> 2) & 3) << 6) | (((lane >> 4) & 1) << 5) | (((lane >> 5) & 1) << 8); }
DI int crow(int r, int hi) { return (r & 3) + 8 * (r >> 2) + 4 * hi; }

DI void mask_causal(f32x16& p0, f32x16& p1, int dq) {
    const float NEG = -__builtin_inff();
#pragma unroll
    for (int r = 0; r < 16; ++r) { const int c = (r & 3) + 8 * (r >> 2);
        if (dq - c < 0) p0[r] = NEG;
        if (dq - c - 32 < 0) p1[r] = NEG; }
}
template <int NP>
DI void partialSM(f32x16& p0, f32x16& p1, float& m_reg, float& alpha, const float C2, const float SCALE) {
    float pmax = p0[0];
#pragma unroll
    for (int r = 1; r < 16; ++r) pmax = fmaxf(pmax, p0[r]);
    if (NP == 2) {
#pragma unroll
        for (int r = 0; r < 16; ++r) pmax = fmaxf(pmax, p1[r]); }
    { auto rr = __builtin_amdgcn_permlane32_swap(__float_as_uint(pmax), __float_as_uint(pmax), false, false);
      pmax = fmaxf(__uint_as_float(rr[0]), __uint_as_float(rr[1])); }
    float mn;
    if (__builtin_expect(__all((pmax - m_reg) * SCALE <= 8.f), 1)) { mn = m_reg; alpha = 1.f; }
    else { mn = fmaxf(m_reg, pmax); alpha = __builtin_amdgcn_exp2f((m_reg - mn) * C2); m_reg = mn; }
    const float mnL = -mn * C2;
#pragma unroll
    for (int r = 0; r < 16; ++r) p0[r] = __builtin_amdgcn_exp2f(fmaf(p0[r], C2, mnL));
    if (NP == 2) {
#pragma unroll
        for (int r = 0; r < 16; ++r) p1[r] = __builtin_amdgcn_exp2f(fmaf(p1[r], C2, mnL)); }
}
#define PK4(P, B_, OUT) do { unsigned a0 = cvt_pk_bf16_a(P[B_+0], P[B_+1]), a1 = cvt_pk_bf16_a(P[B_+2], P[B_+3]);                          \
        unsigned b0 = cvt_pk_bf16_a(P[B_+4], P[B_+5]), b1 = cvt_pk_bf16_a(P[B_+6], P[B_+7]);                                             \
        asm volatile("s_nop 1" : "+v"(a0), "+v"(a1), "+v"(b0), "+v"(b1));                                                                                                         \
        auto r0 = __builtin_amdgcn_permlane32_swap(a0, b0, false, false); auto r1 = __builtin_amdgcn_permlane32_swap(a1, b1, false, false); \
        u32x4 w = {r0[0], r1[0], r0[1], r1[1]}; OUT = *reinterpret_cast<bf16x8*>(&w); } while (0)
template <int NP>
DI void finishSM(f32x16& p0, f32x16& p1, float alpha, float& l_reg, bf16x8& pa0, bf16x8& pa1, bf16x8& pa2, bf16x8& pa3) {
    float ps = 0.f;
#pragma unroll
    for (int r = 0; r < 16; ++r) ps += p0[r];
    if (NP == 2) {
#pragma unroll
        for (int r = 0; r < 16; ++r) ps += p1[r]; }
    { auto rr = __builtin_amdgcn_permlane32_swap(__float_as_uint(ps), __float_as_uint(ps), false, false);
      ps = __uint_as_float(rr[0]) + __uint_as_float(rr[1]); }
    l_reg = l_reg * alpha + ps;
    PK4(p0, 0, pa0); PK4(p0, 8, pa1);
    if (NP == 2) { PK4(p1, 0, pa2); PK4(p1, 8, pa3); }
}
DI void qkt(f32x16& p0, f32x16& p1, const LAS char* Kt, int r32, int hi, const bf16x8* qr) {
    const LAS char* kb[4];
#pragma unroll
    for (int dd = 0; dd < 4; ++dd) kb[dd] = Kt + KSWZ(r32, (dd * 16 + hi * 8) * 2);
#pragma unroll
    for (int d0 = 0; d0 < 8; ++d0) { const LAS char* a = kb[d0 & 3] + (d0 >> 2) * 128;
        const bf16x8 b0 = *reinterpret_cast<const LAS bf16x8*>(a);
        const bf16x8 b1 = *reinterpret_cast<const LAS bf16x8*>(a + 32 * 256);
        p0 = __builtin_amdgcn_mfma_f32_32x32x16_bf16(b0, qr[d0], p0, 0, 0, 0);
        p1 = __builtin_amdgcn_mfma_f32_32x32x16_bf16(b1, qr[d0], p1, 0, 0, 0); }
}
#define TRRD(dst, vb, off) asm volatile("ds_read_b64_tr_b16 %0, %1 offset:%2" : "=&v"(dst) : "v"(vb), "i"(off) : "memory")
#define TR8_64(S_, vb, base_, NCB) do { constexpr int b_ = (base_); \
        TRRD(S_##l0, vb, b_); TRRD(S_##h0, vb, b_ + NCB * 512); TRRD(S_##l1, vb, b_ + 2 * NCB * 512); TRRD(S_##h1, vb, b_ + 3 * NCB * 512);               \
        TRRD(S_##l2, vb, b_ + 4 * NCB * 512); TRRD(S_##h2, vb, b_ + 5 * NCB * 512); TRRD(S_##l3, vb, b_ + 6 * NCB * 512); TRRD(S_##h3, vb, b_ + 7 * NCB * 512); } while (0)
#define MMA4_64(o_, S_) do { \
        o_ = __builtin_amdgcn_mfma_f32_32x32x16_bf16((bf16x8){S_##l0[0], S_##l0[1], S_##l0[2], S_##l0[3], S_##h0[0], S_##h0[1], S_##h0[2], S_##h0[3]}, pa0, o_, 0, 0, 0);   \
        o_ = __builtin_amdgcn_mfma_f32_32x32x16_bf16((bf16x8){S_##l1[0], S_##l1[1], S_##l1[2], S_##l1[3], S_##h1[0], S_##h1[1], S_##h1[2], S_##h1[3]}, pa1, o_, 0, 0, 0);   \
        o_ = __builtin_amdgcn_mfma_f32_32x32x16_bf16((bf16x8){S_##l2[0], S_##l2[1], S_##l2[2], S_##l2[3], S_##h2[0], S_##h2[1], S_##h2[2], S_##h2[3]}, pa2, o_, 0, 0, 0);   \
        o_ = __builtin_amdgcn_mfma_f32_32x32x16_bf16((bf16x8){S_##l3[0], S_##l3[1], S_##l3[2], S_##l3[3], S_##h3[0], S_##h3[1], S_##h3[2], S_##h3[3]}, pa3, o_, 0, 0, 0); } while (0)
#define LGKM_WAIT(n) asm volatile("s_waitcnt lgkmcnt(" #n ")" ::: "memory")
#define PV_STEP(o_, Scur, Snxt, vb, nbase, NCB) do { TR8_64(Snxt, vb, nbase, NCB); LGKM_WAIT(8); SBAR(); MMA4_64(o_, Scur); SBAR(); } while (0)
#define PV_LAST(o_, Scur) do { LGKM_WAIT(0); SBAR(); MMA4_64(o_, Scur); SBAR(); } while (0)
#define PV_DECL() s16x4 fAl0, fAl1, fAl2, fAl3, fAh0, fAh1, fAh2, fAh3, fBl0, fBl1, fBl2, fBl3, fBh0, fBh1, fBh2, fBh3
#define PV_D0_32(o_, vb, base_, NCB) do { s16x4 l0, l1, h0, h1; constexpr int b_ = (base_);                                                   \
        TRRD(l0, vb, b_); TRRD(h0, vb, b_ + NCB * 512); TRRD(l1, vb, b_ + 2 * NCB * 512); TRRD(h1, vb, b_ + 3 * NCB * 512);               \
        asm volatile("s_waitcnt lgkmcnt(0)" ::: "memory"); SBAR();                                                                          \
        o_ = __builtin_amdgcn_mfma_f32_32x32x16_bf16((bf16x8){l0[0], l0[1], l0[2], l0[3], h0[0], h0[1], h0[2], h0[3]}, pa0, o_, 0, 0, 0);   \
        o_ = __builtin_amdgcn_mfma_f32_32x32x16_bf16((bf16x8){l1[0], l1[1], l1[2], l1[3], h1[0], h1[1], h1[2], h1[3]}, pa1, o_, 0, 0, 0); } while (0)

#define PV_JOUTER_64_DIFF(o, vb) do { s16x4 jl0, jl1, jl2, jl3, jl4, jh0, jh1, jh2, jh3, jh4; \
        TRRD(jl0, vb, 0); TRRD(jh0, vb, 4096); \
        TRRD(jl1, vb, 512); TRRD(jh1, vb, 4608); \
        TRRD(jl2, vb, 1024); TRRD(jh2, vb, 5120); \
        TRRD(jl3, vb, 1536); TRRD(jh3, vb, 5632); \
        TRRD(jl4, vb, 2048); TRRD(jh4, vb, 6144); LGKM_WAIT(8); SBAR(); o[0] = __builtin_amdgcn_mfma_f32_32x32x16_bf16((bf16x8){jl0[0], jl0[1], jl0[2], jl0[3], jh0[0], jh0[1], jh0[2], jh0[3]}, pa0, o[0], 0, 0, 0); SBAR(); \
        TRRD(jl0, vb, 2560); TRRD(jh0, vb, 6656); LGKM_WAIT(8); SBAR(); o[1] = __builtin_amdgcn_mfma_f32_32x32x16_bf16((bf16x8){jl1[0], jl1[1], jl1[2], jl1[3], jh1[0], jh1[1], jh1[2], jh1[3]}, pa0, o[1], 0, 0, 0); SBAR(); \
        TRRD(jl1, vb, 3072); TRRD(jh1, vb, 7168); LGKM_WAIT(8); SBAR(); o[2] = __builtin_amdgcn_mfma_f32_32x32x16_bf16((bf16x8){jl2[0], jl2[1], jl2[2], jl2[3], jh2[0], jh2[1], jh2[2], jh2[3]}, pa0, o[2], 0, 0, 0); SBAR(); \
        TRRD(jl2, vb, 3584); TRRD(jh2, vb, 7680); LGKM_WAIT(8); SBAR(); o[3] = __builtin_amdgcn_mfma_f32_32x32x16_bf16((bf16x8){jl3[0], jl3[1], jl3[2], jl3[3], jh3[0], jh3[1], jh3[2], jh3[3]}, pa0, o[3], 0, 0, 0); SBAR(); \
        TRRD(jl3, vb, 8192); TRRD(jh3, vb, 12288); LGKM_WAIT(8); SBAR(); o[4] = __builtin_amdgcn_mfma_f32_32x32x16_bf16((bf16x8){jl4[0], jl4[1], jl4[2], jl4[3], jh4[0], jh4[1], jh4[2], jh4[3]}, pa0, o[4], 0, 0, 0); SBAR(); \
        TRRD(jl4, vb, 8704); TRRD(jh4, vb, 12800); LGKM_WAIT(8); SBAR(); o[5] = __builtin_amdgcn_mfma_f32_32x32x16_bf16((bf16x8){jl0[0], jl0[1], jl0[2], jl0[3], jh0[0], jh0[1], jh0[2], jh0[3]}, pa0, o[5], 0, 0, 0); SBAR(); \
        TRRD(jl0, vb, 9216); TRRD(jh0, vb, 13312); LGKM_WAIT(8); SBAR(); o[6] = __builtin_amdgcn_mfma_f32_32x32x16_bf16((bf16x8){jl1[0], jl1[1], jl1[2], jl1[3], jh1[0], jh1[1], jh1[2], jh1[3]}, pa0, o[6], 0, 0, 0); SBAR(); \
        TRRD(jl1, vb, 9728); TRRD(jh1, vb, 13824); LGKM_WAIT(8); SBAR(); o[7] = __builtin_amdgcn_mfma_f32_32x32x16_bf16((bf16x8){jl2[0], jl2[1], jl2[2], jl2[3], jh2[0], jh2[1], jh2[2], jh2[3]}, pa0, o[7], 0, 0, 0); SBAR(); \
        TRRD(jl2, vb, 10240); TRRD(jh2, vb, 14336); LGKM_WAIT(8); SBAR(); o[0] = __builtin_amdgcn_mfma_f32_32x32x16_bf16((bf16x8){jl3[0], jl3[1], jl3[2], jl3[3], jh3[0], jh3[1], jh3[2], jh3[3]}, pa1, o[0], 0, 0, 0); SBAR(); \
        TRRD(jl3, vb, 10752); TRRD(jh3, vb, 14848); LGKM_WAIT(8); SBAR(); o[1] = __builtin_amdgcn_mfma_f32_32x32x16_bf16((bf16x8){jl4[0], jl4[1], jl4[2], jl4[3], jh4[0], jh4[1], jh4[2], jh4[3]}, pa1, o[1], 0, 0, 0); SBAR(); \
        TRRD(jl4, vb, 11264); TRRD(jh4, vb, 15360); LGKM_WAIT(8); SBAR(); o[2] = __builtin_amdgcn_mfma_f32_32x32x16_bf16((bf16x8){jl0[0], jl0[1], jl0[2], jl0[3], jh0[0], jh0[1], jh0[2], jh0[3]}, pa1, o[2], 0, 0, 0); SBAR(); \
        TRRD(jl0, vb, 11776); TRRD(jh0, vb, 15872); LGKM_WAIT(8); SBAR(); o[3] = __builtin_amdgcn_mfma_f32_32x32x16_bf16((bf16x8){jl1[0], jl1[1], jl1[2], jl1[3], jh1[0], jh1[1], jh1[2], jh1[3]}, pa1, o[3], 0, 0, 0); SBAR(); \
        TRRD(jl1, vb, 16384); TRRD(jh1, vb, 20480); LGKM_WAIT(8); SBAR(); o[4] = __builtin_amdgcn_mfma_f32_32x32x16_bf16((bf16x8){jl2[0], jl2[1], jl2[2], jl2[3], jh2[0], jh2[1], jh2[2], jh2[3]}, pa1, o[4], 0, 0, 0); SBAR(); \
        TRRD(jl2, vb, 16896); TRRD(jh2, vb, 20992); LGKM_WAIT(8); SBAR(); o[5] = __builtin_amdgcn_mfma_f32_32x32x16_bf16((bf16x8){jl3[0], jl3[1], jl3[2], jl3[3], jh3[0], jh3[1], jh3[2], jh3[3]}, pa1, o[5], 0, 0, 0); SBAR(); \
        TRRD(jl3, vb, 17408); TRRD(jh3, vb, 21504); LGKM_WAIT(8); SBAR(); o[6] = __builtin_amdgcn_mfma_f32_32x32x16_bf16((bf16x8){jl4[0], jl4[1], jl4[2], jl4[3], jh4[0], jh4[1], jh4[2], jh4[3]}, pa1, o[6], 0, 0, 0); SBAR(); \
        TRRD(jl4, vb, 17920); TRRD(jh4, vb, 22016); LGKM_WAIT(8); SBAR(); o[7] = __builtin_amdgcn_mfma_f32_32x32x16_bf16((bf16x8){jl0[0], jl0[1], jl0[2], jl0[3], jh0[0], jh0[1], jh0[2], jh0[3]}, pa1, o[7], 0, 0, 0); SBAR(); \
        TRRD(jl0, vb, 18432); TRRD(jh0, vb, 22528); LGKM_WAIT(8); SBAR(); o[0] = __builtin_amdgcn_mfma_f32_32x32x16_bf16((bf16x8){jl1[0], jl1[1], jl1[2], jl1[3], jh1[0], jh1[1], jh1[2], jh1[3]}, pa2, o[0], 0, 0, 0); SBAR(); \
        TRRD(jl1, vb, 18944); TRRD(jh1, vb, 23040); LGKM_WAIT(8); SBAR(); o[1] = __builtin_amdgcn_mfma_f32_32x32x16_bf16((bf16x8){jl2[0], jl2[1], jl2[2], jl2[3], jh2[0], jh2[1], jh2[2], jh2[3]}, pa2, o[1], 0, 0, 0); SBAR(); \
        TRRD(jl2, vb, 19456); TRRD(jh2, vb, 23552); LGKM_WAIT(8); SBAR(); o[2] = __builtin_amdgcn_mfma_f32_32x32x16_bf16((bf16x8){jl3[0], jl3[1], jl3[2], jl3[3], jh3[0], jh3[1], jh3[2], jh3[3]}, pa2, o[2], 0, 0, 0); SBAR(); \
        TRRD(jl3, vb, 19968); TRRD(jh3, vb, 24064); LGKM_WAIT(8); SBAR(); o[3] = __builtin_amdgcn_mfma_f32_32x32x16_bf16((bf16x8){jl4[0], jl4[1], jl4[2], jl4[3], jh4[0], jh4[1], jh4[2], jh4[3]}, pa2, o[3], 0, 0, 0); SBAR(); \
        TRRD(jl4, vb, 24576); TRRD(jh4, vb, 28672); LGKM_WAIT(8); SBAR(); o[4] = __builtin_amdgcn_mfma_f32_32x32x16_bf16((bf16x8){jl0[0], jl0[1], jl0[2], jl0[3], jh0[0], jh0[1], jh0[2], jh0[3]}, pa2, o[4], 0, 0, 0); SBAR(); \
        TRRD(jl0, vb, 25088); TRRD(jh0, vb, 29184); LGKM_WAIT(8); SBAR(); o[5] = __builtin_amdgcn_mfma_f32_32x32x16_bf16((bf16x8){jl1[0], jl1[1], jl1[2], jl1[3], jh1[0], jh1[1], jh1[2], jh1[3]}, pa2, o[5], 0, 0, 0); SBAR(); \
        TRRD(jl1, vb, 25600); TRRD(jh1, vb, 29696); LGKM_WAIT(8); SBAR(); o[6] = __builtin_amdgcn_mfma_f32_32x32x16_bf16((bf16x8){jl2[0], jl2[1], jl2[2], jl2[3], jh2[0], jh2[1], jh2[2], jh2[3]}, pa2, o[6], 0, 0, 0); SBAR(); \
        TRRD(jl2, vb, 26112); TRRD(jh2, vb, 30208); LGKM_WAIT(8); SBAR(); o[7] = __builtin_amdgcn_mfma_f32_32x32x16_bf16((bf16x8){jl3[0], jl3[1], jl3[2], jl3[3], jh3[0], jh3[1], jh3[2], jh3[3]}, pa2, o[7], 0, 0, 0); SBAR(); \
        TRRD(jl3, vb, 26624); TRRD(jh3, vb, 30720); LGKM_WAIT(8); SBAR(); o[0] = __builtin_amdgcn_mfma_f32_32x32x16_bf16((bf16x8){jl4[0], jl4[1], jl4[2], jl4[3], jh4[0], jh4[1], jh4[2], jh4[3]}, pa3, o[0], 0, 0, 0); SBAR(); \
        TRRD(jl4, vb, 27136); TRRD(jh4, vb, 31232); LGKM_WAIT(8); SBAR(); o[1] = __builtin_amdgcn_mfma_f32_32x32x16_bf16((bf16x8){jl0[0], jl0[1], jl0[2], jl0[3], jh0[0], jh0[1], jh0[2], jh0[3]}, pa3, o[1], 0, 0, 0); SBAR(); \
        TRRD(jl0, vb, 27648); TRRD(jh0, vb, 31744); LGKM_WAIT(8); SBAR(); o[2] = __builtin_amdgcn_mfma_f32_32x32x16_bf16((bf16x8){jl1[0], jl1[1], jl1[2], jl1[3], jh1[0], jh1[1], jh1[2], jh1[3]}, pa3, o[2], 0, 0, 0); SBAR(); \
        TRRD(jl1, vb, 28160); TRRD(jh1, vb, 32256); LGKM_WAIT(8); SBAR(); o[3] = __builtin_amdgcn_mfma_f32_32x32x16_bf16((bf16x8){jl2[0], jl2[1], jl2[2], jl2[3], jh2[0], jh2[1], jh2[2], jh2[3]}, pa3, o[3], 0, 0, 0); SBAR(); \
        LGKM_WAIT(6); SBAR(); o[4] = __builtin_amdgcn_mfma_f32_32x32x16_bf16((bf16x8){jl3[0], jl3[1], jl3[2], jl3[3], jh3[0], jh3[1], jh3[2], jh3[3]}, pa3, o[4], 0, 0, 0); SBAR(); \
        LGKM_WAIT(4); SBAR(); o[5] = __builtin_amdgcn_mfma_f32_32x32x16_bf16((bf16x8){jl4[0], jl4[1], jl4[2], jl4[3], jh4[0], jh4[1], jh4[2], jh4[3]}, pa3, o[5], 0, 0, 0); SBAR(); \
        LGKM_WAIT(2); SBAR(); o[6] = __builtin_amdgcn_mfma_f32_32x32x16_bf16((bf16x8){jl0[0], jl0[1], jl0[2], jl0[3], jh0[0], jh0[1], jh0[2], jh0[3]}, pa3, o[6], 0, 0, 0); SBAR(); \
        LGKM_WAIT(0); SBAR(); o[7] = __builtin_amdgcn_mfma_f32_32x32x16_bf16((bf16x8){jl1[0], jl1[1], jl1[2], jl1[3], jh1[0], jh1[1], jh1[2], jh1[3]}, pa3, o[7], 0, 0, 0); SBAR(); \
    } while (0)
DI void store_pair16(bf16_t* p, float a0, float a1, float a2, float a3, float b0, float b1, float b2, float b3) {
    unsigned gx = cvt_pk_bf16_a(a0, a1), gy = cvt_pk_bf16_a(a2, a3), hx = cvt_pk_bf16_a(b0, b1), hy = cvt_pk_bf16_a(b2, b3);
    asm volatile("s_nop 1" : "+v"(gx), "+v"(gy), "+v"(hx), "+v"(hy));
    auto rx = __builtin_amdgcn_permlane32_swap(gx, hx, false, false); auto ry = __builtin_amdgcn_permlane32_swap(gy, hy, false, false);
    u32x4 w = {rx[0], ry[0], rx[1], ry[1]};
    *(u32x4*)p = w;
}
struct CoopArgs {
    const bf16_t* q;
    const bf16_t* k0; const bf16_t* k1; const bf16_t* v;
    int rsq, rsk, nt;
};
DI void stage_k(LAS char* st, const CoopArgs& a, int kb0, int wid, int lane) {
    const int l16 = lane & 15, lr = lane >> 4;
#pragma unroll
    for (int i = 0; i < 2; ++i) { const int piece = 2 * wid + i, row = piece * 4 + lr, ch = l16 ^ (row & 7);
        const size_t go = (size_t)(kb0 + row) * a.rsk + ch * 8;
        __builtin_amdgcn_global_load_lds((const unsigned*)(a.k0 + go), (LAS unsigned*)(st + piece * 1024), 16, 0, 0);
        __builtin_amdgcn_global_load_lds((const unsigned*)(a.k1 + go), (LAS unsigned*)(st + SHM_K + piece * 1024), 16, 0, 0); }
}
DI void stage_v(LAS char* st, const CoopArgs& a, int kb0, int wid, int lane) {
    const int sub = lane >> 5, kr = (lane & 31) >> 2, ch4 = lane & 3; const int key = swap23(8 * wid + kr);
    const bf16_t* vp = a.v + (size_t)(kb0 + key) * a.rsk + sub * 32 + ch4 * 8;
#pragma unroll
    for (int j = 0; j < 4; ++j)
        __builtin_amdgcn_global_load_lds((const unsigned*)(vp + j * 64), (LAS unsigned*)(st + 2 * SHM_K + wid * 4096 + j * 1024), 16, 0, 0);
}
}
namespace att {
struct DiffOut { bf16_t* ob; const float* subln; float lam; };
template <int MODE>
DI void coop_unit(LAS char* lds, const CoopArgs& a, int qpos0  , const float C2, const float SCALE,
                  bf16_t* orow  , int ors, const DiffOut& dout) {
    const int tid = threadIdx.x, wid = __builtin_amdgcn_readfirstlane(tid >> 6), lane = tid & 63, r32 = lane & 31, hi = lane >> 5;
    const int c = wid >> 2, wq = wid & 3;
    constexpr int NQ = MODE == 0 ? 8 : 16, NO = MODE == 0 ? 8 : 4;
    bf16x8 qr[NQ];
    { const bf16_t* qp = a.q + (MODE == 0 ? c * 128 : 0) + (size_t)(wq * 32 + r32) * a.rsq + hi * 8;
#pragma unroll
      for (int d0 = 0; d0 < NQ; ++d0) qr[d0] = *(const bf16x8*)(qp + d0 * 16); }
    f32x16 o[NO];
#pragma unroll
    for (int d = 0; d < NO; ++d)
#pragma unroll
        for (int r = 0; r < 16; ++r) o[d][r] = 0.f;
    float m_reg = -1e30f, l_reg = 0.f;
    const int NT = a.nt;
    const int qlo = qpos0 + wq * 32;
    stage_k(lds, a, 0, wid, lane); stage_v(lds, a, 0, wid, lane);
    for (int t = 0; t < NT; ++t) {
        VM_WAIT(); __syncthreads();
        LAS char* st = lds + (t & 1) * STG;
        if (t + 1 < NT) { stage_k(lds + ((t + 1) & 1) * STG, a, (t + 1) * 64, wid, lane); stage_v(lds + ((t + 1) & 1) * STG, a, (t + 1) * 64, wid, lane); }
        const int kb0 = t * 64;
        if (MODE == 1 || kb0 <= qlo + 31) {
            f32x16 p0, p1;
#pragma unroll
            for (int r = 0; r < 16; ++r) { p0[r] = 0.f; p1[r] = 0.f; }
            if (MODE == 0) qkt(p0, p1, st + c * SHM_K, r32, hi, qr);
            else { qkt(p0, p1, st, r32, hi, qr); qkt(p0, p1, st + SHM_K, r32, hi, qr + 8); }
            if (MODE == 0 && kb0 + 63 > qlo) mask_causal(p0, p1, qlo + r32 - kb0 - 4 * hi);
            float alpha;
            partialSM<2>(p0, p1, m_reg, alpha, C2, SCALE);
            if (__any(alpha < 1.f)) {
#pragma unroll
                for (int d = 0; d < NO; ++d)
#pragma unroll
                    for (int r = 0; r < 16; ++r) o[d][r] *= alpha; }
            bf16x8 pa0, pa1, pa2, pa3;
            finishSM<2>(p0, p1, alpha, l_reg, pa0, pa1, pa2, pa3);
            const int vb = (int)(uintptr_t)(st + 2 * SHM_K) + v_rd_base(lane) + (MODE == 1 ? c * 4 * 512 : 0);
            if constexpr (MODE == 0) { PV_JOUTER_64_DIFF(o, vb); }
            else { PV_DECL();
                TR8_64(fA, vb, 0 * 512, 8);
                PV_STEP(o[0], fA, fB, vb, 1 * 512, 8); PV_STEP(o[1], fB, fA, vb, 2 * 512, 8); PV_STEP(o[2], fA, fB, vb, 3 * 512, 8); PV_LAST(o[3], fB); }
        }
    }
    const float il = __builtin_amdgcn_rcpf(l_reg);
    if constexpr (MODE == 1) {
        bf16_t* op = orow + (size_t)(wq * 32 + r32) * ors + c * 128 + 8 * hi;
#pragma unroll
        for (int d = 0; d < 4; ++d)
#pragma unroll
            for (int g = 0; g < 4; g += 2)
                store_pair16(op + d * 32 + 8 * g, o[d][4 * g] * il, o[d][4 * g + 1] * il, o[d][4 * g + 2] * il, o[d][4 * g + 3] * il,
                             o[d][4 * g + 4] * il, o[d][4 * g + 5] * il, o[d][4 * g + 6] * il, o[d][4 * g + 7] * il);
        __syncthreads();
    } else {
        __syncthreads();
        LAS float* X = (LAS float*)lds + wq * 8192 + lane;
        if (c == 1) { const float sc = il * dout.lam;
#pragma unroll
            for (int d = 0; d < 8; ++d)
#pragma unroll
                for (int r = 0; r < 16; ++r) X[(d * 16 + r) * 64] = o[d][r] * sc; }
        __syncthreads();
        if (c == 0) {
            float ss = 0.f;
#pragma unroll
            for (int d = 0; d < 8; ++d)
#pragma unroll
                for (int r = 0; r < 16; ++r) { const float v = o[d][r] * il - X[(d * 16 + r) * 64]; o[d][r] = v; ss += v * v; }
            { auto rr = __builtin_amdgcn_permlane32_swap(__float_as_uint(ss), __float_as_uint(ss), false, false); ss = __uint_as_float(rr[0]) + __uint_as_float(rr[1]); }
            const float rs = __builtin_amdgcn_rsqf(ss * (1.f / 256.f) + EPS) * (1.f - LAM_INIT);
            bf16_t* op = orow + (size_t)(wq * 32 + r32) * ors + 8 * hi;
#pragma unroll
            for (int d = 0; d < 8; ++d)
#pragma unroll
                for (int g = 0; g < 4; g += 2) { const f32x4 ga = *(const f32x4*)(dout.subln + d * 32 + 8 * g + 4 * hi), gb = *(const f32x4*)(dout.subln + d * 32 + 8 * g + 8 + 4 * hi);
                    store_pair16(op + d * 32 + 8 * g, o[d][4 * g] * rs * ga[0], o[d][4 * g + 1] * rs * ga[1], o[d][4 * g + 2] * rs * ga[2], o[d][4 * g + 3] * rs * ga[3],
                                 o[d][4 * g + 4] * rs * gb[0], o[d][4 * g + 5] * rs * gb[1], o[d][4 * g + 6] * rs * gb[2], o[d][4 * g + 7] * rs * gb[3]); }
        }
        __syncthreads();
    }
}

DI void dil_wave_unit(LAS char* wl  , const bf16_t* proj, bf16_t* ob, int wu, int lane) {
    const int r32 = lane & 31, hi = lane >> 5;
    const int bh = wu >> 8, j = wu & 255, b = bh >> 3, h = bh & 7;
    const int tq0 = (j >> 3) * 256 + ((j >> 2) & 1) * 128 + (j & 3);
    const int tq = tq0 + 4 * r32;
    const size_t rowb = (size_t)b * SEQ;
    constexpr float SCALE = 0.08838834764831845f, C2 = 1.4426950408889634f * SCALE;
    bf16x8 qr[8];
    { const bf16_t* qp = proj + (rowb + tq) * INC + C_LQ + h * 128 + hi * 8;
#pragma unroll
      for (int d0 = 0; d0 < 8; ++d0) qr[d0] = *(const bf16x8*)(qp + d0 * 16); }
    f32x16 o[4];
#pragma unroll
    for (int d = 0; d < 4; ++d)
#pragma unroll
        for (int r = 0; r < 16; ++r) o[d][r] = 0.f;
    float m_reg = -1e30f, l_reg = 0.f;
    const bf16_t* kcol = proj + C_LK + h * 128 + hi * 8;
    const bf16_t* vcol = proj + C_LV + h * 128 + (lane >> 5) * 32 + (lane & 3) * 8;
    const int kr = (lane & 31) >> 2;
    for (int tau = 0; tau < 30; ++tau) {
        int ks, dmask, W, kbase;
        if (tau < 5) { ks = 4; dmask = 3; W = 512; kbase = tq0 - 512 + 128 * tau; }
        else if (tau < 22) { ks = 4; dmask = 15; W = 2048; kbase = tq0 - 2048 + 128 * (tau - 5); }
        else { ks = 1; dmask = 0; W = 128; kbase = tq0 - 128 + 32 * (tau - 22); }
        if (kbase + 31 * ks < 0) continue;
        int kp = kbase + ks * r32; kp = kp < 0 ? 0 : (kp > SEQ - 1 ? SEQ - 1 : kp);
        const bf16_t* krow = kcol + (rowb + kp) * INC;
        bf16x8 kf[8];
#pragma unroll
        for (int d0 = 0; d0 < 8; ++d0) kf[d0] = *(const bf16x8*)(krow + d0 * 16);
#pragma unroll
        for (int kg = 0; kg < 4; ++kg) { int vp = kbase + ks * swap23(8 * kg + kr); vp = vp < 0 ? 0 : (vp > SEQ - 1 ? SEQ - 1 : vp);
            const bf16_t* vr = vcol + (rowb + vp) * INC;
            __builtin_amdgcn_global_load_lds((const unsigned*)vr, (LAS unsigned*)(wl + (2 * kg) * 1024), 16, 0, 0);
            __builtin_amdgcn_global_load_lds((const unsigned*)(vr + 64), (LAS unsigned*)(wl + (2 * kg + 1) * 1024), 16, 0, 0); }
        VM_WAIT();
        f32x16 p0, p1;
#pragma unroll
        for (int r = 0; r < 16; ++r) p0[r] = 0.f;
#pragma unroll
        for (int d0 = 0; d0 < 8; ++d0) p0 = __builtin_amdgcn_mfma_f32_32x32x16_bf16(kf[d0], qr[d0], p0, 0, 0, 0);
        { const float NEG = -__builtin_inff(); const int lim = W < tq ? W : tq;
          const int d0v = tq - kbase - ks * 4 * hi;
#pragma unroll
          for (int r = 0; r < 16; ++r) { const int delta = d0v - ks * ((r & 3) + 8 * (r >> 2));
              if ((unsigned)delta > (unsigned)lim || (delta & dmask) != 0) p0[r] = NEG; } }
        float alpha;
        partialSM<1>(p0, p1, m_reg, alpha, C2, SCALE);
        if (__any(alpha < 1.f)) {
#pragma unroll
            for (int d = 0; d < 4; ++d)
#pragma unroll
                for (int r = 0; r < 16; ++r) o[d][r] *= alpha; }
        bf16x8 pa0, pa1, pa2, pa3;
        finishSM<1>(p0, p1, alpha, l_reg, pa0, pa1, pa2, pa3);
        const int vb = (int)(uintptr_t)wl + v_rd_base(lane);
        PV_D0_32(o[0], vb, 0 * 512, 4); PV_D0_32(o[1], vb, 1 * 512, 4); PV_D0_32(o[2], vb, 2 * 512, 4); PV_D0_32(o[3], vb, 3 * 512, 4);
    }
    const float il = __builtin_amdgcn_rcpf(l_reg);
    bf16_t* op = ob + (rowb + tq) * 4096 + 2048 + h * 128 + 8 * hi;
#pragma unroll
    for (int d = 0; d < 4; ++d)
#pragma unroll
        for (int g = 0; g < 4; g += 2)
            store_pair16(op + d * 32 + 8 * g, o[d][4 * g] * il, o[d][4 * g + 1] * il, o[d][4 * g + 2] * il, o[d][4 * g + 3] * il,
                         o[d][4 * g + 4] * il, o[d][4 * g + 5] * il, o[d][4 * g + 6] * il, o[d][4 * g + 7] * il);
}
}
constexpr size_t MiB = 1u << 20;
constexpr size_t WS_CTL = 0, CTL_ZERO_BYTES = 1 * MiB;
constexpr size_t WS_SCAL = 1 * MiB, WS_SLOTA = 116 * MiB, WS_SLOTW = 118 * MiB, WS_CS = 8 * MiB, WS_WR2 = 10 * MiB;
constexpr size_t WS_WIN = 16 * MiB, WS_WMKV = 80 * MiB, WS_WBR = 88 * MiB, WS_WOUT = 104 * MiB, WS_MN = 112 * MiB, WS_KVM = 114 * MiB;
constexpr size_t WS_XN = 128 * MiB, WS_OB = 192 * MiB, WS_MERGED = 320 * MiB, WS_PROJ = 384 * MiB, WS_WGU = 896 * MiB, WS_WD = 1152 * MiB;
constexpr size_t WS_YBUF = 1280 * MiB, WS_XG = 1536 * MiB, WS_ACT = 2560 * MiB, WS_XN8 = 3584 * MiB  , WS_WING8 = 3616 * MiB  , WS_END = 3648 * MiB;
constexpr int CW_QDIFF = 8192, CW_QDIL = 8192 + 512, CW_QMEM = 8192 + 1024  , CW_CNT = 256  , CW_BAR = 4096, CW_JUNK = 3700, CW_KVM = 12288  , CW_QCONV = 12352  ;

#define XB_TMO      128
#define XB_XCNT(j)  (256  + 64 * (j))
#define XB_XSUB(j)  (1280 + 64 * (j))
#define XB_XGEN(j)  (2304 + 64 * (j))
#define XB_TOP      3328
#define XB_TOPGEN   3392
#define XCD_BAR_WORDS 3456
#define XB_SPIN_CAP (1u << 23)
DI unsigned xb_ld(unsigned* p)              { return __hip_atomic_load(p, __ATOMIC_RELAXED, __HIP_MEMORY_SCOPE_AGENT); }
DI unsigned xb_add(unsigned* p, unsigned v) { return __hip_atomic_fetch_add(p, v, __ATOMIC_RELAXED, __HIP_MEMORY_SCOPE_AGENT); }
DI unsigned xb_xcc_id() { return (unsigned)__builtin_amdgcn_s_getreg((3 << 11) | 20) & 0xFu; }
#define XB_SPIN(cond, bar) do { unsigned _sp = 0; while (cond) { __builtin_amdgcn_s_sleep(1); \
    if ((++_sp & 255u) == 0u) { if (xb_ld(&(bar)[XB_TMO])) break; if (_sp > XB_SPIN_CAP) { atomicAdd(&(bar)[XB_TMO], 1u); break; } } } } while (0)
struct XcdBarrier { unsigned* bar; unsigned x; volatile LAS unsigned* st; };
DI XcdBarrier xcd_barrier_post(unsigned* bar, volatile LAS unsigned* st) {
    XcdBarrier b; b.bar = bar; b.x = xb_xcc_id(); b.st = st;
    if (threadIdx.x == 0) (void)xb_add(&bar[XB_XCNT(b.x)], 1u);
    return b;
}
DI void xcd_barrier_complete(unsigned* bar, unsigned x, unsigned& nloc, unsigned& nx) {
    const unsigned G = gridDim.x * gridDim.y * gridDim.z;
    unsigned sum, cnt, mine, sp = 0u;
    for (;;) {
        sum = 0u; cnt = 0u; mine = 0u;
#pragma unroll
        for (unsigned j = 0; j < 16; ++j) { const unsigned c = xb_ld(&bar[XB_XCNT(j)]); sum += c; cnt += (c > 0u) ? 1u : 0u; mine = (j == x) ? c : mine; }
        if (sum == G) break;
        __builtin_amdgcn_s_sleep(1);
        if ((++sp & 255u) == 0u) { if (xb_ld(&bar[XB_TMO])) break; if (sp > XB_SPIN_CAP) { atomicAdd(&bar[XB_TMO], 1u); break; } }
    }
    nloc = mine > 0u ? mine : 1u; nx = cnt > 0u ? cnt : 1u;
}
DI void xcd_barrier(const XcdBarrier& b) {
    asm volatile("s_waitcnt vmcnt(0)" ::: "memory");
    __syncthreads();
    if (threadIdx.x == 0) {
        unsigned* bar = b.bar;
        __builtin_amdgcn_s_waitcnt(0);
        unsigned nloc = b.st[0], nx = b.st[1];
        if (nloc == 0u) { xcd_barrier_complete(bar, b.x, nloc, nx); b.st[0] = nloc; b.st[1] = nx; }
        const unsigned old = xb_add(&bar[XB_XSUB(b.x)], 1u);
        const unsigned gen = old / nloc;
        if (old + 1u == (gen + 1u) * nloc) {
            __builtin_amdgcn_fence(__ATOMIC_RELEASE, "agent");
            asm volatile("s_waitcnt vmcnt(0)" ::: "memory");
            const unsigned og = xb_add(&bar[XB_TOP], 1u);
            const unsigned tg = og / nx;
            if (og + 1u == (tg + 1u) * nx) xb_add(&bar[XB_TOPGEN], 1u);
            else XB_SPIN(xb_ld(&bar[XB_TOPGEN]) == tg, bar);
            __builtin_amdgcn_fence(__ATOMIC_ACQUIRE, "agent");
            xb_add(&bar[XB_XGEN(b.x)], 1u);
            asm volatile("s_waitcnt vmcnt(0)" ::: "memory");
        } else {
            XB_SPIN(xb_ld(&bar[XB_XGEN(b.x)]) == gen, bar);
            __builtin_amdgcn_fence(__ATOMIC_ACQUIRE, "agent");
            asm volatile("s_waitcnt vmcnt(0)" ::: "memory");
        }
    }
    __syncthreads();
}

__device__ const double ROPE_REV[16] = {0.15915494309189535, 0.0700865215877985, 0.03086376340470123, 0.013591370636193905, 0.005985185712713705, 0.002635675898667414, 0.001160663641240061, 0.0005111175045375439, 0.00022507907903927653, 9.911730936901935e-05, 4.364795279280289e-05, 1.9221100684944863e-05, 8.464330808241401e-06, 3.727408601915352e-06, 1.6414262627950345e-06, 7.228293068832865e-07};

DI void t16_load(f32x4 (&v)[16], const float* src, int ldw) {
#pragma unroll
    for (int j = 0; j < 16; ++j) v[j] = __builtin_nontemporal_load((const f32x4*)(src + (size_t)(8 * (j >> 1) + (j & 1)) * ldw));
}
DI void t16_store(const f32x4 (&v)[16], bf16_t* dst, int ldt, LAS unsigned* scr, int lane) {
    const int l15 = lane & 15, l4 = lane >> 4;
#pragma unroll
    for (int jj = 0; jj < 8; ++jj) { const int kp = 4 * jj + l4;
#pragma unroll
        for (int i = 0; i < 4; ++i) scr[(4 * l15 + i) * 33 + kp] = cvt_pk_bf16(v[2 * jj][i], v[2 * jj + 1][i]); }
    LDS_WAIT(); asm volatile("" ::: "memory");
    const int ch = lane & 7, nr = lane >> 3;
#pragma unroll
    for (int i = 0; i < 8; ++i) { const int n = 8 * i + nr; const LAS unsigned* s = scr + n * 33 + 4 * ch; u32x4 w; w.x = s[0]; w.y = s[1]; w.z = s[2]; w.w = s[3];
        *(u32x4*)(dst + (size_t)n * ldt + 8 * ch) = w; }
    LDS_WAIT(); asm volatile("" ::: "memory");
}
DI void f8_decode(int r, const float* wgu, const float* wd, const float* wing, unsigned char* WguT, unsigned char* WdT, unsigned char* WinG8, int lane, const float*& src, unsigned char*& dst, int& ldw) {
    const int l7 = lane & 7, l8 = lane >> 3;
    if (r >= 98304) { r -= 98304; const int k0 = (r / 288) * 128, g = r % 288; ldw = INC;
        const int n0 = g < 64 ? C_DV + 32 * g : (g < 96 ? C_LV + 32 * (g - 64) : C_G + 32 * (g - 96));
        src = wing + (size_t)(k0 + 4 * l8) * INC + n0 + 4 * l7; dst = WinG8 + (size_t)n0 * 2048 + k0; }
    else if (r < 65536) { const int e = r >> 11, q = r & 2047, k0 = (q >> 7) * 128, n0 = (q & 127) * 32; ldw = 4096;
        src = wgu + (size_t)e * 2048 * 4096 + (size_t)(k0 + 4 * l8) * 4096 + n0 + 4 * l7; dst = WguT + (size_t)e * 4096 * 2048 + (size_t)n0 * 2048 + k0; }
    else { r -= 65536; const int e = r >> 10, q = r & 1023, k0 = (q >> 6) * 128, n0 = (q & 63) * 32; ldw = 2048;
        src = wd + (size_t)e * 2048 * 2048 + (size_t)(k0 + 4 * l8) * 2048 + n0 + 4 * l7; dst = WdT + (size_t)e * 2048 * 2048 + (size_t)n0 * 2048 + k0; }
}
DI void f8_load(f32x4 (&v)[16], const float* src, int ldw) {
#pragma unroll
    for (int j = 0; j < 16; ++j) v[j] = __builtin_nontemporal_load((const f32x4*)(src + (size_t)(32 * (j >> 2) + (j & 3)) * ldw));
}
DI void f8_store(const f32x4 (&v)[16], unsigned char* dst, LAS unsigned* scr, int lane) {
    const int l7 = lane & 7, l8 = lane >> 3; constexpr float SC = (float)(1 << pg8::WSH);
#pragma unroll
    for (int jj = 0; jj < 4; ++jj) { const int kq = 8 * jj + l8;
#pragma unroll
        for (int i = 0; i < 4; ++i) scr[(4 * l7 + i) * 33 + kq] = pack4_fp8(v[4 * jj][i] * SC, v[4 * jj + 1][i] * SC, v[4 * jj + 2][i] * SC, v[4 * jj + 3][i] * SC); }
    LDS_WAIT(); asm volatile("" ::: "memory");
    const int ch = lane & 7, nr = lane >> 3;
#pragma unroll
    for (int i = 0; i < 4; ++i) { const int n = 8 * i + nr; const LAS unsigned* s = scr + n * 33 + 4 * ch; u32x4 w; w.x = s[0]; w.y = s[1]; w.z = s[2]; w.w = s[3];
        __builtin_nontemporal_store(w, (u32x4*)(dst + (size_t)n * 2048 + 16 * ch)); }
    LDS_WAIT(); asm volatile("" ::: "memory");
}
template <int NR, bool F8 = false>
DI void rms_rows_to_bf16(const float* xrow, size_t rs, const float* gain, bf16_t* orow, size_t os, int lane, unsigned char* orow8 = nullptr) {
    const f32x4* gr = (const f32x4*)gain + lane;
    f32x4 v[NR][8];
#pragma unroll
    for (int q = 0; q < NR; ++q) { const f32x4* xr = (const f32x4*)(xrow + q * rs) + lane;
#pragma unroll
        for (int j = 0; j < 8; ++j) v[q][j] = __builtin_nontemporal_load(xr + 64 * j); }
#pragma unroll
    for (int q = 0; q < NR; ++q) { float s = 0.f;
#pragma unroll
        for (int j = 0; j < 8; ++j) s += (v[q][j][0] * v[q][j][0] + v[q][j][1] * v[q][j][1]) + (v[q][j][2] * v[q][j][2] + v[q][j][3] * v[q][j][3]);
        const float rstd = __builtin_amdgcn_rsqf(wave_sum(s) * (1.f / 2048.f) + EPS);
        u32x2* o8 = (u32x2*)(orow + q * os) + lane;
#pragma unroll
        for (int j = 0; j < 8; ++j) { const f32x4 g = gr[64 * j]; const float a = v[q][j][0] * rstd * g[0], b = v[q][j][1] * rstd * g[1], c = v[q][j][2] * rstd * g[2], d = v[q][j][3] * rstd * g[3];
            u32x2 w; w.x = cvt_pk_bf16(a, b); w.y = cvt_pk_bf16(c, d); o8[64 * j] = w;
            if (F8) ((unsigned*)(orow8 + q * os) + lane)[64 * j] = pack4_fp8(a, b, c, d); } }
}
enum { I_X = 0, I_MEM, I_POS, I_GMIX, I_WIN, I_BGATE, I_DQN, I_DKN, I_DLAM, I_SUBLN, I_LQN, I_LKN, I_GMEM, I_WMKV, I_MQN, I_MKN, I_WBD, I_WBL, I_WBM, I_WOUT, I_GFFN, I_WR, I_BR, I_WGU, I_BGU, I_WD, I_BD, N_IN };
constexpr int N_PHASES = 9;
struct Args { const void* in[N_IN]; float* out; unsigned char* ws; int ph_lo, ph_hi; int use_bar, pad; };

DI int moe_tables(const unsigned* ctl, LAS int* tab  , int tid) {
    if (tid < 64) { const int e = tid & 31; const unsigned c = __hip_atomic_load(ctl + CW_CNT + 64 * e, __ATOMIC_RELAXED, __HIP_MEMORY_SCOPE_AGENT); int n = (int)((c + 255u) >> 8), s = n;
#pragma unroll
        for (int o = 1; o < 32; o <<= 1) { const int t = __shfl_up(s, o, 32); if ((tid & 31) >= o) s += t; }
        if (tid < 32) { tab[300 + tid + 1] = s; tab[340 + tid] = (int)c; if (tid == 0) tab[300] = 0; } }
    __syncthreads();
    const int nrb = tab[332];
    for (int rb = tid; rb < nrb; rb += NTHR) { int e = 0;
#pragma unroll 1
        for (int k = 1; k < 32; ++k) if (rb >= tab[300 + k]) e = k;
        tab[rb] = e; }
    __syncthreads();
    return nrb;
}

__global__ void __launch_bounds__(NTHR, 2) fwd(Args args) {
    extern __shared__ __attribute__((aligned(16))) unsigned char lds_raw[];
    LAS unsigned char* lds = (LAS unsigned char*)lds_raw;
    volatile LAS unsigned* MISC = (volatile LAS unsigned*)(lds + MISC_OFF);
    const int G = gridDim.x, bx = blockIdx.x, NGW = G * NWAVES;
#define LANE_CONSTS() int tid_ = threadIdx.x; asm volatile("" : "+v"(tid_)); const int tid = tid_, lane = tid & 63, wave = __builtin_amdgcn_readfirstlane(tid >> 6), gw = bx * NWAVES + wave; (void)lane; (void)gw
    unsigned char* ws = args.ws;
    unsigned* ctl = (unsigned*)(ws + WS_CTL);
    if (threadIdx.x < 32) MISC[threadIdx.x] = 0u;
    __syncthreads();
    XcdBarrier bar; bar.bar = ctl + CW_BAR; bar.x = 0; bar.st = nullptr;
    if (args.use_bar) bar = xcd_barrier_post(ctl + CW_BAR, MISC + 8);
    const int lo = args.ph_lo, hi = args.ph_hi;
#ifndef PHASE_MASK
#define PHASE_MASK 0x1ff
#endif
#define IN(k) (((PHASE_MASK >> (k)) & 1) && lo <= (k) && (k) < hi)
#define SEAM(k) do { if (IN(k) && IN((k) + 1)) xcd_barrier(bar); } while (0)

    const float* x = (const float*)args.in[I_X];
    bf16_t* WinT = (bf16_t*)(ws + WS_WIN); bf16_t* WmkvT = (bf16_t*)(ws + WS_WMKV); bf16_t* WbrT = (bf16_t*)(ws + WS_WBR); bf16_t* WoutT = (bf16_t*)(ws + WS_WOUT);
    unsigned char* WguT = ws + WS_WGU; unsigned char* WdT = ws + WS_WD;
    unsigned char* XN8 = ws + WS_XN8; unsigned char* WinG8 = ws + WS_WING8;
    bf16_t* XN = (bf16_t*)(ws + WS_XN); bf16_t* MN = (bf16_t*)(ws + WS_MN); bf16_t* KVM = (bf16_t*)(ws + WS_KVM); bf16_t* PROJ = (bf16_t*)(ws + WS_PROJ);
    bf16_t* OB = (bf16_t*)(ws + WS_OB); bf16_t* MERGED = (bf16_t*)(ws + WS_MERGED); unsigned char* XG = ws + WS_XG; unsigned char* ACT = ws + WS_ACT;
    bf16_t* YBUF = (bf16_t*)(ws + WS_YBUF);
    float* CS = (float*)(ws + WS_CS); float* WR2 = (float*)(ws + WS_WR2); float* SCAL = (float*)(ws + WS_SCAL);
    int* SLOTA = (int*)(ws + WS_SLOTA); float* SLOTW = (float*)(ws + WS_SLOTW);
    float* X1 = args.out;

    if (IN(0)) { LANE_CONSTS();
        LAS unsigned* scr = (LAS unsigned*)(lds + RING_OFF + wave * 16384);
        constexpr int I_IN = 32 * 112  , I_MKV = 32 * 32, I_BD = 32 * 32, I_BL = 16 * 32, I_BM = 16 * 32, I_OUT = 32 * 32, I_GU = 32 * 32 * 64, I_DN = 32 * 32 * 32;
        constexpr int NITEMS = I_IN + I_MKV + I_BD + I_BL + I_BM + I_OUT;
        {
            auto dec = [&](int r, const float*& src, int& ldw, bf16_t*& dst, int& ldt) {
                const float* W; bf16_t* WT; int k0, n0, ko = 0;
                if (r < I_IN) { W = (const float*)args.in[I_WIN]; ldw = INC; WT = WinT; ldt = DM; k0 = (r / 112) * 64; const int j = r % 112; n0 = j < 64 ? 64 * j : (j < 96 ? C_LQ + 64 * (j - 64) : C_MQ + 64 * (j - 96)); }
                else { r -= I_IN; k0 = ((r & 1023) >> 5) * 64; n0 = (r & 31) * 64; ldw = 2048;
                    if (r < 1024) { W = (const float*)args.in[I_WMKV]; WT = WmkvT; ldt = DM; }
                    else if (r < 2048) { W = (const float*)args.in[I_WBD]; WT = WbrT; ldt = 4096; }
                    else if (r < 2560) { W = (const float*)args.in[I_WBL]; WT = WbrT; ldt = 4096; ko = 2048; }
                    else if (r < 3072) { W = (const float*)args.in[I_WBM]; WT = WbrT; ldt = 4096; ko = 3072; k0 = (((r - 2560) & 511) >> 5) * 64; }
                    else { W = (const float*)args.in[I_WOUT]; WT = WoutT; ldt = DM; } }
                src = W + (size_t)(k0 + 2 * (lane >> 4)) * ldw + n0 + 4 * (lane & 15); dst = WT + (size_t)n0 * ldt + ko + k0; };
            f32x4 va[16], vb[16]; const float* s; int ldw, lta = 0, ltb = 0; bf16_t* da = nullptr; bf16_t* db = nullptr;
            int r = gw;
            if (r < NITEMS) { dec(r, s, ldw, da, lta); t16_load(va, s, ldw); }
            if (r + NGW < NITEMS) { dec(r + NGW, s, ldw, db, ltb); t16_load(vb, s, ldw); }
            while (r < NITEMS) {
                t16_store(va, da, lta, scr, lane);
                if (r + 2 * NGW < NITEMS) { dec(r + 2 * NGW, s, ldw, da, lta); t16_load(va, s, ldw); }
                if (r + NGW >= NITEMS) break;
                t16_store(vb, db, ltb, scr, lane);
                if (r + 3 * NGW < NITEMS) { dec(r + 3 * NGW, s, ldw, db, ltb); t16_load(vb, s, ldw); }
                r += 2 * NGW;
            }
        }
        {
            const float* wgu = (const float*)args.in[I_WGU]; const float* wd = (const float*)args.in[I_WD];
            constexpr int F8_LO = I_GU + I_DN, NF8 = I_GU + I_DN + 16 * 288;
            const float* wing = (const float*)args.in[I_WIN];
            f32x4 va[16], vb[16]; const float* s; int ldw; unsigned char* da = nullptr; unsigned char* db = nullptr;
            int r = F8_LO + gw;
            if (r < NF8) { f8_decode(r, wgu, wd, wing, WguT, WdT, WinG8, lane, s, da, ldw); f8_load(va, s, ldw); }
            if (r + NGW < NF8) { f8_decode(r + NGW, wgu, wd, wing, WguT, WdT, WinG8, lane, s, db, ldw); f8_load(vb, s, ldw); }
            while (r < NF8) {
                f8_store(va, da, scr, lane);
                if (r + 2 * NGW < NF8) { f8_decode(r + 2 * NGW, wgu, wd, wing, WguT, WdT, WinG8, lane, s, da, ldw); f8_load(va, s, ldw); }
                if (r + NGW >= NF8) break;
                f8_store(vb, db, scr, lane);
                if (r + 3 * NGW < NF8) { f8_decode(r + 3 * NGW, wgu, wd, wing, WguT, WdT, WinG8, lane, s, db, ldw); f8_load(vb, s, ldw); }
                r += 2 * NGW;
            }
        }
        for (int m = gw; m < T; m += 2 * NGW) {
            if (m + NGW < T) rms_rows_to_bf16<2, true>(x + (size_t)m * DM, (size_t)NGW * DM, (const float*)args.in[I_GMIX], XN + (size_t)m * DM, (size_t)NGW * DM, lane, XN8 + (size_t)m * DM);
            else rms_rows_to_bf16<1, true>(x + (size_t)m * DM, 0, (const float*)args.in[I_GMIX], XN + (size_t)m * DM, 0, lane, XN8 + (size_t)m * DM); }
        for (int m = gw; m < TM; m += NGW) rms_rows_to_bf16<1>((const float*)args.in[I_MEM] + (size_t)m * DM, 0, (const float*)args.in[I_GMEM], MN + (size_t)m * DM, 0, lane);
        { const int* pos = (const int*)args.in[I_POS];
          for (int i = bx * NTHR + tid; i < T * 16; i += G * NTHR) { const int tok = i >> 4, f = i & 15; const double rev = (double)pos[tok] * ROPE_REV[f]; const float fr_ = (float)(rev - __builtin_floor(rev));
              CS[(size_t)tok * 32 + f] = __builtin_amdgcn_cosf(fr_); CS[(size_t)tok * 32 + 16 + f] = __builtin_amdgcn_sinf(fr_); } }
        for (int i = bx * NTHR + tid; i < PSLOTS; i += G * NTHR) SLOTA[i] = -1;
        { const float* wr = (const float*)args.in[I_WR]; const float* gf = (const float*)args.in[I_GFFN];
          for (int i = bx * NTHR + tid; i < 2048 * 32; i += G * NTHR) WR2[i] = wr[i] * gf[i >> 5]; }
        if (bx == 1 && tid < 128) { SCAL[1024 + tid] = ((const float*)args.in[I_DQN])[tid]; SCAL[1024 + 128 + tid] = ((const float*)args.in[I_DKN])[tid];
            SCAL[1024 + 256 + tid] = ((const float*)args.in[I_LQN])[tid]; SCAL[1024 + 384 + tid] = ((const float*)args.in[I_LKN])[tid]; }
        if (bx == 0 && wave == 0) { const float* lp = (const float*)args.in[I_DLAM];
            const float s1 = wave_sum(lp[lane] * lp[128 + lane] + lp[64 + lane] * lp[192 + lane]), s2 = wave_sum(lp[256 + lane] * lp[384 + lane] + lp[320 + lane] * lp[448 + lane]);
            if (lane == 0) SCAL[0] = __expf(s1) - __expf(s2) + LAM_INIT; }
    }
    SEAM(0);

    if (IN(1)) {
        EpiProj<1> E1; E1.out = PROJ; E1.ldc = INC; E1.memkv = 0; E1.gt = SCAL + 1024;
        E1.gmq = (const float*)args.in[I_MQN]; E1.gmk = (const float*)args.in[I_MKN]; E1.bgate = (const float*)args.in[I_BGATE]; E1.cs = CS; E1.P = (LAS float*)(lds + EPIP_OFF);
        SchedGrid S; S.A = (const char*)XN; S.B = (const char*)WinT; S.nM = 64; S.nt = 32; S.G = G; S.c = bx; S.astep = (size_t)256 * DM * 2; S.bstep = (size_t)256 * DM * 2;
        S.nN = 24; S.pn_a = 16; S.pn_skip = 8; S.pn0 = 0;
        pg8::gemm_phase<EpiProj<1>, SchedGrid>(lds + RING_OFF, DM, DM, (size_t)128 * DM * 2, S, E1);
        EpiProj<0> E0; E0.out = PROJ; E0.ldc = INC; E0.memkv = 0; E0.gt = E1.gt; E0.gmq = E1.gmq; E0.gmk = E1.gmk; E0.bgate = E1.bgate; E0.cs = CS; E0.P = E1.P;
        S.nN = 12; S.pn_a = 8; S.pn_skip = 8; S.pn0 = 16;
        { SchedGrid S8 = S; S8.A = (const char*)XN8; S8.B = (const char*)WinG8; S8.nt = 16; S8.astep = (size_t)256 * DM; S8.bstep = (size_t)256 * DM;
          pg8::gemm_phase<EpiProj<0>, SchedGrid, true>(lds + RING_OFF, DM / 2, DM / 2, (size_t)128 * DM, S8, E0); }
        EpiProj<2> E2; E2.out = PROJ; E2.ldc = INC; E2.memkv = 0; E2.gt = E1.gt; E2.gmq = E1.gmq; E2.gmk = E1.gmk; E2.bgate = E1.bgate; E2.cs = CS; E2.P = E1.P;
        S.nN = 4; S.pn_a = 4; S.pn_skip = 0; S.pn0 = 36;
        pg8::gemm_phase<EpiProj<2>, SchedGrid>(lds + RING_OFF, DM, DM, (size_t)128 * DM * 2, S, E2);
        EpiProj<3> E3; E3.out = PROJ; E3.ldc = INC; E3.memkv = 0; E3.gt = E1.gt; E3.gmq = E1.gmq; E3.gmk = E1.gmk; E3.bgate = E1.bgate; E3.cs = CS; E3.P = E1.P;
        S.nN = 24; S.pn_a = 24; S.pn_skip = 0; S.pn0 = 40;
        { SchedGrid S8 = S; S8.A = (const char*)XN8; S8.B = (const char*)WinG8; S8.nt = 16; S8.astep = (size_t)256 * DM; S8.bstep = (size_t)256 * DM;
          pg8::gemm_phase<EpiProj<3>, SchedGrid, true>(lds + RING_OFF, DM / 2, DM / 2, (size_t)128 * DM, S8, E3); }
    }
    SEAM(1);

    if (IN(2)) { LANE_CONSTS(); constexpr int qo = 0;
        const float lam = SCAL[0];
        att::DiffOut dout; dout.ob = OB; dout.subln = (const float*)args.in[I_SUBLN]; dout.lam = lam;
        for (int mu = bx; mu < 16; mu += G) {
            SchedGrid S2; S2.A = (const char*)MN; S2.B = (const char*)WmkvT; S2.nM = 2; S2.nN = 4; S2.nt = 32; S2.G = 1 << 20; S2.c = mu & 7; S2.astep = (size_t)256 * DM * 2; S2.bstep = (size_t)256 * DM * 2;
            S2.pn_a = 4; S2.pn_skip = 0; S2.pn0 = mu < 8 ? 0 : 4;
            if (mu < 8) { EpiProj<2> E2; E2.out = KVM; E2.ldc = 2048; E2.memkv = 1; E2.gt = SCAL + 1024; E2.gmq = (const float*)args.in[I_MQN]; E2.gmk = (const float*)args.in[I_MKN]; E2.bgate = (const float*)args.in[I_BGATE];
                E2.cs = CS; E2.P = (LAS float*)(lds + EPIP_OFF);
                pg8::gemm_phase<EpiProj<2>, SchedGrid>(lds + RING_OFF, DM, DM, (size_t)128 * DM * 2, S2, E2); }
            else { EpiProj<0> E0; E0.out = KVM; E0.ldc = 2048; E0.memkv = 1; E0.gt = SCAL + 1024; E0.gmq = (const float*)args.in[I_MQN]; E0.gmk = (const float*)args.in[I_MKN]; E0.bgate = (const float*)args.in[I_BGATE];
                E0.cs = CS; E0.P = (LAS float*)(lds + EPIP_OFF);
                pg8::gemm_phase<EpiProj<0>, SchedGrid>(lds + RING_OFF, DM, DM, (size_t)128 * DM * 2, S2, E0); }
            if (threadIdx.x == 0) { __builtin_amdgcn_fence(__ATOMIC_RELEASE, "agent"); asm volatile("s_waitcnt vmcnt(0)" ::: "memory"); (void)xb_add(ctl + CW_KVM + qo, 1u); }
        }
        const int xcc = (int)(xb_xcc_id() & 7u);
        auto diff_units = [&]() __attribute__((always_inline)) {
            int t_ = threadIdx.x; asm volatile("" : "+v"(t_)); const int tid = t_, lane = t_ & 63, wave = __builtin_amdgcn_readfirstlane(t_ >> 6); (void)tid; (void)lane; (void)wave;
        for (;;) {
            if (tid == 0) { int u = -1;
                for (int kq = 0; kq < 8 && u < 0; ++kq) { const int q = (xcc + kq) & 7; const unsigned v = xb_add(ctl + CW_QDIFF + qo + 64 * q, 1u); if (v < 128u) u = q * 128 + (int)v; }
                MISC[16] = (unsigned)u; }
            __syncthreads(); const int u = (int)MISC[16]; __syncthreads();
            if (u < 0) break;
            const int q = u >> 7, v = u & 127, bh = 2 * q + (v & 1), qb = 63 - (v >> 1), b = bh >> 3, h = bh & 7, s0 = qb * 128;
            att::CoopArgs a; a.q = PROJ + ((size_t)b * SEQ + s0) * INC + C_DQ + h * 256; a.k0 = PROJ + (size_t)b * SEQ * INC + C_DK + h * 256; a.k1 = a.k0 + 128;
            a.v = PROJ + (size_t)b * SEQ * INC + C_DV + h * 256; a.rsq = INC; a.rsk = INC; a.nt = 2 * (qb + 1);
            att::coop_unit<0>((LAS char*)(lds + RING_OFF), a, s0, 1.4426950408889634f * 0.08838834764831845f, 0.08838834764831845f, OB + ((size_t)b * SEQ + s0) * 4096 + h * 256, 4096, dout);
        }
        };
        auto mem_units = [&](int maxn) __attribute__((always_inline)) {
            int t_ = threadIdx.x; asm volatile("" : "+v"(t_)); const int tid = t_, lane = t_ & 63, wave = __builtin_amdgcn_readfirstlane(t_ >> 6); (void)tid; (void)lane; (void)wave;
            if (tid == 0) { XB_SPIN(xb_ld(ctl + CW_KVM + qo) < 16u, ctl + CW_BAR); __builtin_amdgcn_fence(__ATOMIC_ACQUIRE, "agent"); asm volatile("s_waitcnt vmcnt(0)" ::: "memory"); }
            __syncthreads();
            for (int n = 0; n < maxn; ++n) {
                if (tid == 0) { int u = -1;
                    for (int kq = 0; kq < 8 && u < 0; ++kq) { const int q = (xcc + kq) & 7; const unsigned v = xb_add(ctl + CW_QMEM + qo + 64 * q, 1u); if (v < 64u) u = q * 64 + (int)v; }
                    MISC[16] = (unsigned)u; }
                __syncthreads(); const int u = (int)MISC[16]; __syncthreads();
                if (u < 0) break;
                const int q = u >> 6, b = q >> 2, hm = q & 3, qg = b * 64 + (u & 63);
                att::CoopArgs a; a.q = PROJ + (size_t)qg * 128 * INC + C_MQ + hm * 256; a.k0 = KVM + (size_t)b * MEML * 2048 + hm * 256; a.k1 = a.k0 + 128;
                a.v = KVM + (size_t)b * MEML * 2048 + 1024 + hm * 256; a.rsq = INC; a.rsk = 2048; a.nt = 4;
                att::coop_unit<1>((LAS char*)(lds + RING_OFF), a, 0, 1.4426950408889634f * 0.0625f, 0.0625f, OB + (size_t)qg * 128 * 4096 + 3072 + hm * 256, 4096, dout);
            }
        };
        auto stretch = [&]() __attribute__((always_inline)) {
            int t_ = threadIdx.x; asm volatile("" : "+v"(t_)); const int tid = t_, lane = t_ & 63, wave = __builtin_amdgcn_readfirstlane(t_ >> 6); (void)tid; (void)lane; (void)wave;
        {
            const float* wgu = (const float*)args.in[I_WGU]; const float* wd = (const float*)args.in[I_WD];
            LAS unsigned* scr = (LAS unsigned*)(lds + RING_OFF + wave * 16384);
            constexpr int CBN = 16, NBATCH = (32 * 32 * 64 + 32 * 32 * 32) / CBN;
            bool dil_left = true, conv_left = true;
            auto mix_round = [&]() __attribute__((always_inline)) {
                int t_ = threadIdx.x; asm volatile("" : "+v"(t_)); const int lane = t_ & 63; (void)lane;
                if (dil_left) { int wu = -1;
                    if (lane == 0) { for (int kq = 0; kq < 8 && wu < 0; ++kq) { const int q = (xcc + kq) & 7; const unsigned v = xb_add(ctl + CW_QDIL + qo + 64 * q, 1u); if (v < 512u) wu = (2 * q + (int)(v & 1u)) * 256 + (int)(v >> 1); } }
                    wu = __builtin_amdgcn_readfirstlane(wu);
                    if (wu < 0) dil_left = false; else att::dil_wave_unit((LAS char*)scr, PROJ, OB, wu, lane); }
                for (int rep = 0; rep < 2 && conv_left; ++rep) {
                    int cb = 0; if (lane == 0) cb = (int)xb_add(ctl + CW_QCONV + qo, 1u);
                    cb = __builtin_amdgcn_readfirstlane(cb);
                    if (cb >= NBATCH) { conv_left = false; break; }
                    f32x4 va[16], vb[16]; const float* s; int ldw; unsigned char* da = nullptr; unsigned char* db = nullptr;
                    int r = cb * CBN; const int rend = r + CBN;
                    f8_decode(r, wgu, wd, nullptr, WguT, WdT, nullptr, lane, s, da, ldw); f8_load(va, s, ldw);
                    f8_decode(r + 1, wgu, wd, nullptr, WguT, WdT, nullptr, lane, s, db, ldw); f8_load(vb, s, ldw);
                    while (r < rend) {
                        f8_store(va, da, scr, lane);
                        if (r + 2 < rend) { f8_decode(r + 2, wgu, wd, nullptr, WguT, WdT, nullptr, lane, s, da, ldw); f8_load(va, s, ldw); }
                        f8_store(vb, db, scr, lane);
                        if (r + 3 < rend) { f8_decode(r + 3, wgu, wd, nullptr, WguT, WdT, nullptr, lane, s, db, ldw); f8_load(vb, s, ldw); }
                        r += 2;
                    }
                }
            };
#pragma unroll 1
            for (int it = 0; it < 4; ++it) {
                mix_round();
                if (it == (bx & 3)) { __syncthreads(); mem_units(2); __syncthreads(); }
            }
            while (dil_left || conv_left) mix_round();
        }
        __syncthreads();
        mem_units(1 << 30);
        __syncthreads();
        };
        const bool stretch_first = ((bx >> 3) & 3) == 0;
        if (stretch_first) { stretch(); diff_units(); } else { diff_units(); stretch(); }
    }
    SEAM(2);

    if (IN(3)) {
        EpiBranch E; E.proj = PROJ; E.merged = MERGED;
        SchedBranch S; S.A = (const char*)OB; S.B = (const char*)WbrT; S.G = G; S.c = bx;
        pg8::gemm_phase<EpiBranch, SchedBranch>(lds + RING_OFF, 4096, 4096, (size_t)128 * 4096 * 2, S, E);
    }
    SEAM(3);

    if (IN(4)) {
        EpiOut E; E.x = x; E.x1 = X1;
        SchedGrid S; S.A = (const char*)MERGED; S.B = (const char*)WoutT; S.nM = 64; S.nN = 8; S.nt = 32; S.G = G; S.c = bx; S.astep = (size_t)256 * DM * 2; S.bstep = (size_t)256 * DM * 2; S.pn_a = 8; S.pn_skip = 0; S.pn0 = 0;
        pg8::gemm_phase<EpiOut, SchedGrid>(lds + RING_OFF, DM, DM, (size_t)128 * DM * 2, S, E);
    }
    SEAM(4);

    if (IN(5)) { LANE_CONSTS();
        LAS float* part = (LAS float*)(lds + RING_OFF);
        LAS float* ssp = part + 8 * 32 * 33;
        LAS float* rsd = ssp + 8 * 32;
        LAS unsigned* asl = (LAS unsigned*)(rsd + 32);
        const float* brt = (const float*)args.in[I_BR];
        for (int tt = bx; tt < T / 32; tt += G) {
            const int m = lane & 31, kh = lane >> 5; const size_t tok = (size_t)tt * 32 + m;
            const float* xr = X1 + tok * DM + wave * 256 + 4 * kh; const float* wp = WR2 + (wave * 256 + 4 * kh) * 32 + m;
            f32x16 acc;
#pragma unroll
            for (int r = 0; r < 16; ++r) acc[r] = 0.f;
            float ss = 0.f;
#pragma unroll 8
            for (int c = 0; c < 32; ++c) { const f32x4 xv = *(const f32x4*)(xr + 8 * c); ss += (xv[0] * xv[0] + xv[1] * xv[1]) + (xv[2] * xv[2] + xv[3] * xv[3]);
                const float* w = wp + c * 256;
                acc = __builtin_amdgcn_mfma_f32_32x32x2f32(xv[0], w[0], acc, 0, 0, 0); acc = __builtin_amdgcn_mfma_f32_32x32x2f32(xv[1], w[32], acc, 0, 0, 0);
                acc = __builtin_amdgcn_mfma_f32_32x32x2f32(xv[2], w[64], acc, 0, 0, 0); acc = __builtin_amdgcn_mfma_f32_32x32x2f32(xv[3], w[96], acc, 0, 0, 0); }
            ss += __shfl_xor(ss, 32);
#pragma unroll
            for (int r = 0; r < 16; ++r) part[(wave * 32 + (r & 3) + 8 * (r >> 2) + 4 * kh) * 33 + m] = acc[r];
            if (lane < 32) ssp[wave * 32 + m] = ss;
            __syncthreads();
            if (lane < 4) {
                const int tl = wave * 4 + lane; const size_t tk = (size_t)tt * 32 + tl;
                float s2 = 0.f;
#pragma unroll
                for (int w8 = 0; w8 < 8; ++w8) s2 += ssp[w8 * 32 + tl];
                const float rstd = __builtin_amdgcn_rsqf(s2 * (1.f / 2048.f) + EPS);
                float lg[32];
#pragma unroll
                for (int e = 0; e < 32; ++e) { float a = 0.f;
#pragma unroll
                    for (int w8 = 0; w8 < 8; ++w8) a += part[(w8 * 32 + tl) * 33 + e];
                    lg[e] = a * rstd + brt[e]; }
                unsigned chosen = 0u; float tv[4]; int te[4];
#pragma unroll
                for (int kk = 0; kk < 4; ++kk) { float best = -__builtin_inff(); int bi = 0;
#pragma unroll
                    for (int e = 0; e < 32; ++e) { const float v = ((chosen >> e) & 1u) ? -__builtin_inff() : lg[e]; if (v > best) { best = v; bi = e; } }
                    chosen |= 1u << bi; tv[kk] = best; te[kk] = bi; }
                const float e1 = __expf(tv[1] - tv[0]), e2 = __expf(tv[2] - tv[0]), e3 = __expf(tv[3] - tv[0]); const float inv = 1.f / (1.f + e1 + e2 + e3);
                const float wv[4] = {inv, e1 * inv, e2 * inv, e3 * inv};
                rsd[tl] = rstd;
#pragma unroll
                for (int kk = 0; kk < 4; ++kk) { const unsigned pos = xb_add(ctl + CW_CNT + 64 * te[kk], 1u); const unsigned slot = (unsigned)te[kk] * ECAP + pos;
                    SLOTA[slot] = (int)(tk * 4 + kk); SLOTW[slot] = wv[kk]; asl[tl * 4 + kk] = slot; }
            }
            LDS_WAIT(); asm volatile("" ::: "memory");
            {
                const f32x4* gr = (const f32x4*)args.in[I_GFFN] + lane;
#pragma unroll 1
                for (int q = 0; q < 4; ++q) { const int tl = wave * 4 + q; const size_t tk = (size_t)tt * 32 + tl; const float rstd = rsd[tl];
                    const f32x4* xq = (const f32x4*)(X1 + tk * DM) + lane; unsigned w8[8];
#pragma unroll
                    for (int j = 0; j < 8; ++j) { const f32x4 v = xq[64 * j], g = gr[64 * j]; w8[j] = pack4_fp8(v[0] * rstd * g[0], v[1] * rstd * g[1], v[2] * rstd * g[2], v[3] * rstd * g[3]); }
#pragma unroll
                    for (int kk = 0; kk < 4; ++kk) { unsigned* o4 = (unsigned*)(XG + (size_t)asl[tl * 4 + kk] * DM) + lane;
#pragma unroll
                        for (int j = 0; j < 8; ++j) o4[64 * j] = w8[j]; } }
            }
            __syncthreads();
        }
    }
    SEAM(5);

    if (IN(6)) { LANE_CONSTS();
        LAS int* tab = (LAS int*)(lds + TAB_OFF);
        const int nrb = moe_tables(ctl, tab, tid);
        EpiSwiglu E; E.bgu = (const float*)args.in[I_BGU]; E.act = ACT;
        SchedMoE S; S.A = (const char*)XG; S.B = (const char*)WguT; S.rb2e = tab; S.nrb = nrb; S.NPN = 16; S.G = G; S.c = bx; S.nt = 16; S.apan = (size_t)256 * 2048; S.bexp = (size_t)4096 * 2048; S.bpn = (size_t)128 * 2048;
        pg8::gemm_phase<EpiSwiglu, SchedMoE, true>(lds + RING_OFF, 1024, 1024, (size_t)2048 * 2048, S, E);
    }
    SEAM(6);

    if (IN(7)) { LANE_CONSTS();
        LAS int* tab = (LAS int*)(lds + TAB_OFF);
        const int nrb = moe_tables(ctl, tab, tid);
        EpiDown E; E.bd = (const float*)args.in[I_BD]; E.slot_asg = SLOTA; E.slot_w = SLOTW; E.ybuf = YBUF;
        SchedMoE S; S.A = (const char*)ACT; S.B = (const char*)WdT; S.rb2e = tab; S.nrb = nrb; S.NPN = 8; S.G = G; S.c = bx; S.nt = 16; S.apan = (size_t)256 * 2048; S.bexp = (size_t)2048 * 2048; S.bpn = (size_t)256 * 2048;
        pg8::gemm_phase<EpiDown, SchedMoE, true>(lds + RING_OFF, 1024, 1024, (size_t)128 * 2048, S, E);
    }
    SEAM(7);

    if (IN(8)) { LANE_CONSTS();
        for (size_t i = (size_t)bx * NTHR + tid; i < (size_t)T * 256; i += (size_t)G * NTHR) {
            const size_t t = i >> 8; const int c8 = (int)(i & 255) * 8;
            f32x4 a0 = *(const f32x4*)(X1 + t * DM + c8), a1 = *(const f32x4*)(X1 + t * DM + c8 + 4);
#pragma unroll
            for (int k = 0; k < 4; ++k)
            { const u32x4 y = *(const u32x4*)(YBUF + (t * 4 + k) * DM + c8);
                a0[0] += bf_lo(y.x); a0[1] += bf_hi(y.x); a0[2] += bf_lo(y.y); a0[3] += bf_hi(y.y); a1[0] += bf_lo(y.z); a1[1] += bf_hi(y.z); a1[2] += bf_lo(y.w); a1[3] += bf_hi(y.w); }
            *(f32x4*)(X1 + t * DM + c8) = a0; *(f32x4*)(X1 + t * DM + c8 + 4) = a1;
        }
    }
#undef IN
#undef SEAM
}

#ifndef MK_N_LAUNCHES
#define MK_N_LAUNCHES 1
#endif
extern "C" void kernel_launch(void* const* d_in, const int* in_sizes, int n_in, void* d_out, int out_size, void* d_ws, size_t ws_size, hipStream_t stream) {
    static int grid = 0;
    if (grid == 0) {
        if (n_in != N_IN || out_size != T * DM || ws_size < WS_END) { fprintf(stderr, "kernel_launch: unexpected shapes (n_in %d, out %d, ws %zu)\n", n_in, out_size, ws_size); grid = -1; return; }
        int dev = 0, cus = 0, per_cu = 0;
        if (hipGetDevice(&dev) != hipSuccess || hipDeviceGetAttribute(&cus, hipDeviceAttributeMultiprocessorCount, dev) != hipSuccess) { grid = -1; return; }
        if (hipFuncSetAttribute((const void*)fwd, hipFuncAttributeMaxDynamicSharedMemorySize, LDS_BYTES) != hipSuccess) { fprintf(stderr, "kernel_launch: hipFuncSetAttribute failed\n"); grid = -1; return; }
        if (hipOccupancyMaxActiveBlocksPerMultiprocessor(&per_cu, (const void*)fwd, NTHR, LDS_BYTES) != hipSuccess || per_cu < 1) { fprintf(stderr, "kernel_launch: occupancy query reports %d\n", per_cu); }
        (void)hipGetLastError();
        grid = cus;
    }
    if (grid < 0) return;
    if (hipMemsetAsync((char*)d_ws + WS_CTL, 0, CTL_ZERO_BYTES, stream) != hipSuccess) return;
    Args a{};
    for (int i = 0; i < N_IN; ++i) a.in[i] = d_in[i];
    a.out = (float*)d_out; a.ws = (unsigned char*)d_ws; a.pad = 0;
#if MK_N_LAUNCHES == 1
    a.ph_lo = 0; a.ph_hi = N_PHASES; a.use_bar = 1;
    hipLaunchKernelGGL(fwd, dim3(grid), dim3(NTHR), LDS_BYTES, stream, a);
#else
    for (int p = 0; p < N_PHASES; ++p) { a.ph_lo = p; a.ph_hi = p + 1; a.use_bar = 0; hipLaunchKernelGGL(fwd, dim3(grid), dim3(NTHR), LDS_BYTES, stream, a); }
#endif
}
```

```cpp
#include <hip/hip_runtime.h>
#include <cstdio>
#include <cstdint>
#include <type_traits>

#define GAS __attribute__((address_space(1)))
#define LAS __attribute__((address_space(3)))
typedef unsigned short bf16_t;
typedef short bf16x8 __attribute__((ext_vector_type(8)));
typedef short s16x4 __attribute__((ext_vector_type(4)));
typedef float f32x4 __attribute__((ext_vector_type(4)));
typedef float f32x2 __attribute__((ext_vector_type(2)));
typedef float f32x16 __attribute__((ext_vector_type(16)));
typedef unsigned u32x4 __attribute__((ext_vector_type(4)));
typedef unsigned u32x2 __attribute__((ext_vector_type(2)));
#define DI __device__ __forceinline__
#define VM_WAIT() asm volatile("s_waitcnt vmcnt(0)" ::: "memory")
#define LDS_WAIT() asm volatile("s_waitcnt lgkmcnt(0)" ::: "memory")
#define SBAR() __builtin_amdgcn_sched_barrier(0)

typedef __bf16 bf16x2_t __attribute__((ext_vector_type(2)));
DI unsigned cvt_pk_bf16(float lo, float hi) { const f32x2 v = {lo, hi}; return __builtin_bit_cast(unsigned, __builtin_convertvector(v, bf16x2_t)); }
DI unsigned cvt_pk_bf16_a(float lo, float hi) { unsigned r; asm volatile("s_nop 0\n\tv_cvt_pk_bf16_f32 %0, %1, %2" : "=v"(r) : "v"(lo), "v"(hi)); return r; }
DI float bf_lo(unsigned w) { return __uint_as_float(w << 16); }
DI float bf_hi(unsigned w) { return __uint_as_float(w & 0xffff0000u); }
DI float wave_sum(float v) {
#pragma unroll
    for (int o = 1; o < 64; o <<= 1) v += __shfl_xor(v, o);
    return v;
}

constexpr int BATCH = 2, SEQ = 8192, DM = 2048, T = BATCH * SEQ;
constexpr int MEML = 256, TM = BATCH * MEML;
constexpr int INC = 16384;
constexpr int C_DQ = 0, C_DK = 2048, C_DV = 4096, C_LQ = 6144, C_LK = 7168, C_LV = 8192, C_MQ = 9216, C_G = 10240;
constexpr int NE = 32, TOPK = 4, DFF = 2048;
constexpr int NASG = T * TOPK;
constexpr int ECAP = 16384;
constexpr int PSLOTS = NE * ECAP;
constexpr int MAXRB = PSLOTS / 256;
constexpr float EPS = 1e-6f;
constexpr float LAM_INIT = 0.2f;
constexpr int NWAVES = 8, NTHR = 512;
DI unsigned pack4_fp8(float a, float b, float c, float d) { int w = __builtin_amdgcn_cvt_pk_fp8_f32(a, b, 0, false); w = __builtin_amdgcn_cvt_pk_fp8_f32(c, d, w, true); return (unsigned)w; }
namespace pg8 {
typedef int i32x4 __attribute__((ext_vector_type(4)));
constexpr int WSH = 6; constexpr int WSCALE_E8M0 = (127 - WSH) * 0x01010101;
constexpr int BM = 256, BK = 64, HALF = 128, HTB = HALF * BK * 2  , STAGE_BYTES = 8 * HTB, NXCD = 8, WGM = 8;
__host__ __device__ __forceinline__ int lds_byte(int r, int c) { const int st = (r >> 4) * 2 + (c >> 5), rr = r & 15, cc = c & 31, ob = rr * 64 + cc * 2; return st * 1024 + (ob ^ (((ob >> 9) & 1) << 5)); }
__host__ __device__ __forceinline__ void stage_rc(int b, int& R, int& C) { const int st = b / 1024, sb = b % 1024, swz = sb ^ (((sb >> 9) & 1) << 5); R = (st >> 1) * 16 + swz / 64; C = (st & 1) * 32 + (swz % 64) / 2; }
__host__ __device__ __forceinline__ int perm32(int rho) { const int n = rho >> 4, i = rho & 15; return 8 * (i >> 2) + 4 * n + (i & 3); }

struct GU { const char* A; const char* B; int nt; int pm, pn, tag; int half; };

DI void tile_order(int L, int nM, int nN, int& pm, int& pn) {
    const int nwg = nM * nN; int wgid = L;
    { const int q = nwg / NXCD, r = nwg % NXCD, xcd = wgid % NXCD, off = wgid / NXCD; wgid = (xcd < r ? xcd * (q + 1) : r * (q + 1) + (xcd - r) * q) + off; }
    const int nig = WGM * nN, gid = wgid / nig, fm = gid * WGM, gsz = (nM - fm) < WGM ? (nM - fm) : WGM;
    pm = fm + ((wgid % nig) % gsz); pn = (wgid % nig) / gsz;
}

template <class Epi, class Sched, bool FP8 = false, bool ALIGN_EPI = true, bool SP2 = true>
DI void gemm_phase(LAS unsigned char* lds, const int lda, const int ldb, const size_t hstepB, const Sched& S, const Epi& E) {
    int tid_ = threadIdx.x; asm volatile("" : "+v"(tid_));
    const int tid = tid_, wid = __builtin_amdgcn_readfirstlane(tid >> 6), lane = tid & 63, wr = wid >> 2, wc = (wid + wr) & 3  , fr = lane & 15, fq = lane >> 4;
    unsigned voffA[2], voffB[2];
#pragma unroll
    for (int i = 0; i < 2; ++i) { int R, C; stage_rc(tid * 16 + i * 8192, R, C); const int Rb = Epi::PERM ? ((R & ~31) + perm32(R & 31)) : R;
        voffA[i] = (unsigned)(R * lda + C) * 2u; voffB[i] = (unsigned)(Rb * ldb + C) * 2u; }
    const size_t kstep = (size_t)(BK * 2);
    const size_t hstepA = (size_t)HALF * lda * 2;
    const unsigned ldsw = (unsigned)wid * 1024u;
    const int aoff = lds_byte(wr * 64 + fr, fq * 8), boff = lds_byte(wc * 32 + fr, fq * 8);
#define PG8_SA(b, h) (((b) * 2 + (h)) * HTB)
#define PG8_SB(b, h) ((4 + (b) * 2 + (h)) * HTB)
#define PG8_STAGE(bufoff, gbase, voff) do { _Pragma("unroll") for (int _i = 0; _i < 2; ++_i) \
        __builtin_amdgcn_global_load_lds((const unsigned*)((const char*)(gbase) + (voff)[_i]), (LAS unsigned*)(lds + (bufoff) + ldsw + _i * 8192), 16, 0, 0); } while (0)
#define PG8_LD1(dst, i_, off) do { if constexpr (FP8) { const i32x4 _p0 = *(const LAS i32x4*)(lds + (off)), _p1 = *(const LAS i32x4*)(lds + (off) + 1024); dst##8[i_] = __builtin_shufflevector(_p0, _p1, 0, 1, 2, 3, 4, 5, 6, 7); } \
        else { dst[i_][0] = *(const LAS bf16x8*)(lds + (off)); dst[i_][1] = *(const LAS bf16x8*)(lds + (off) + 1024); } } while (0)
#define PG8_LDA(dst, b, h) do { _Pragma("unroll") for (int m = 0; m < 4; ++m) PG8_LD1(dst, m, PG8_SA(b, h) + aoff + m * 2048); } while (0)
#define PG8_LDB(dst, b, h) do { _Pragma("unroll") for (int n = 0; n < 2; ++n) PG8_LD1(dst, n, PG8_SB(b, h) + boff + n * 2048); } while (0)
#define PG8_CAT(x0, x1) __builtin_shufflevector(__builtin_bit_cast(i32x4, x0), __builtin_bit_cast(i32x4, x1), 0, 1, 2, 3, 4, 5, 6, 7)
#define PG8_MMA(ai, bj, At, Bt) do { __builtin_amdgcn_s_setprio(1); _Pragma("unroll") for (int m = 0; m < 4; ++m) _Pragma("unroll") for (int n = 0; n < 2; ++n) { \
        if constexpr (FP8) asm volatile("v_mfma_scale_f32_16x16x128_f8f6f4 %0, %1, %2, %0, %3, %4 op_sel_hi:[0,0,0]" : "+v"(acc[ai][bj][m][n]) : "v"(Bt##8[n]), "v"(At##8[m]), "v"(wscale), "v"(ascale)); \
        else { _Pragma("unroll") for (int k = 0; k < 2; ++k) acc[ai][bj][m][n] = __builtin_amdgcn_mfma_f32_16x16x32_bf16(Bt[n][k], At[m][k], acc[ai][bj][m][n], 0, 0, 0); } } __builtin_amdgcn_s_setprio(0); } while (0)
#define PG8_WAIT_V(n) asm volatile("s_waitcnt vmcnt(" #n ")" ::: "memory")
#define PG8_WAIT_L(n) asm volatile("s_waitcnt lgkmcnt(" #n ")" ::: "memory")
#define PG8_BAR __builtin_amdgcn_s_barrier()
#define PG8_SCHED __builtin_amdgcn_sched_barrier(0)
    typedef int i32x8 __attribute__((ext_vector_type(8)));
    int wscale = WSCALE_E8M0, ascale = 0x7f7f7f7f; if constexpr (FP8) asm volatile("" : "+v"(wscale), "+v"(ascale));
    GU cur, nxt; int ui = 0;
    if (!S.next(0, cur)) return;
    f32x4 acc[2][2][4][2];
#pragma unroll
    for (int a = 0; a < 2; ++a)
#pragma unroll
        for (int b = 0; b < 2; ++b)
#pragma unroll
            for (int m = 0; m < 4; ++m)
#pragma unroll
                for (int n = 0; n < 2; ++n) acc[a][b][m][n] = (f32x4){0.f, 0.f, 0.f, 0.f};
    bf16x8 At[4][2], B0[2][2], B1[2][2];
    i32x8 At8[4], B08[2], B18[2];
    const char* cA = cur.A; const char* cB = cur.B;
    if constexpr (SP2) {
        PG8_STAGE(PG8_SB(0, 0), cB, voffB); PG8_STAGE(PG8_SB(0, 1), cB + hstepB, voffB); PG8_STAGE(PG8_SA(0, 0), cA, voffA); PG8_STAGE(PG8_SA(0, 1), cA + hstepA, voffA);
        if (wr == 1) PG8_BAR;
        PG8_WAIT_V(2); PG8_BAR;
        PG8_STAGE(PG8_SB(1, 0), cB + kstep, voffB); PG8_STAGE(PG8_SA(1, 0), cA + kstep, voffA); PG8_STAGE(PG8_SB(1, 1), cB + hstepB + kstep, voffB);
        PG8_WAIT_V(6); PG8_BAR;
    } else {
        PG8_STAGE(PG8_SB(0, 0), cB, voffB); PG8_STAGE(PG8_SA(0, 0), cA, voffA); PG8_STAGE(PG8_SB(0, 1), cB + hstepB, voffB); PG8_STAGE(PG8_SA(0, 1), cA + hstepA, voffA);
        if (wr == 1) PG8_BAR;
        PG8_WAIT_V(4); PG8_BAR;
        PG8_STAGE(PG8_SB(1, 0), cB + kstep, voffB); PG8_STAGE(PG8_SA(1, 0), cA + kstep, voffA); PG8_STAGE(PG8_SB(1, 1), cB + hstepB + kstep, voffB);
        PG8_WAIT_V(6); PG8_BAR;
    }
    for (;;) {
        const bool has_next = S.next(ui + 1, nxt);
        const char* nA = has_next ? nxt.A : cA; const char* nB = has_next ? nxt.B : cB;
        const int nt = cur.nt; const bool half1 = FP8 && cur.half != 0;
        for (int t = 0; t < nt; t += 2) {
            const bool last = (t == nt - 2);
            const char* a1 = cA + (size_t)(t + 1) * kstep;
            const char* a2 = last ? nA : cA + (size_t)(t + 2) * kstep; const char* b2 = last ? nB : cB + (size_t)(t + 2) * kstep;
            const char* a3 = a2 + kstep; const char* b3 = b2 + kstep;
            if constexpr (SP2) {
            PG8_LDB(B0, 0, 0); PG8_LDB(B1, 0, 1); PG8_SCHED; PG8_LDA(At, 0, 0); PG8_STAGE(PG8_SA(1, 1), a1 + hstepA, voffA);
            PG8_WAIT_V(8); PG8_WAIT_L(0); PG8_BAR; PG8_MMA(0, 0, At, B0); PG8_MMA(0, 1, At, B1); PG8_BAR; PG8_SCHED;
            if (!half1) PG8_LDA(At, 0, 1); PG8_STAGE(PG8_SB(0, 0), b2, voffB); PG8_STAGE(PG8_SB(0, 1), b2 + hstepB, voffB); PG8_STAGE(PG8_SA(0, 0), a2, voffA);
            PG8_WAIT_V(8); PG8_WAIT_L(0); PG8_BAR; if (!half1) { PG8_MMA(1, 0, At, B0); PG8_MMA(1, 1, At, B1); } PG8_BAR; PG8_SCHED;
            PG8_LDB(B0, 1, 0); PG8_LDB(B1, 1, 1); PG8_SCHED; PG8_LDA(At, 1, 0); PG8_STAGE(PG8_SA(0, 1), a2 + hstepA, voffA);
            PG8_WAIT_V(8); PG8_WAIT_L(0); PG8_BAR; PG8_MMA(0, 0, At, B0); PG8_MMA(0, 1, At, B1); PG8_BAR; PG8_SCHED;
            if (!half1) PG8_LDA(At, 1, 1); PG8_STAGE(PG8_SB(1, 0), b3, voffB); PG8_STAGE(PG8_SB(1, 1), b3 + hstepB, voffB); PG8_STAGE(PG8_SA(1, 0), a3, voffA);
            PG8_WAIT_V(8); PG8_WAIT_L(0); PG8_BAR; if (!half1) { PG8_MMA(1, 0, At, B0); PG8_MMA(1, 1, At, B1); } PG8_BAR; PG8_SCHED;
            } else {
            PG8_LDB(B0, 0, 0); PG8_SCHED; PG8_LDA(At, 0, 0); PG8_STAGE(PG8_SA(1, 1), a1 + hstepA, voffA);
            PG8_WAIT_L(8); PG8_BAR; PG8_WAIT_L(0); PG8_MMA(0, 0, At, B0); PG8_BAR; PG8_SCHED;
            PG8_LDB(B1, 0, 1); PG8_STAGE(PG8_SB(0, 0), b2, voffB);
            PG8_BAR; PG8_WAIT_L(0); PG8_MMA(0, 1, At, B1); PG8_BAR;
            PG8_LDA(At, 0, 1); PG8_STAGE(PG8_SA(0, 0), a2, voffA);
            PG8_BAR; PG8_WAIT_L(0); PG8_MMA(1, 0, At, B0); PG8_BAR; PG8_SCHED;
            PG8_STAGE(PG8_SB(0, 1), b2 + hstepB, voffB);
            PG8_WAIT_V(6); PG8_BAR; PG8_MMA(1, 1, At, B1); PG8_BAR;
            PG8_LDB(B0, 1, 0); PG8_SCHED; PG8_LDA(At, 1, 0); PG8_STAGE(PG8_SA(0, 1), a2 + hstepA, voffA);
            PG8_WAIT_L(8); PG8_BAR; PG8_WAIT_L(0); PG8_MMA(0, 0, At, B0); PG8_BAR; PG8_SCHED;
            PG8_LDB(B1, 1, 1); PG8_STAGE(PG8_SB(1, 0), b3, voffB);
            PG8_BAR; PG8_WAIT_L(0); PG8_MMA(0, 1, At, B1); PG8_BAR;
            PG8_LDA(At, 1, 1); PG8_STAGE(PG8_SA(1, 0), a3, voffA);
            PG8_BAR; PG8_WAIT_L(0); PG8_MMA(1, 0, At, B0); PG8_BAR; PG8_SCHED;
            PG8_STAGE(PG8_SB(1, 1), b3 + hstepB, voffB);
            PG8_WAIT_V(6); PG8_BAR; PG8_MMA(1, 1, At, B1); PG8_BAR;
            }
        }
        if constexpr (ALIGN_EPI) { if (wr == 0) PG8_BAR; }
        if constexpr (FP8) {
            asm volatile("s_nop 15\n\ts_nop 15" ::: "memory");
#pragma unroll
            for (int a = 0; a < 2; ++a)
#pragma unroll
                for (int b = 0; b < 2; ++b)
#pragma unroll
                    for (int m = 0; m < 4; ++m)
#pragma unroll
                        for (int n = 0; n < 2; ++n) asm volatile("" : "+v"(acc[a][b][m][n]));
        }
        const bool keep = E(acc, cur, wr, wc, fr, fq);
        if (!has_next) break;
        if (!keep) {
#pragma unroll
            for (int a = 0; a < 2; ++a)
#pragma unroll
                for (int b = 0; b < 2; ++b)
#pragma unroll
                    for (int m = 0; m < 4; ++m)
#pragma unroll
                        for (int n = 0; n < 2; ++n) acc[a][b][m][n] = (f32x4){0.f, 0.f, 0.f, 0.f};
        }
        cur = nxt; cA = nA; cB = nB; ++ui;
        if constexpr (ALIGN_EPI) { if (wr == 1) PG8_BAR; }
    }
    PG8_WAIT_V(0);
    if constexpr (!ALIGN_EPI) { if (wr == 0) PG8_BAR; }
    PG8_BAR;
#undef PG8_SA
#undef PG8_SB
#undef PG8_STAGE
#undef PG8_LD1
#undef PG8_LDA
#undef PG8_LDB
#undef PG8_MMA
#undef PG8_CAT
#undef PG8_WAIT_V
#undef PG8_WAIT_L
#undef PG8_BAR
#undef PG8_SCHED
}
}
constexpr int RING_OFF = 0, RING_BYTES = 131072;
constexpr int EPIP_OFF = RING_BYTES;
constexpr int TAB_OFF = EPIP_OFF + 8192;
constexpr int MISC_OFF = TAB_OFF + 2048;
constexpr int LDS_BYTES = 147456;
static_assert(MISC_OFF + 128 <= LDS_BYTES, "LDS map");

struct SchedGrid {
    const char* A; const char* B; int nM, nN, nt, G, c; size_t astep, bstep;
    int pn0, pn_a, pn_skip;
    DI bool next(int i, pg8::GU& u) const {
        const long L = (long)i * G + c; if (L >= (long)nM * nN) return false;
        int pm, pn; pg8::tile_order((int)L, nM, nN, pm, pn);
        pn = pn0 + pn + (pn >= pn_a ? pn_skip : 0);
        u.pm = pm; u.pn = pn; u.tag = 0; u.half = 0; u.nt = nt; u.A = A + (size_t)pm * astep; u.B = B + (size_t)pn * bstep; return true;
    }
};
struct SchedBranch {
    const char* A; const char* B; int G, c;
    DI bool next(int i, pg8::GU& u) const {
        const int ti = i / 3, sub = i - ti * 3; const long L = (long)ti * G + c; if (L >= 64 * 8) return false;
        int pm, pn; pg8::tile_order((int)L, 64, 8, pm, pn);
        const int koff = sub == 0 ? 0 : (sub == 1 ? 2048 : 3072);
        u.pm = pm; u.pn = pn; u.tag = sub; u.half = 0; u.nt = sub == 0 ? 32 : 16;
        u.A = A + ((size_t)pm * 256 * 4096 + koff) * 2; u.B = B + ((size_t)pn * 256 * 4096 + koff) * 2; return true;
    }
};
struct SchedMoE {
    const char* A; const char* B; const LAS int* rb2e; int nrb, NPN, G, c, nt; size_t apan, bexp, bpn;
    DI bool next(int i, pg8::GU& u) const {
        const long L = (long)i * G + c; if (L >= (long)nrb * NPN) return false;
        const int rb = (int)(L / NPN), pn = (int)(L - (long)rb * NPN); const int e = rb2e[rb];
        const int pm = e * (ECAP / 256) + (rb - rb2e[300 + e]);
        u.pm = pm; u.pn = pn; u.tag = e; u.nt = nt;
        u.half = rb2e[340 + e] - (rb - rb2e[300 + e]) * 256 <= 128;
        u.A = A + (size_t)pm * apan; u.B = B + (size_t)e * bexp + (size_t)pn * bpn; return true;
    }
};

typedef f32x4 AccT[2][2][4][2];
DI float sigmoidf_(float v) { v = fmaxf(v, -80.f); return __builtin_amdgcn_rcpf(1.f + __builtin_amdgcn_exp2f(-1.4426950408889634f * v)); }

template <int TYPE  > struct EpiProj {
    static constexpr bool PERM = true;
    bf16_t* out; int ldc; int memkv;
    const float *gt, *gmq, *gmk, *bgate; const float* cs;
    LAS float* P;
    DI bool operator()(AccT& acc, const pg8::GU& u, int wr, int wc, int fr, int fq) const {
        asm volatile("" : "+v"(fr), "+v"(fq));
        const float* gain = nullptr;
        const int pn = u.pn;
        if (TYPE == 2) gain = memkv ? gmk : gmq;
        if (TYPE == 1) gain = gt + (pn < 16 ? (pn >> 3) : 2 + ((pn - 24) >> 2)) * 128;
        const int rloc0 = wr * 64 + fr, cloc0 = wc * 32 + 8 * fq;
        if (TYPE == 1 || TYPE == 2) {
            const bool dorope = (TYPE == 1) && wc == 0;
            constexpr int NS = 3;
            f32x4 cc[NS][2], ss[NS][2];
            if (dorope) {
#pragma unroll
                for (int m = 0; m < NS; ++m) { const float* cp = cs + ((size_t)u.pm * 256 + rloc0 + m * 16) * 32 + 8 * (fq & 1);
#pragma unroll
                    for (int n = 0; n < 2; ++n) { cc[m][n] = *(const f32x4*)(cp + 4 * n); ss[m][n] = *(const f32x4*)(cp + 16 + 4 * n); } } }
            constexpr int NG = TYPE == 2 ? 2 : 1;
            f32x4 g[NG][2];
#pragma unroll
            for (int bj = 0; bj < NG; ++bj)
#pragma unroll
                for (int n = 0; n < 2; ++n) g[bj][n] = *(const f32x4*)(gain + bj * 128 + cloc0 + n * 4);
            asm volatile("" ::: "memory");
#pragma unroll
            for (int ai = 0; ai < 2; ++ai)
#pragma unroll
                for (int m = 0; m < 4; ++m)
#pragma unroll
                    for (int bj = 0; bj < 2; ++bj) { float s = 0.f;
#pragma unroll
                        for (int n = 0; n < 2; ++n) { const f32x4 x = acc[ai][bj][m][n]; s += (x[0] * x[0] + x[1] * x[1]) + (x[2] * x[2] + x[3] * x[3]); }
                        s += __shfl_xor(s, 16); s += __shfl_xor(s, 32);
                        if (fq == 0) P[(ai * 128 + rloc0 + m * 16) * 8 + bj * 4 + wc] = s; }
            LDS_WAIT(); __builtin_amdgcn_s_barrier(); asm volatile("" ::: "memory");
#pragma unroll
            for (int ai = 0; ai < 2; ++ai)
#pragma unroll
                for (int m = 0; m < 4; ++m) {
                    const LAS f32x4* pr = (const LAS f32x4*)(P + (ai * 128 + rloc0 + m * 16) * 8);
                    const f32x4 p0 = pr[0], p1 = pr[1];
                    const float t0 = (p0[0] + p0[1]) + (p0[2] + p0[3]), t1 = (p1[0] + p1[1]) + (p1[2] + p1[3]);
                    float r0, r1;
                    if (TYPE == 1) { r0 = __builtin_amdgcn_rsqf(t0 * (1.f / 128.f) + EPS); r1 = __builtin_amdgcn_rsqf(t1 * (1.f / 128.f) + EPS); }
                    else { r0 = r1 = __builtin_amdgcn_rsqf((t0 + t1) * (1.f / 256.f) + EPS); }
#pragma unroll
                    for (int n = 0; n < 2; ++n) { acc[ai][0][m][n] = acc[ai][0][m][n] * r0 * g[0][n]; acc[ai][1][m][n] = acc[ai][1][m][n] * r1 * g[NG - 1][n]; }
                    if (dorope) {
#pragma unroll
                        for (int n = 0; n < 2; ++n) { const f32x4 c = cc[(ai * 4 + m) % NS][n], s = ss[(ai * 4 + m) % NS][n];
#pragma unroll
                            for (int bj = 0; bj < 2; ++bj)
#pragma unroll
                                for (int jp = 0; jp < 4; jp += 2) {
                                    const float cs_ = fq < 2 ? c[jp] : c[jp + 1], sn_ = fq < 2 ? s[jp] : s[jp + 1];
                                    auto r1 = __builtin_amdgcn_permlane32_swap(__float_as_uint(acc[ai][bj][m][n][jp]), __float_as_uint(acc[ai][bj][m][n][jp + 1]), false, false);
                                    const float u1 = __uint_as_float(r1[0]), u2 = __uint_as_float(r1[1]);
                                    const float o1 = u1 * cs_ - u2 * sn_, o2 = u2 * cs_ + u1 * sn_;
                                    auto r2 = __builtin_amdgcn_permlane32_swap(__float_as_uint(o1), __float_as_uint(o2), false, false);
                                    acc[ai][bj][m][n][jp] = __uint_as_float(r2[0]); acc[ai][bj][m][n][jp + 1] = __uint_as_float(r2[1]); } }
                        if (ai * 4 + m + NS < 8) {
                            constexpr int dummy = 0; (void)dummy; const int rn = ai * 4 + m + NS;
                            const float* cp = cs + ((size_t)u.pm * 256 + (rn >> 2) * 128 + rloc0 + (rn & 3) * 16) * 32 + 8 * (fq & 1);
#pragma unroll
                            for (int n = 0; n < 2; ++n) { cc[(ai * 4 + m) % NS][n] = *(const f32x4*)(cp + 4 * n); ss[(ai * 4 + m) % NS][n] = *(const f32x4*)(cp + 16 + 4 * n); } }
                    }
                    asm volatile("" : "+v"(acc[ai][0][m][0]), "+v"(acc[ai][0][m][1]), "+v"(acc[ai][1][m][0]), "+v"(acc[ai][1][m][1]));
#pragma unroll
                    for (int bj = 0; bj < 2; ++bj) { const f32x4 v0 = acc[ai][bj][m][0], v1 = acc[ai][bj][m][1]; u32x4 w;
                        w.x = cvt_pk_bf16(v0[0], v0[1]); w.y = cvt_pk_bf16(v0[2], v0[3]); w.z = cvt_pk_bf16(v1[0], v1[1]); w.w = cvt_pk_bf16(v1[2], v1[3]);
                        *(u32x4*)(out + ((size_t)u.pm * 256 + ai * 128 + rloc0 + m * 16) * ldc + pn * 256 + cloc0 + bj * 128) = w; }
                    asm volatile("" ::: "memory");
                }
            return false;
        } else if (TYPE == 3) {
            const int cb = pn * 256 - C_G + cloc0;
            f32x4 bvv[2][2];
#pragma unroll
            for (int bj = 0; bj < 2; ++bj)
#pragma unroll
                for (int n = 0; n < 2; ++n) bvv[bj][n] = *(const f32x4*)(bgate + cb + bj * 128 + n * 4);
            asm volatile("" ::: "memory");
#pragma unroll
            for (int ai = 0; ai < 2; ++ai)
#pragma unroll
                for (int m = 0; m < 4; ++m) {
#pragma unroll
                    for (int bj = 0; bj < 2; ++bj)
#pragma unroll
                        for (int n = 0; n < 2; ++n) { f32x4 v = acc[ai][bj][m][n] + bvv[bj][n];
                            v[0] = sigmoidf_(v[0]); v[1] = sigmoidf_(v[1]); v[2] = sigmoidf_(v[2]); v[3] = sigmoidf_(v[3]); acc[ai][bj][m][n] = v; }
#pragma unroll
                    for (int bj = 0; bj < 2; ++bj) { const f32x4 v0 = acc[ai][bj][m][0], v1 = acc[ai][bj][m][1]; u32x4 w;
                        w.x = cvt_pk_bf16(v0[0], v0[1]); w.y = cvt_pk_bf16(v0[2], v0[3]); w.z = cvt_pk_bf16(v1[0], v1[1]); w.w = cvt_pk_bf16(v1[2], v1[3]);
                        *(u32x4*)(out + ((size_t)u.pm * 256 + ai * 128 + rloc0 + m * 16) * ldc + pn * 256 + cloc0 + bj * 128) = w; }
                    asm volatile("" ::: "memory");
                }
            return false;
        }
#pragma unroll
        for (int ai = 0; ai < 2; ++ai)
#pragma unroll
            for (int m = 0; m < 4; ++m) { bf16_t* rowp = out + ((size_t)u.pm * 256 + ai * 128 + rloc0 + m * 16) * ldc + pn * 256 + cloc0;
#pragma unroll
                for (int bj = 0; bj < 2; ++bj) { const f32x4 v0 = acc[ai][bj][m][0], v1 = acc[ai][bj][m][1]; u32x4 w;
                    w.x = cvt_pk_bf16(v0[0], v0[1]); w.y = cvt_pk_bf16(v0[2], v0[3]); w.z = cvt_pk_bf16(v1[0], v1[1]); w.w = cvt_pk_bf16(v1[2], v1[3]);
                    *(u32x4*)(rowp + bj * 128) = w; } }
        return false;
    }
};

struct EpiBranch {
    static constexpr bool PERM = true; static constexpr int EB_ROWS = 4;
    const bf16_t* proj; bf16_t* merged;
    DI bool operator()(AccT& acc, const pg8::GU& u, int wr, int wc, int fr, int fq) const {
        asm volatile("" : "+v"(fr), "+v"(fq));
        const int sub = u.tag; const int rloc0 = wr * 64 + fr, col0 = u.pn * 256 + wc * 32 + 8 * fq;
        const int oa = sub * 2048, ob = (sub < 2 ? sub + 1 : 2) * 2048;
        const bool ratio = sub < 2;
#pragma unroll
        for (int am = 0; am < 8; am += EB_ROWS) {
            u32x4 A[EB_ROWS][2], B[EB_ROWS][2];
#pragma unroll
            for (int q = 0; q < EB_ROWS; ++q)
#pragma unroll
                for (int bj = 0; bj < 2; ++bj) { const int ai = (am + q) >> 2, m = (am + q) & 3; const bf16_t* gp = proj + ((size_t)u.pm * 256 + ai * 128 + rloc0 + m * 16) * INC + C_G + col0 + bj * 128;
                    A[q][bj] = *(const u32x4*)(gp + oa); B[q][bj] = *(const u32x4*)(gp + ob); }
            asm volatile("" ::: "memory");
#pragma unroll
            for (int q = 0; q < EB_ROWS; ++q) { const int ai = (am + q) >> 2, m = (am + q) & 3;
#pragma unroll
                for (int bj = 0; bj < 2; ++bj) { const u32x4 a = A[q][bj], b = B[q][bj];
#define EB_F(av, bv) ((av) * (ratio ? __builtin_amdgcn_rcpf(bv) : 1.f))
                    const f32x4 f0 = {EB_F(bf_lo(a.x), bf_lo(b.x)), EB_F(bf_hi(a.x), bf_hi(b.x)), EB_F(bf_lo(a.y), bf_lo(b.y)), EB_F(bf_hi(a.y), bf_hi(b.y))};
                    const f32x4 f1 = {EB_F(bf_lo(a.z), bf_lo(b.z)), EB_F(bf_hi(a.z), bf_hi(b.z)), EB_F(bf_lo(a.w), bf_lo(b.w)), EB_F(bf_hi(a.w), bf_hi(b.w))};
#undef EB_F
                    acc[ai][bj][m][0] = acc[ai][bj][m][0] * f0; acc[ai][bj][m][1] = acc[ai][bj][m][1] * f1; } }
            asm volatile("" ::: "memory");
        }
        if (sub == 2) {
#pragma unroll
            for (int ai = 0; ai < 2; ++ai)
#pragma unroll
                for (int m = 0; m < 4; ++m) { const size_t row = (size_t)u.pm * 256 + ai * 128 + rloc0 + m * 16;
#pragma unroll
                    for (int bj = 0; bj < 2; ++bj) { const f32x4 v0 = acc[ai][bj][m][0], v1 = acc[ai][bj][m][1]; u32x4 w;
                        w.x = cvt_pk_bf16(v0[0], v0[1]); w.y = cvt_pk_bf16(v0[2], v0[3]); w.z = cvt_pk_bf16(v1[0], v1[1]); w.w = cvt_pk_bf16(v1[2], v1[3]);
                        *(u32x4*)(merged + row * DM + col0 + bj * 128) = w; } }
        }
        return sub < 2;
    }
};

struct EpiOut {
    static constexpr bool PERM = false;
    const float* x; float* x1;
    DI bool operator()(AccT& acc, const pg8::GU& u, int wr, int wc, int fr, int fq) const {
        const int rloc0 = wr * 64 + fr, col0 = u.pn * 256 + wc * 32 + 4 * fq;
#pragma unroll
        for (int ai = 0; ai < 2; ++ai)
            { f32x4 xv[4][2][2];
#pragma unroll
              for (int m = 0; m < 4; ++m) { const size_t off = ((size_t)u.pm * 256 + ai * 128 + rloc0 + m * 16) * DM + col0;
#pragma unroll
                for (int bj = 0; bj < 2; ++bj)
#pragma unroll
                    for (int n = 0; n < 2; ++n) xv[m][bj][n] = __builtin_nontemporal_load((const f32x4*)(x + off + bj * 128 + n * 16)); }
              asm volatile("" ::: "memory");
#pragma unroll
              for (int m = 0; m < 4; ++m) { const size_t off = ((size_t)u.pm * 256 + ai * 128 + rloc0 + m * 16) * DM + col0;
#pragma unroll
                for (int bj = 0; bj < 2; ++bj)
#pragma unroll
                    for (int n = 0; n < 2; ++n) *(f32x4*)(x1 + off + bj * 128 + n * 16) = xv[m][bj][n] + acc[ai][bj][m][n]; }
              asm volatile("" ::: "memory"); }
        return false;
    }
};

struct EpiSwiglu {
    static constexpr bool PERM = true;
    const float* bgu; unsigned char* act;
    DI bool operator()(AccT& acc, const pg8::GU& u, int wr, int wc, int fr, int fq) const {
        const int rloc0 = wr * 64 + fr, cc = wc * 32 + 8 * fq, gcol = u.pn * 128 + cc; const float* bp = bgu + (size_t)u.tag * 4096 + gcol;
        const f32x4 bg0 = *(const f32x4*)bp, bg1 = *(const f32x4*)(bp + 4), bu0 = *(const f32x4*)(bp + 2048), bu1 = *(const f32x4*)(bp + 2052);
#pragma unroll
        for (int ai = 0; ai < 2; ++ai)
#pragma unroll
            for (int m = 0; m < 4; ++m) { const size_t row = (size_t)u.pm * 256 + ai * 128 + rloc0 + m * 16;
                f32x4 r[2];
#pragma unroll
                for (int n = 0; n < 2; ++n) { const f32x4 gt = acc[ai][0][m][n] + (n ? bg1 : bg0), up = acc[ai][1][m][n] + (n ? bu1 : bu0);
#pragma unroll
                    for (int j = 0; j < 4; ++j) { const float g = fminf(gt[j], 7.f), uu = fminf(fmaxf(up[j], -7.f), 7.f);
                        r[n][j] = (uu + 1.f) * g * __builtin_amdgcn_rcpf(1.f + __builtin_amdgcn_exp2f(-1.702f * 1.4426950408889634f * g)); } }
                u32x2 w; w.x = pack4_fp8(r[0][0], r[0][1], r[0][2], r[0][3]); w.y = pack4_fp8(r[1][0], r[1][1], r[1][2], r[1][3]);
                *(u32x2*)(act + row * DFF + gcol) = w; }
        return false;
    }
};

struct EpiDown {
    static constexpr bool PERM = true;
    const float* bd; const int* slot_asg; const float* slot_w; bf16_t* ybuf;
    DI bool operator()(AccT& acc, const pg8::GU& u, int wr, int wc, int fr, int fq) const {
        const int rloc0 = wr * 64 + fr, col0 = u.pn * 256 + wc * 32 + 8 * fq; const float* bp = bd + (size_t)u.tag * DM + col0;
        f32x4 bv[2][2];
#pragma unroll
        for (int bj = 0; bj < 2; ++bj)
#pragma unroll
            for (int n = 0; n < 2; ++n) bv[bj][n] = *(const f32x4*)(bp + bj * 128 + 4 * n);
        int av[2][4]; float wv[2][4];
#pragma unroll
        for (int ai = 0; ai < 2; ++ai)
#pragma unroll
            for (int m = 0; m < 4; ++m) { const size_t slot = (size_t)u.pm * 256 + ai * 128 + rloc0 + m * 16; av[ai][m] = slot_asg[slot]; wv[ai][m] = slot_w[slot]; }
        asm volatile("" ::: "memory");
#pragma unroll
        for (int ai = 0; ai < 2; ++ai)
#pragma unroll
            for (int m = 0; m < 4; ++m) { const int a = av[ai][m]; const float wgt = wv[ai][m];
                if (a >= 0) {
#pragma unroll
                    for (int bj = 0; bj < 2; ++bj) { const f32x4 v0 = (acc[ai][bj][m][0] + bv[bj][0]) * wgt, v1 = (acc[ai][bj][m][1] + bv[bj][1]) * wgt; u32x4 w;
                        w.x = cvt_pk_bf16(v0[0], v0[1]); w.y = cvt_pk_bf16(v0[2], v0[3]); w.z = cvt_pk_bf16(v1[0], v1[1]); w.w = cvt_pk_bf16(v1[2], v1[3]);
                        *(u32x4*)(ybuf + (size_t)a * DM + col0 + bj * 128) = w; } } }
        return false;
    }
};
namespace att {
constexpr int SHM_K = 64 * 128 * 2, SHM_V = 64 * 256 * 2, STG = 2 * SHM_K + SHM_V;
#define KSWZ(row, colB) ((row) * 256 + ((colB) ^ (((row) & 7) << 4)))
DI int swap23(int k) { return (k & ~0xC) | ((k & 4) << 1) | ((k & 8) >> 1); }
DI int v_rd_base(int lane) { return ((lane & 3) << 3) | (((lane >> 2) & 3) << 6) | (((lane >> 4) & 1) << 5) | (((lane >> 5) & 1) << 8); }
DI int crow(int r, int hi) { return (r & 3) + 8 * (r >> 2) + 4 * hi; }

DI void mask_causal(f32x16& p0, f32x16& p1, int dq) {
    const float NEG = -__builtin_inff();
#pragma unroll
    for (int r = 0; r < 16; ++r) { const int c = (r & 3) + 8 * (r >> 2);
        if (dq - c < 0) p0[r] = NEG;
        if (dq - c - 32 < 0) p1[r] = NEG; }
}
template <int NP>
DI void partialSM(f32x16& p0, f32x16& p1, float& m_reg, float& alpha, const float C2, const float SCALE) {
    float pmax = p0[0];
#pragma unroll
    for (int r = 1; r < 16; ++r) pmax = fmaxf(pmax, p0[r]);
    if (NP == 2) {
#pragma unroll
        for (int r = 0; r < 16; ++r) pmax = fmaxf(pmax, p1[r]); }
    { auto rr = __builtin_amdgcn_permlane32_swap(__float_as_uint(pmax), __float_as_uint(pmax), false, false);
      pmax = fmaxf(__uint_as_float(rr[0]), __uint_as_float(rr[1])); }
    float mn;
    if (__builtin_expect(__all((pmax - m_reg) * SCALE <= 8.f), 1)) { mn = m_reg; alpha = 1.f; }
    else { mn = fmaxf(m_reg, pmax); alpha = __builtin_amdgcn_exp2f((m_reg - mn) * C2); m_reg = mn; }
    const float mnL = -mn * C2;
#pragma unroll
    for (int r = 0; r < 16; ++r) p0[r] = __builtin_amdgcn_exp2f(fmaf(p0[r], C2, mnL));
    if (NP == 2) {
#pragma unroll
        for (int r = 0; r < 16; ++r) p1[r] = __builtin_amdgcn_exp2f(fmaf(p1[r], C2, mnL)); }
}
#define PK4(P, B_, OUT) do { unsigned a0 = cvt_pk_bf16_a(P[B_+0], P[B_+1]), a1 = cvt_pk_bf16_a(P[B_+2], P[B_+3]);                          \
        unsigned b0 = cvt_pk_bf16_a(P[B_+4], P[B_+5]), b1 = cvt_pk_bf16_a(P[B_+6], P[B_+7]);                                             \
        asm volatile("s_nop 1" : "+v"(a0), "+v"(a1), "+v"(b0), "+v"(b1));                                                                                                         \
        auto r0 = __builtin_amdgcn_permlane32_swap(a0, b0, false, false); auto r1 = __builtin_amdgcn_permlane32_swap(a1, b1, false, false); \
        u32x4 w = {r0[0], r1[0], r0[1], r1[1]}; OUT = *reinterpret_cast<bf16x8*>(&w); } while (0)
template <int NP>
DI void finishSM(f32x16& p0, f32x16& p1, float alpha, float& l_reg, bf16x8& pa0, bf16x8& pa1, bf16x8& pa2, bf16x8& pa3) {
    float ps = 0.f;
#pragma unroll
    for (int r = 0; r < 16; ++r) ps += p0[r];
    if (NP == 2) {
#pragma unroll
        for (int r = 0; r < 16; ++r) ps += p1[r]; }
    { auto rr = __builtin_amdgcn_permlane32_swap(__float_as_uint(ps), __float_as_uint(ps), false, false);
      ps = __uint_as_float(rr[0]) + __uint_as_float(rr[1]); }
    l_reg = l_reg * alpha + ps;
    PK4(p0, 0, pa0); PK4(p0, 8, pa1);
    if (NP == 2) { PK4(p1, 0, pa2); PK4(p1, 8, pa3); }
}
DI void qkt(f32x16& p0, f32x16& p1, const LAS char* Kt, int r32, int hi, const bf16x8* qr) {
    const LAS char* kb[4];
#pragma unroll
    for (int dd = 0; dd < 4; ++dd) kb[dd] = Kt + KSWZ(r32, (dd * 16 + hi * 8) * 2);
#pragma unroll
    for (int d0 = 0; d0 < 8; ++d0) { const LAS char* a = kb[d0 & 3] + (d0 >> 2) * 128;
        const bf16x8 b0 = *reinterpret_cast<const LAS bf16x8*>(a);
        const bf16x8 b1 = *reinterpret_cast<const LAS bf16x8*>(a + 32 * 256);
        p0 = __builtin_amdgcn_mfma_f32_32x32x16_bf16(b0, qr[d0], p0, 0, 0, 0);
        p1 = __builtin_amdgcn_mfma_f32_32x32x16_bf16(b1, qr[d0], p1, 0, 0, 0); }
}
#define TRRD(dst, vb, off) asm volatile("ds_read_b64_tr_b16 %0, %1 offset:%2" : "=&v"(dst) : "v"(vb), "i"(off) : "memory")
#define TR8_64(S_, vb, base_, NCB) do { constexpr int b_ = (base_); \
        TRRD(S_##l0, vb, b_); TRRD(S_##h0, vb, b_ + NCB * 512); TRRD(S_##l1, vb, b_ + 2 * NCB * 512); TRRD(S_##h1, vb, b_ + 3 * NCB * 512);               \
        TRRD(S_##l2, vb, b_ + 4 * NCB * 512); TRRD(S_##h2, vb, b_ + 5 * NCB * 512); TRRD(S_##l3, vb, b_ + 6 * NCB * 512); TRRD(S_##h3, vb, b_ + 7 * NCB * 512); } while (0)
#define MMA4_64(o_, S_) do { \
        o_ = __builtin_amdgcn_mfma_f32_32x32x16_bf16((bf16x8){S_##l0[0], S_##l0[1], S_##l0[2], S_##l0[3], S_##h0[0], S_##h0[1], S_##h0[2], S_##h0[3]}, pa0, o_, 0, 0, 0);   \
        o_ = __builtin_amdgcn_mfma_f32_32x32x16_bf16((bf16x8){S_##l1[0], S_##l1[1], S_##l1[2], S_##l1[3], S_##h1[0], S_##h1[1], S_##h1[2], S_##h1[3]}, pa1, o_, 0, 0, 0);   \
        o_ = __builtin_amdgcn_mfma_f32_32x32x16_bf16((bf16x8){S_##l2[0], S_##l2[1], S_##l2[2], S_##l2[3], S_##h2[0], S_##h2[1], S_##h2[2], S_##h2[3]}, pa2, o_, 0, 0, 0);   \
        o_ = __builtin_amdgcn_mfma_f32_32x32x16_bf16((bf16x8){S_##l3[0], S_##l3[1], S_##l3[2], S_##l3[3], S_##h3[0], S_##h3[1], S_##h3[2], S_##h3[3]}, pa3, o_, 0, 0, 0); } while (0)
#define LGKM_WAIT(n) asm volatile("s_waitcnt lgkmcnt(" #n ")" ::: "memory")
#define PV_STEP(o_, Scur, Snxt, vb, nbase, NCB) do { TR8_64(Snxt, vb, nbase, NCB); LGKM_WAIT(8); SBAR(); MMA4_64(o_, Scur); SBAR(); } while (0)
#define PV_LAST(o_, Scur) do { LGKM_WAIT(0); SBAR(); MMA4_64(o_, Scur); SBAR(); } while (0)
#define PV_DECL() s16x4 fAl0, fAl1, fAl2, fAl3, fAh0, fAh1, fAh2, fAh3, fBl0, fBl1, fBl2, fBl3, fBh0, fBh1, fBh2, fBh3
#define PV_D0_32(o_, vb, base_, NCB) do { s16x4 l0, l1, h0, h1; constexpr int b_ = (base_);                                                   \
        TRRD(l0, vb, b_); TRRD(h0, vb, b_ + NCB * 512); TRRD(l1, vb, b_ + 2 * NCB * 512); TRRD(h1, vb, b_ + 3 * NCB * 512);               \
        asm volatile("s_waitcnt lgkmcnt(0)" ::: "memory"); SBAR();                                                                          \
        o_ = __builtin_amdgcn_mfma_f32_32x32x16_bf16((bf16x8){l0[0], l0[1], l0[2], l0[3], h0[0], h0[1], h0[2], h0[3]}, pa0, o_, 0, 0, 0);   \
        o_ = __builtin_amdgcn_mfma_f32_32x32x16_bf16((bf16x8){l1[0], l1[1], l1[2], l1[3], h1[0], h1[1], h1[2], h1[3]}, pa1, o_, 0, 0, 0); } while (0)

#define PV_JOUTER_64_DIFF(o, vb) do { s16x4 jl0, jl1, jl2, jl3, jl4, jh0, jh1, jh2, jh3, jh4; \
        TRRD(jl0, vb, 0); TRRD(jh0, vb, 4096); \
        TRRD(jl1, vb, 512); TRRD(jh1, vb, 4608); \
        TRRD(jl2, vb, 1024); TRRD(jh2, vb, 5120); \
        TRRD(jl3, vb, 1536); TRRD(jh3, vb, 5632); \
        TRRD(jl4, vb, 2048); TRRD(jh4, vb, 6144); LGKM_WAIT(8); SBAR(); o[0] = __builtin_amdgcn_mfma_f32_32x32x16_bf16((bf16x8){jl0[0], jl0[1], jl0[2], jl0[3], jh0[0], jh0[1], jh0[2], jh0[3]}, pa0, o[0], 0, 0, 0); SBAR(); \
        TRRD(jl0, vb, 2560); TRRD(jh0, vb, 6656); LGKM_WAIT(8); SBAR(); o[1] = __builtin_amdgcn_mfma_f32_32x32x16_bf16((bf16x8){jl1[0], jl1[1], jl1[2], jl1[3], jh1[0], jh1[1], jh1[2], jh1[3]}, pa0, o[1], 0, 0, 0); SBAR(); \
        TRRD(jl1, vb, 3072); TRRD(jh1, vb, 7168); LGKM_WAIT(8); SBAR(); o[2] = __builtin_amdgcn_mfma_f32_32x32x16_bf16((bf16x8){jl2[0], jl2[1], jl2[2], jl2[3], jh2[0], jh2[1], jh2[2], jh2[3]}, pa0, o[2], 0, 0, 0); SBAR(); \
        TRRD(jl2, vb, 3584); TRRD(jh2, vb, 7680); LGKM_WAIT(8); SBAR(); o[3] = __builtin_amdgcn_mfma_f32_32x32x16_bf16((bf16x8){jl3[0], jl3[1], jl3[2], jl3[3], jh3[0], jh3[1], jh3[2], jh3[3]}, pa0, o[3], 0, 0, 0); SBAR(); \
        TRRD(jl3, vb, 8192); TRRD(jh3, vb, 12288); LGKM_WAIT(8); SBAR(); o[4] = __builtin_amdgcn_mfma_f32_32x32x16_bf16((bf16x8){jl4[0], jl4[1], jl4[2], jl4[3], jh4[0], jh4[1], jh4[2], jh4[3]}, pa0, o[4], 0, 0, 0); SBAR(); \
        TRRD(jl4, vb, 8704); TRRD(jh4, vb, 12800); LGKM_WAIT(8); SBAR(); o[5] = __builtin_amdgcn_mfma_f32_32x32x16_bf16((bf16x8){jl0[0], jl0[1], jl0[2], jl0[3], jh0[0], jh0[1], jh0[2], jh0[3]}, pa0, o[5], 0, 0, 0); SBAR(); \
        TRRD(jl0, vb, 9216); TRRD(jh0, vb, 13312); LGKM_WAIT(8); SBAR(); o[6] = __builtin_amdgcn_mfma_f32_32x32x16_bf16((bf16x8){jl1[0], jl1[1], jl1[2], jl1[3], jh1[0], jh1[1], jh1[2], jh1[3]}, pa0, o[6], 0, 0, 0); SBAR(); \
        TRRD(jl1, vb, 9728); TRRD(jh1, vb, 13824); LGKM_WAIT(8); SBAR(); o[7] = __builtin_amdgcn_mfma_f32_32x32x16_bf16((bf16x8){jl2[0], jl2[1], jl2[2], jl2[3], jh2[0], jh2[1], jh2[2], jh2[3]}, pa0, o[7], 0, 0, 0); SBAR(); \
        TRRD(jl2, vb, 10240); TRRD(jh2, vb, 14336); LGKM_WAIT(8); SBAR(); o[0] = __builtin_amdgcn_mfma_f32_32x32x16_bf16((bf16x8){jl3[0], jl3[1], jl3[2], jl3[3], jh3[0], jh3[1], jh3[2], jh3[3]}, pa1, o[0], 0, 0, 0); SBAR(); \
        TRRD(jl3, vb, 10752); TRRD(jh3, vb, 14848); LGKM_WAIT(8); SBAR(); o[1] = __builtin_amdgcn_mfma_f32_32x32x16_bf16((bf16x8){jl4[0], jl4[1], jl4[2], jl4[3], jh4[0], jh4[1], jh4[2], jh4[3]}, pa1, o[1], 0, 0, 0); SBAR(); \
        TRRD(jl4, vb, 11264); TRRD(jh4, vb, 15360); LGKM_WAIT(8); SBAR(); o[2] = __builtin_amdgcn_mfma_f32_32x32x16_bf16((bf16x8){jl0[0], jl0[1], jl0[2], jl0[3], jh0[0], jh0[1], jh0[2], jh0[3]}, pa1, o[2], 0, 0, 0); SBAR(); \
        TRRD(jl0, vb, 11776); TRRD(jh0, vb, 15872); LGKM_WAIT(8); SBAR(); o[3] = __builtin_amdgcn_mfma_f32_32x32x16_bf16((bf16x8){jl1[0], jl1[1], jl1[2], jl1[3], jh1[0], jh1[1], jh1[2], jh1[3]}, pa1, o[3], 0, 0, 0); SBAR(); \
        TRRD(jl1, vb, 16384); TRRD(jh1, vb, 20480); LGKM_WAIT(8); SBAR(); o[4] = __builtin_amdgcn_mfma_f32_32x32x16_bf16((bf16x8){jl2[0], jl2[1], jl2[2], jl2[3], jh2[0], jh2[1], jh2[2], jh2[3]}, pa1, o[4], 0, 0, 0); SBAR(); \
        TRRD(jl2, vb, 16896); TRRD(jh2, vb, 20992); LGKM_WAIT(8); SBAR(); o[5] = __builtin_amdgcn_mfma_f32_32x32x16_bf16((bf16x8){jl3[0], jl3[1], jl3[2], jl3[3], jh3[0], jh3[1], jh3[2], jh3[3]}, pa1, o[5], 0, 0, 0); SBAR(); \
        TRRD(jl3, vb, 17408); TRRD(jh3, vb, 21504); LGKM_WAIT(8); SBAR(); o[6] = __builtin_amdgcn_mfma_f32_32x32x16_bf16((bf16x8){jl4[0], jl4[1], jl4[2], jl4[3], jh4[0], jh4[1], jh4[2], jh4[3]}, pa1, o[6], 0, 0, 0); SBAR(); \
        TRRD(jl4, vb, 17920); TRRD(jh4, vb, 22016); LGKM_WAIT(8); SBAR(); o[7] = __builtin_amdgcn_mfma_f32_32x32x16_bf16((bf16x8){jl0[0], jl0[1], jl0[2], jl0[3], jh0[0], jh0[1], jh0[2], jh0[3]}, pa1, o[7], 0, 0, 0); SBAR(); \
        TRRD(jl0, vb, 18432); TRRD(jh0, vb, 22528); LGKM_WAIT(8); SBAR(); o[0] = __builtin_amdgcn_mfma_f32_32x32x16_bf16((bf16x8){jl1[0], jl1[1], jl1[2], jl1[3], jh1[0], jh1[1], jh1[2], jh1[3]}, pa2, o[0], 0, 0, 0); SBAR(); \
        TRRD(jl1, vb, 18944); TRRD(jh1, vb, 23040); LGKM_WAIT(8); SBAR(); o[1] = __builtin_amdgcn_mfma_f32_32x32x16_bf16((bf16x8){jl2[0], jl2[1], jl2[2], jl2[3], jh2[0], jh2[1], jh2[2], jh2[3]}, pa2, o[1], 0, 0, 0); SBAR(); \
        TRRD(jl2, vb, 19456); TRRD(jh2, vb, 23552); LGKM_WAIT(8); SBAR(); o[2] = __builtin_amdgcn_mfma_f32_32x32x16_bf16((bf16x8){jl3[0], jl3[1], jl3[2], jl3[3], jh3[0], jh3[1], jh3[2], jh3[3]}, pa2, o[2], 0, 0, 0); SBAR(); \
        TRRD(jl3, vb, 19968); TRRD(jh3, vb, 24064); LGKM_WAIT(8); SBAR(); o[3] = __builtin_amdgcn_mfma_f32_32x32x16_bf16((bf16x8){jl4[0], jl4[1], jl4[2], jl4[3], jh4[0], jh4[1], jh4[2], jh4[3]}, pa2, o[3], 0, 0, 0); SBAR(); \
        TRRD(jl4, vb, 24576); TRRD(jh4, vb, 28672); LGKM_WAIT(8); SBAR(); o[4] = __builtin_amdgcn_mfma_f32_32x32x16_bf16((bf16x8){jl0[0], jl0[1], jl0[2], jl0[3], jh0[0], jh0[1], jh0[2], jh0[3]}, pa2, o[4], 0, 0, 0); SBAR(); \
        TRRD(jl0, vb, 25088); TRRD(jh0, vb, 29184); LGKM_WAIT(8); SBAR(); o[5] = __builtin_amdgcn_mfma_f32_32x32x16_bf16((bf16x8){jl1[0], jl1[1], jl1[2], jl1[3], jh1[0], jh1[1], jh1[2], jh1[3]}, pa2, o[5], 0, 0, 0); SBAR(); \
        TRRD(jl1, vb, 25600); TRRD(jh1, vb, 29696); LGKM_WAIT(8); SBAR(); o[6] = __builtin_amdgcn_mfma_f32_32x32x16_bf16((bf16x8){jl2[0], jl2[1], jl2[2], jl2[3], jh2[0], jh2[1], jh2[2], jh2[3]}, pa2, o[6], 0, 0, 0); SBAR(); \
        TRRD(jl2, vb, 26112); TRRD(jh2, vb, 30208); LGKM_WAIT(8); SBAR(); o[7] = __builtin_amdgcn_mfma_f32_32x32x16_bf16((bf16x8){jl3[0], jl3[1], jl3[2], jl3[3], jh3[0], jh3[1], jh3[2], jh3[3]}, pa2, o[7], 0, 0, 0); SBAR(); \
        TRRD(jl3, vb, 26624); TRRD(jh3, vb, 30720); LGKM_WAIT(8); SBAR(); o[0] = __builtin_amdgcn_mfma_f32_32x32x16_bf16((bf16x8){jl4[0], jl4[1], jl4[2], jl4[3], jh4[0], jh4[1], jh4[2], jh4[3]}, pa3, o[0], 0, 0, 0); SBAR(); \
        TRRD(jl4, vb, 27136); TRRD(jh4, vb, 31232); LGKM_WAIT(8); SBAR(); o[1] = __builtin_amdgcn_mfma_f32_32x32x16_bf16((bf16x8){jl0[0], jl0[1], jl0[2], jl0[3], jh0[0], jh0[1], jh0[2], jh0[3]}, pa3, o[1], 0, 0, 0); SBAR(); \
        TRRD(jl0, vb, 27648); TRRD(jh0, vb, 31744); LGKM_WAIT(8); SBAR(); o[2] = __builtin_amdgcn_mfma_f32_32x32x16_bf16((bf16x8){jl1[0], jl1[1], jl1[2], jl1[3], jh1[0], jh1[1], jh1[2], jh1[3]}, pa3, o[2], 0, 0, 0); SBAR(); \
        TRRD(jl1, vb, 28160); TRRD(jh1, vb, 32256); LGKM_WAIT(8); SBAR(); o[3] = __builtin_amdgcn_mfma_f32_32x32x16_bf16((bf16x8){jl2[0], jl2[1], jl2[2], jl2[3], jh2[0], jh2[1], jh2[2], jh2[3]}, pa3, o[3], 0, 0, 0); SBAR(); \
        LGKM_WAIT(6); SBAR(); o[4] = __builtin_amdgcn_mfma_f32_32x32x16_bf16((bf16x8){jl3[0], jl3[1], jl3[2], jl3[3], jh3[0], jh3[1], jh3[2], jh3[3]}, pa3, o[4], 0, 0, 0); SBAR(); \
        LGKM_WAIT(4); SBAR(); o[5] = __builtin_amdgcn_mfma_f32_32x32x16_bf16((bf16x8){jl4[0], jl4[1], jl4[2], jl4[3], jh4[0], jh4[1], jh4[2], jh4[3]}, pa3, o[5], 0, 0, 0); SBAR(); \
        LGKM_WAIT(2); SBAR(); o[6] = __builtin_amdgcn_mfma_f32_32x32x16_bf16((bf16x8){jl0[0], jl0[1], jl0[2], jl0[3], jh0[0], jh0[1], jh0[2], jh0[3]}, pa3, o[6], 0, 0, 0); SBAR(); \
        LGKM_WAIT(0); SBAR(); o[7] = __builtin_amdgcn_mfma_f32_32x32x16_bf16((bf16x8){jl1[0], jl1[1], jl1[2], jl1[3], jh1[0], jh1[1], jh1[2], jh1[3]}, pa3, o[7], 0, 0, 0); SBAR(); \
    } while (0)
DI void store_pair16(bf16_t* p, float a0, float a1, float a2, float a3, float b0, float b1, float b2, float b3) {
    unsigned gx = cvt_pk_bf16_a(a0, a1), gy = cvt_pk_bf16_a(a2, a3), hx = cvt_pk_bf16_a(b0, b1), hy = cvt_pk_bf16_a(b2, b3);
    asm volatile("s_nop 1" : "+v"(gx), "+v"(gy), "+v"(hx), "+v"(hy));
    auto rx = __builtin_amdgcn_permlane32_swap(gx, hx, false, false); auto ry = __builtin_amdgcn_permlane32_swap(gy, hy, false, false);
    u32x4 w = {rx[0], ry[0], rx[1], ry[1]};
    *(u32x4*)p = w;
}
struct CoopArgs {
    const bf16_t* q;
    const bf16_t* k0; const bf16_t* k1; const bf16_t* v;
    int rsq, rsk, nt;
};
DI void stage_k(LAS char* st, const CoopArgs& a, int kb0, int wid, int lane) {
    const int l16 = lane & 15, lr = lane >> 4;
#pragma unroll
    for (int i = 0; i < 2; ++i) { const int piece = 2 * wid + i, row = piece * 4 + lr, ch = l16 ^ (row & 7);
        const size_t go = (size_t)(kb0 + row) * a.rsk + ch * 8;
        __builtin_amdgcn_global_load_lds((const unsigned*)(a.k0 + go), (LAS unsigned*)(st + piece * 1024), 16, 0, 0);
        __builtin_amdgcn_global_load_lds((const unsigned*)(a.k1 + go), (LAS unsigned*)(st + SHM_K + piece * 1024), 16, 0, 0); }
}
DI void stage_v(LAS char* st, const CoopArgs& a, int kb0, int wid, int lane) {
    const int sub = lane >> 5, kr = (lane & 31) >> 2, ch4 = lane & 3; const int key = swap23(8 * wid + kr);
    const bf16_t* vp = a.v + (size_t)(kb0 + key) * a.rsk + sub * 32 + ch4 * 8;
#pragma unroll
    for (int j = 0; j < 4; ++j)
        __builtin_amdgcn_global_load_lds((const unsigned*)(vp + j * 64), (LAS unsigned*)(st + 2 * SHM_K + wid * 4096 + j * 1024), 16, 0, 0);
}
}
namespace att {
struct DiffOut { bf16_t* ob; const float* subln; float lam; };
template <int MODE>
DI void coop_unit(LAS char* lds, const CoopArgs& a, int qpos0  , const float C2, const float SCALE,
                  bf16_t* orow  , int ors, const DiffOut& dout) {
    const int tid = threadIdx.x, wid = __builtin_amdgcn_readfirstlane(tid >> 6), lane = tid & 63, r32 = lane & 31, hi = lane >> 5;
    const int c = wid >> 2, wq = wid & 3;
    constexpr int NQ = MODE == 0 ? 8 : 16, NO = MODE == 0 ? 8 : 4;
    bf16x8 qr[NQ];
    { const bf16_t* qp = a.q + (MODE == 0 ? c * 128 : 0) + (size_t)(wq * 32 + r32) * a.rsq + hi * 8;
#pragma unroll
      for (int d0 = 0; d0 < NQ; ++d0) qr[d0] = *(const bf16x8*)(qp + d0 * 16); }
    f32x16 o[NO];
#pragma unroll
    for (int d = 0; d < NO; ++d)
#pragma unroll
        for (int r = 0; r < 16; ++r) o[d][r] = 0.f;
    float m_reg = -1e30f, l_reg = 0.f;
    const int NT = a.nt;
    const int qlo = qpos0 + wq * 32;
    stage_k(lds, a, 0, wid, lane); stage_v(lds, a, 0, wid, lane);
    for (int t = 0; t < NT; ++t) {
        VM_WAIT(); __syncthreads();
        LAS char* st = lds + (t & 1) * STG;
        if (t + 1 < NT) { stage_k(lds + ((t + 1) & 1) * STG, a, (t + 1) * 64, wid, lane); stage_v(lds + ((t + 1) & 1) * STG, a, (t + 1) * 64, wid, lane); }
        const int kb0 = t * 64;
        if (MODE == 1 || kb0 <= qlo + 31) {
            f32x16 p0, p1;
#pragma unroll
            for (int r = 0; r < 16; ++r) { p0[r] = 0.f; p1[r] = 0.f; }
            if (MODE == 0) qkt(p0, p1, st + c * SHM_K, r32, hi, qr);
            else { qkt(p0, p1, st, r32, hi, qr); qkt(p0, p1, st + SHM_K, r32, hi, qr + 8); }
            if (MODE == 0 && kb0 + 63 > qlo) mask_causal(p0, p1, qlo + r32 - kb0 - 4 * hi);
            float alpha;
            partialSM<2>(p0, p1, m_reg, alpha, C2, SCALE);
            if (__any(alpha < 1.f)) {
#pragma unroll
                for (int d = 0; d < NO; ++d)
#pragma unroll
                    for (int r = 0; r < 16; ++r) o[d][r] *= alpha; }
            bf16x8 pa0, pa1, pa2, pa3;
            finishSM<2>(p0, p1, alpha, l_reg, pa0, pa1, pa2, pa3);
            const int vb = (int)(uintptr_t)(st + 2 * SHM_K) + v_rd_base(lane) + (MODE == 1 ? c * 4 * 512 : 0);
            if constexpr (MODE == 0) { PV_JOUTER_64_DIFF(o, vb); }
            else { PV_DECL();
                TR8_64(fA, vb, 0 * 512, 8);
                PV_STEP(o[0], fA, fB, vb, 1 * 512, 8); PV_STEP(o[1], fB, fA, vb, 2 * 512, 8); PV_STEP(o[2], fA, fB, vb, 3 * 512, 8); PV_LAST(o[3], fB); }
        }
    }
    const float il = __builtin_amdgcn_rcpf(l_reg);
    if constexpr (MODE == 1) {
        bf16_t* op = orow + (size_t)(wq * 32 + r32) * ors + c * 128 + 8 * hi;
#pragma unroll
        for (int d = 0; d < 4; ++d)
#pragma unroll
            for (int g = 0; g < 4; g += 2)
                store_pair16(op + d * 32 + 8 * g, o[d][4 * g] * il, o[d][4 * g + 1] * il, o[d][4 * g + 2] * il, o[d][4 * g + 3] * il,
                             o[d][4 * g + 4] * il, o[d][4 * g + 5] * il, o[d][4 * g + 6] * il, o[d][4 * g + 7] * il);
        __syncthreads();
    } else {
        __syncthreads();
        LAS float* X = (LAS float*)lds + wq * 8192 + lane;
        if (c == 1) { const float sc = il * dout.lam;
#pragma unroll
            for (int d = 0; d < 8; ++d)
#pragma unroll
                for (int r = 0; r < 16; ++r) X[(d * 16 + r) * 64] = o[d][r] * sc; }
        __syncthreads();
        if (c == 0) {
            float ss = 0.f;
#pragma unroll
            for (int d = 0; d < 8; ++d)
#pragma unroll
                for (int r = 0; r < 16; ++r) { const float v = o[d][r] * il - X[(d * 16 + r) * 64]; o[d][r] = v; ss += v * v; }
            { auto rr = __builtin_amdgcn_permlane32_swap(__float_as_uint(ss), __float_as_uint(ss), false, false); ss = __uint_as_float(rr[0]) + __uint_as_float(rr[1]); }
            const float rs = __builtin_amdgcn_rsqf(ss * (1.f / 256.f) + EPS) * (1.f - LAM_INIT);
            bf16_t* op = orow + (size_t)(wq * 32 + r32) * ors + 8 * hi;
#pragma unroll
            for (int d = 0; d < 8; ++d)
#pragma unroll
                for (int g = 0; g < 4; g += 2) { const f32x4 ga = *(const f32x4*)(dout.subln + d * 32 + 8 * g + 4 * hi), gb = *(const f32x4*)(dout.subln + d * 32 + 8 * g + 8 + 4 * hi);
                    store_pair16(op + d * 32 + 8 * g, o[d][4 * g] * rs * ga[0], o[d][4 * g + 1] * rs * ga[1], o[d][4 * g + 2] * rs * ga[2], o[d][4 * g + 3] * rs * ga[3],
                                 o[d][4 * g + 4] * rs * gb[0], o[d][4 * g + 5] * rs * gb[1], o[d][4 * g + 6] * rs * gb[2], o[d][4 * g + 7] * rs * gb[3]); }
        }
        __syncthreads();
    }
}

DI void dil_wave_unit(LAS char* wl  , const bf16_t* proj, bf16_t* ob, int wu, int lane) {
    const int r32 = lane & 31, hi = lane >> 5;
    const int bh = wu >> 8, j = wu & 255, b = bh >> 3, h = bh & 7;
    const int tq0 = (j >> 3) * 256 + ((j >> 2) & 1) * 128 + (j & 3);
    const int tq = tq0 + 4 * r32;
    const size_t rowb = (size_t)b * SEQ;
    constexpr float SCALE = 0.08838834764831845f, C2 = 1.4426950408889634f * SCALE;
    bf16x8 qr[8];
    { const bf16_t* qp = proj + (rowb + tq) * INC + C_LQ + h * 128 + hi * 8;
#pragma unroll
      for (int d0 = 0; d0 < 8; ++d0) qr[d0] = *(const bf16x8*)(qp + d0 * 16); }
    f32x16 o[4];
#pragma unroll
    for (int d = 0; d < 4; ++d)
#pragma unroll
        for (int r = 0; r < 16; ++r) o[d][r] = 0.f;
    float m_reg = -1e30f, l_reg = 0.f;
    const bf16_t* kcol = proj + C_LK + h * 128 + hi * 8;
    const bf16_t* vcol = proj + C_LV + h * 128 + (lane >> 5) * 32 + (lane & 3) * 8;
    const int kr = (lane & 31) >> 2;
    for (int tau = 0; tau < 30; ++tau) {
        int ks, dmask, W, kbase;
        if (tau < 5) { ks = 4; dmask = 3; W = 512; kbase = tq0 - 512 + 128 * tau; }
        else if (tau < 22) { ks = 4; dmask = 15; W = 2048; kbase = tq0 - 2048 + 128 * (tau - 5); }
        else { ks = 1; dmask = 0; W = 128; kbase = tq0 - 128 + 32 * (tau - 22); }
        if (kbase + 31 * ks < 0) continue;
        int kp = kbase + ks * r32; kp = kp < 0 ? 0 : (kp > SEQ - 1 ? SEQ - 1 : kp);
        const bf16_t* krow = kcol + (rowb + kp) * INC;
        bf16x8 kf[8];
#pragma unroll
        for (int d0 = 0; d0 < 8; ++d0) kf[d0] = *(const bf16x8*)(krow + d0 * 16);
#pragma unroll
        for (int kg = 0; kg < 4; ++kg) { int vp = kbase + ks * swap23(8 * kg + kr); vp = vp < 0 ? 0 : (vp > SEQ - 1 ? SEQ - 1 : vp);
            const bf16_t* vr = vcol + (rowb + vp) * INC;
            __builtin_amdgcn_global_load_lds((const unsigned*)vr, (LAS unsigned*)(wl + (2 * kg) * 1024), 16, 0, 0);
            __builtin_amdgcn_global_load_lds((const unsigned*)(vr + 64), (LAS unsigned*)(wl + (2 * kg + 1) * 1024), 16, 0, 0); }
        VM_WAIT();
        f32x16 p0, p1;
#pragma unroll
        for (int r = 0; r < 16; ++r) p0[r] = 0.f;
#pragma unroll
        for (int d0 = 0; d0 < 8; ++d0) p0 = __builtin_amdgcn_mfma_f32_32x32x16_bf16(kf[d0], qr[d0], p0, 0, 0, 0);
        { const float NEG = -__builtin_inff(); const int lim = W < tq ? W : tq;
          const int d0v = tq - kbase - ks * 4 * hi;
#pragma unroll
          for (int r = 0; r < 16; ++r) { const int delta = d0v - ks * ((r & 3) + 8 * (r >> 2));
              if ((unsigned)delta > (unsigned)lim || (delta & dmask) != 0) p0[r] = NEG; } }
        float alpha;
        partialSM<1>(p0, p1, m_reg, alpha, C2, SCALE);
        if (__any(alpha < 1.f)) {
#pragma unroll
            for (int d = 0; d < 4; ++d)
#pragma unroll
                for (int r = 0; r < 16; ++r) o[d][r] *= alpha; }
        bf16x8 pa0, pa1, pa2, pa3;
        finishSM<1>(p0, p1, alpha, l_reg, pa0, pa1, pa2, pa3);
        const int vb = (int)(uintptr_t)wl + v_rd_base(lane);
        PV_D0_32(o[0], vb, 0 * 512, 4); PV_D0_32(o[1], vb, 1 * 512, 4); PV_D0_32(o[2], vb, 2 * 512, 4); PV_D0_32(o[3], vb, 3 * 512, 4);
    }
    const float il = __builtin_amdgcn_rcpf(l_reg);
    bf16_t* op = ob + (rowb + tq) * 4096 + 2048 + h * 128 + 8 * hi;
#pragma unroll
    for (int d = 0; d < 4; ++d)
#pragma unroll
        for (int g = 0; g < 4; g += 2)
            store_pair16(op + d * 32 + 8 * g, o[d][4 * g] * il, o[d][4 * g + 1] * il, o[d][4 * g + 2] * il, o[d][4 * g + 3] * il,
                         o[d][4 * g + 4] * il, o[d][4 * g + 5] * il, o[d][4 * g + 6] * il, o[d][4 * g + 7] * il);
}
}
constexpr size_t MiB = 1u << 20;
constexpr size_t WS_CTL = 0, CTL_ZERO_BYTES = 1 * MiB;
constexpr size_t WS_SCAL = 1 * MiB, WS_SLOTA = 116 * MiB, WS_SLOTW = 118 * MiB, WS_CS = 8 * MiB, WS_WR2 = 10 * MiB;
constexpr size_t WS_WIN = 16 * MiB, WS_WMKV = 80 * MiB, WS_WBR = 88 * MiB, WS_WOUT = 104 * MiB, WS_MN = 112 * MiB, WS_KVM = 114 * MiB;
constexpr size_t WS_XN = 128 * MiB, WS_OB = 192 * MiB, WS_MERGED = 320 * MiB, WS_PROJ = 384 * MiB, WS_WGU = 896 * MiB, WS_WD = 1152 * MiB;
constexpr size_t WS_YBUF = 1280 * MiB, WS_XG = 1536 * MiB, WS_ACT = 2560 * MiB, WS_XN8 = 3584 * MiB  , WS_WING8 = 3616 * MiB  , WS_END = 3648 * MiB;
constexpr int CW_QDIFF = 8192, CW_QDIL = 8192 + 512, CW_QMEM = 8192 + 1024  , CW_CNT = 256  , CW_BAR = 4096, CW_JUNK = 3700, CW_KVM = 12288  , CW_QCONV = 12352  ;

#define XB_TMO      128
#define XB_XCNT(j)  (256  + 64 * (j))
#define XB_XSUB(j)  (1280 + 64 * (j))
#define XB_XGEN(j)  (2304 + 64 * (j))
#define XB_TOP      3328
#define XB_TOPGEN   3392
#define XCD_BAR_WORDS 3456
#define XB_SPIN_CAP (1u << 23)
DI unsigned xb_ld(unsigned* p)              { return __hip_atomic_load(p, __ATOMIC_RELAXED, __HIP_MEMORY_SCOPE_AGENT); }
DI unsigned xb_add(unsigned* p, unsigned v) { return __hip_atomic_fetch_add(p, v, __ATOMIC_RELAXED, __HIP_MEMORY_SCOPE_AGENT); }
DI unsigned xb_xcc_id() { return (unsigned)__builtin_amdgcn_s_getreg((3 << 11) | 20) & 0xFu; }
#define XB_SPIN(cond, bar) do { unsigned _sp = 0; while (cond) { __builtin_amdgcn_s_sleep(1); \
    if ((++_sp & 255u) == 0u) { if (xb_ld(&(bar)[XB_TMO])) break; if (_sp > XB_SPIN_CAP) { atomicAdd(&(bar)[XB_TMO], 1u); break; } } } } while (0)
struct XcdBarrier { unsigned* bar; unsigned x; volatile LAS unsigned* st; };
DI XcdBarrier xcd_barrier_post(unsigned* bar, volatile LAS unsigned* st) {
    XcdBarrier b; b.bar = bar; b.x = xb_xcc_id(); b.st = st;
    if (threadIdx.x == 0) (void)xb_add(&bar[XB_XCNT(b.x)], 1u);
    return b;
}
DI void xcd_barrier_complete(unsigned* bar, unsigned x, unsigned& nloc, unsigned& nx) {
    const unsigned G = gridDim.x * gridDim.y * gridDim.z;
    unsigned sum, cnt, mine, sp = 0u;
    for (;;) {
        sum = 0u; cnt = 0u; mine = 0u;
#pragma unroll
        for (unsigned j = 0; j < 16; ++j) { const unsigned c = xb_ld(&bar[XB_XCNT(j)]); sum += c; cnt += (c > 0u) ? 1u : 0u; mine = (j == x) ? c : mine; }
        if (sum == G) break;
        __builtin_amdgcn_s_sleep(1);
        if ((++sp & 255u) == 0u) { if (xb_ld(&bar[XB_TMO])) break; if (sp > XB_SPIN_CAP) { atomicAdd(&bar[XB_TMO], 1u); break; } }
    }
    nloc = mine > 0u ? mine : 1u; nx = cnt > 0u ? cnt : 1u;
}
DI void xcd_barrier(const XcdBarrier& b) {
    asm volatile("s_waitcnt vmcnt(0)" ::: "memory");
    __syncthreads();
    if (threadIdx.x == 0) {
        unsigned* bar = b.bar;
        __builtin_amdgcn_s_waitcnt(0);
        unsigned nloc = b.st[0], nx = b.st[1];
        if (nloc == 0u) { xcd_barrier_complete(bar, b.x, nloc, nx); b.st[0] = nloc; b.st[1] = nx; }
        const unsigned old = xb_add(&bar[XB_XSUB(b.x)], 1u);
        const unsigned gen = old / nloc;
        if (old + 1u == (gen + 1u) * nloc) {
            __builtin_amdgcn_fence(__ATOMIC_RELEASE, "agent");
            asm volatile("s_waitcnt vmcnt(0)" ::: "memory");
            const unsigned og = xb_add(&bar[XB_TOP], 1u);
            const unsigned tg = og / nx;
            if (og + 1u == (tg + 1u) * nx) xb_add(&bar[XB_TOPGEN], 1u);
            else XB_SPIN(xb_ld(&bar[XB_TOPGEN]) == tg, bar);
            __builtin_amdgcn_fence(__ATOMIC_ACQUIRE, "agent");
            xb_add(&bar[XB_XGEN(b.x)], 1u);
            asm volatile("s_waitcnt vmcnt(0)" ::: "memory");
        } else {
            XB_SPIN(xb_ld(&bar[XB_XGEN(b.x)]) == gen, bar);
            __builtin_amdgcn_fence(__ATOMIC_ACQUIRE, "agent");
            asm volatile("s_waitcnt vmcnt(0)" ::: "memory");
        }
    }
    __syncthreads();
}

__device__ const double ROPE_REV[16] = {0.15915494309189535, 0.0700865215877985, 0.03086376340470123, 0.013591370636193905, 0.005985185712713705, 0.002635675898667414, 0.001160663641240061, 0.0005111175045375439, 0.00022507907903927653, 9.911730936901935e-05, 4.364795279280289e-05, 1.9221100684944863e-05, 8.464330808241401e-06, 3.727408601915352e-06, 1.6414262627950345e-06, 7.228293068832865e-07};

DI void t16_load(f32x4 (&v)[16], const float* src, int ldw) {
#pragma unroll
    for (int j = 0; j < 16; ++j) v[j] = __builtin_nontemporal_load((const f32x4*)(src + (size_t)(8 * (j >> 1) + (j & 1)) * ldw));
}
DI void t16_store(const f32x4 (&v)[16], bf16_t* dst, int ldt, LAS unsigned* scr, int lane) {
    const int l15 = lane & 15, l4 = lane >> 4;
#pragma unroll
    for (int jj = 0; jj < 8; ++jj) { const int kp = 4 * jj + l4;
#pragma unroll
        for (int i = 0; i < 4; ++i) scr[(4 * l15 + i) * 33 + kp] = cvt_pk_bf16(v[2 * jj][i], v[2 * jj + 1][i]); }
    LDS_WAIT(); asm volatile("" ::: "memory");
    const int ch = lane & 7, nr = lane >> 3;
#pragma unroll
    for (int i = 0; i < 8; ++i) { const int n = 8 * i + nr; const LAS unsigned* s = scr + n * 33 + 4 * ch; u32x4 w; w.x = s[0]; w.y = s[1]; w.z = s[2]; w.w = s[3];
        *(u32x4*)(dst + (size_t)n * ldt + 8 * ch) = w; }
    LDS_WAIT(); asm volatile("" ::: "memory");
}
DI void f8_decode(int r, const float* wgu, const float* wd, const float* wing, unsigned char* WguT, unsigned char* WdT, unsigned char* WinG8, int lane, const float*& src, unsigned char*& dst, int& ldw) {
    const int l7 = lane & 7, l8 = lane >> 3;
    if (r >= 98304) { r -= 98304; const int k0 = (r / 288) * 128, g = r % 288; ldw = INC;
        const int n0 = g < 64 ? C_DV + 32 * g : (g < 96 ? C_LV + 32 * (g - 64) : C_G + 32 * (g - 96));
        src = wing + (size_t)(k0 + 4 * l8) * INC + n0 + 4 * l7; dst = WinG8 + (size_t)n0 * 2048 + k0; }
    else if (r < 65536) { const int e = r >> 11, q = r & 2047, k0 = (q >> 7) * 128, n0 = (q & 127) * 32; ldw = 4096;
        src = wgu + (size_t)e * 2048 * 4096 + (size_t)(k0 + 4 * l8) * 4096 + n0 + 4 * l7; dst = WguT + (size_t)e * 4096 * 2048 + (size_t)n0 * 2048 + k0; }
    else { r -= 65536; const int e = r >> 10, q = r & 1023, k0 = (q >> 6) * 128, n0 = (q & 63) * 32; ldw = 2048;
        src = wd + (size_t)e * 2048 * 2048 + (size_t)(k0 + 4 * l8) * 2048 + n0 + 4 * l7; dst = WdT + (size_t)e * 2048 * 2048 + (size_t)n0 * 2048 + k0; }
}
DI void f8_load(f32x4 (&v)[16], const float* src, int ldw) {
#pragma unroll
    for (int j = 0; j < 16; ++j) v[j] = __builtin_nontemporal_load((const f32x4*)(src + (size_t)(32 * (j >> 2) + (j & 3)) * ldw));
}
DI void f8_store(const f32x4 (&v)[16], unsigned char* dst, LAS unsigned* scr, int lane) {
    const int l7 = lane & 7, l8 = lane >> 3; constexpr float SC = (float)(1 << pg8::WSH);
#pragma unroll
    for (int jj = 0; jj < 4; ++jj) { const int kq = 8 * jj + l8;
#pragma unroll
        for (int i = 0; i < 4; ++i) scr[(4 * l7 + i) * 33 + kq] = pack4_fp8(v[4 * jj][i] * SC, v[4 * jj + 1][i] * SC, v[4 * jj + 2][i] * SC, v[4 * jj + 3][i] * SC); }
    LDS_WAIT(); asm volatile("" ::: "memory");
    const int ch = lane & 7, nr = lane >> 3;
#pragma unroll
    for (int i = 0; i < 4; ++i) { const int n = 8 * i + nr; const LAS unsigned* s = scr + n * 33 + 4 * ch; u32x4 w; w.x = s[0]; w.y = s[1]; w.z = s[2]; w.w = s[3];
        __builtin_nontemporal_store(w, (u32x4*)(dst + (size_t)n * 2048 + 16 * ch)); }
    LDS_WAIT(); asm volatile("" ::: "memory");
}
template <int NR, bool F8 = false>
DI void rms_rows_to_bf16(const float* xrow, size_t rs, const float* gain, bf16_t* orow, size_t os, int lane, unsigned char* orow8 = nullptr) {
    const f32x4* gr = (const f32x4*)gain + lane;
    f32x4 v[NR][8];
#pragma unroll
    for (int q = 0; q < NR; ++q) { const f32x4* xr = (const f32x4*)(xrow + q * rs) + lane;
#pragma unroll
        for (int j = 0; j < 8; ++j) v[q][j] = __builtin_nontemporal_load(xr + 64 * j); }
#pragma unroll
    for (int q = 0; q < NR; ++q) { float s = 0.f;
#pragma unroll
        for (int j = 0; j < 8; ++j) s += (v[q][j][0] * v[q][j][0] + v[q][j][1] * v[q][j][1]) + (v[q][j][2] * v[q][j][2] + v[q][j][3] * v[q][j][3]);
        const float rstd = __builtin_amdgcn_rsqf(wave_sum(s) * (1.f / 2048.f) + EPS);
        u32x2* o8 = (u32x2*)(orow + q * os) + lane;
#pragma unroll
        for (int j = 0; j < 8; ++j) { const f32x4 g = gr[64 * j]; const float a = v[q][j][0] * rstd * g[0], b = v[q][j][1] * rstd * g[1], c = v[q][j][2] * rstd * g[2], d = v[q][j][3] * rstd * g[3];
            u32x2 w; w.x = cvt_pk_bf16(a, b); w.y = cvt_pk_bf16(c, d); o8[64 * j] = w;
            if (F8) ((unsigned*)(orow8 + q * os) + lane)[64 * j] = pack4_fp8(a, b, c, d); } }
}
enum { I_X = 0, I_MEM, I_POS, I_GMIX, I_WIN, I_BGATE, I_DQN, I_DKN, I_DLAM, I_SUBLN, I_LQN, I_LKN, I_GMEM, I_WMKV, I_MQN, I_MKN, I_WBD, I_WBL, I_WBM, I_WOUT, I_GFFN, I_WR, I_BR, I_WGU, I_BGU, I_WD, I_BD, N_IN };
constexpr int N_PHASES = 9;
struct Args { const void* in[N_IN]; float* out; unsigned char* ws; int ph_lo, ph_hi; int use_bar, pad; };

DI int moe_tables(const unsigned* ctl, LAS int* tab  , int tid) {
    if (tid < 64) { const int e = tid & 31; const unsigned c = __hip_atomic_load(ctl + CW_CNT + 64 * e, __ATOMIC_RELAXED, __HIP_MEMORY_SCOPE_AGENT); int n = (int)((c + 255u) >> 8), s = n;
#pragma unroll
        for (int o = 1; o < 32; o <<= 1) { const int t = __shfl_up(s, o, 32); if ((tid & 31) >= o) s += t; }
        if (tid < 32) { tab[300 + tid + 1] = s; tab[340 + tid] = (int)c; if (tid == 0) tab[300] = 0; } }
    __syncthreads();
    const int nrb = tab[332];
    for (int rb = tid; rb < nrb; rb += NTHR) { int e = 0;
#pragma unroll 1
        for (int k = 1; k < 32; ++k) if (rb >= tab[300 + k]) e = k;
        tab[rb] = e; }
    __syncthreads();
    return nrb;
}

__global__ void __launch_bounds__(NTHR, 2) fwd(Args args) {
    extern __shared__ __attribute__((aligned(16))) unsigned char lds_raw[];
    LAS unsigned char* lds = (LAS unsigned char*)lds_raw;
    volatile LAS unsigned* MISC = (volatile LAS unsigned*)(lds + MISC_OFF);
    const int G = gridDim.x, bx = blockIdx.x, NGW = G * NWAVES;
#define LANE_CONSTS() int tid_ = threadIdx.x; asm volatile("" : "+v"(tid_)); const int tid = tid_, lane = tid & 63, wave = __builtin_amdgcn_readfirstlane(tid >> 6), gw = bx * NWAVES + wave; (void)lane; (void)gw
    unsigned char* ws = args.ws;
    unsigned* ctl = (unsigned*)(ws + WS_CTL);
    if (threadIdx.x < 32) MISC[threadIdx.x] = 0u;
    __syncthreads();
    XcdBarrier bar; bar.bar = ctl + CW_BAR; bar.x = 0; bar.st = nullptr;
    if (args.use_bar) bar = xcd_barrier_post(ctl + CW_BAR, MISC + 8);
    const int lo = args.ph_lo, hi = args.ph_hi;
#ifndef PHASE_MASK
#define PHASE_MASK 0x1ff
#endif
#define IN(k) (((PHASE_MASK >> (k)) & 1) && lo <= (k) && (k) < hi)
#define SEAM(k) do { if (IN(k) && IN((k) + 1)) xcd_barrier(bar); } while (0)

    const float* x = (const float*)args.in[I_X];
    bf16_t* WinT = (bf16_t*)(ws + WS_WIN); bf16_t* WmkvT = (bf16_t*)(ws + WS_WMKV); bf16_t* WbrT = (bf16_t*)(ws + WS_WBR); bf16_t* WoutT = (bf16_t*)(ws + WS_WOUT);
    unsigned char* WguT = ws + WS_WGU; unsigned char* WdT = ws + WS_WD;
    unsigned char* XN8 = ws + WS_XN8; unsigned char* WinG8 = ws + WS_WING8;
    bf16_t* XN = (bf16_t*)(ws + WS_XN); bf16_t* MN = (bf16_t*)(ws + WS_MN); bf16_t* KVM = (bf16_t*)(ws + WS_KVM); bf16_t* PROJ = (bf16_t*)(ws + WS_PROJ);
    bf16_t* OB = (bf16_t*)(ws + WS_OB); bf16_t* MERGED = (bf16_t*)(ws + WS_MERGED); unsigned char* XG = ws + WS_XG; unsigned char* ACT = ws + WS_ACT;
    bf16_t* YBUF = (bf16_t*)(ws + WS_YBUF);
    float* CS = (float*)(ws + WS_CS); float* WR2 = (float*)(ws + WS_WR2); float* SCAL = (float*)(ws + WS_SCAL);
    int* SLOTA = (int*)(ws + WS_SLOTA); float* SLOTW = (float*)(ws + WS_SLOTW);
    float* X1 = args.out;

    if (IN(0)) { LANE_CONSTS();
        LAS unsigned* scr = (LAS unsigned*)(lds + RING_OFF + wave * 16384);
        constexpr int I_IN = 32 * 112  , I_MKV = 32 * 32, I_BD = 32 * 32, I_BL = 16 * 32, I_BM = 16 * 32, I_OUT = 32 * 32, I_GU = 32 * 32 * 64, I_DN = 32 * 32 * 32;
        constexpr int NITEMS = I_IN + I_MKV + I_BD + I_BL + I_BM + I_OUT;
        {
            auto dec = [&](int r, const float*& src, int& ldw, bf16_t*& dst, int& ldt) {
                const float* W; bf16_t* WT; int k0, n0, ko = 0;
                if (r < I_IN) { W = (const float*)args.in[I_WIN]; ldw = INC; WT = WinT; ldt = DM; k0 = (r / 112) * 64; const int j = r % 112; n0 = j < 64 ? 64 * j : (j < 96 ? C_LQ + 64 * (j - 64) : C_MQ + 64 * (j - 96)); }
                else { r -= I_IN; k0 = ((r & 1023) >> 5) * 64; n0 = (r & 31) * 64; ldw = 2048;
                    if (r < 1024) { W = (const float*)args.in[I_WMKV]; WT = WmkvT; ldt = DM; }
                    else if (r < 2048) { W = (const float*)args.in[I_WBD]; WT = WbrT; ldt = 4096; }
                    else if (r < 2560) { W = (const float*)args.in[I_WBL]; WT = WbrT; ldt = 4096; ko = 2048; }
                    else if (r < 3072) { W = (const float*)args.in[I_WBM]; WT = WbrT; ldt = 4096; ko = 3072; k0 = (((r - 2560) & 511) >> 5) * 64; }
                    else { W = (const float*)args.in[I_WOUT]; WT = WoutT; ldt = DM; } }
                src = W + (size_t)(k0 + 2 * (lane >> 4)) * ldw + n0 + 4 * (lane & 15); dst = WT + (size_t)n0 * ldt + ko + k0; };
            f32x4 va[16], vb[16]; const float* s; int ldw, lta = 0, ltb = 0; bf16_t* da = nullptr; bf16_t* db = nullptr;
            int r = gw;
            if (r < NITEMS) { dec(r, s, ldw, da, lta); t16_load(va, s, ldw); }
            if (r + NGW < NITEMS) { dec(r + NGW, s, ldw, db, ltb); t16_load(vb, s, ldw); }
            while (r < NITEMS) {
                t16_store(va, da, lta, scr, lane);
                if (r + 2 * NGW < NITEMS) { dec(r + 2 * NGW, s, ldw, da, lta); t16_load(va, s, ldw); }
                if (r + NGW >= NITEMS) break;
                t16_store(vb, db, ltb, scr, lane);
                if (r + 3 * NGW < NITEMS) { dec(r + 3 * NGW, s, ldw, db, ltb); t16_load(vb, s, ldw); }
                r += 2 * NGW;
            }
        }
        {
            const float* wgu = (const float*)args.in[I_WGU]; const float* wd = (const float*)args.in[I_WD];
            constexpr int F8_LO = I_GU + I_DN, NF8 = I_GU + I_DN + 16 * 288;
            const float* wing = (const float*)args.in[I_WIN];
            f32x4 va[16], vb[16]; const float* s; int ldw; unsigned char* da = nullptr; unsigned char* db = nullptr;
            int r = F8_LO + gw;
            if (r < NF8) { f8_decode(r, wgu, wd, wing, WguT, WdT, WinG8, lane, s, da, ldw); f8_load(va, s, ldw); }
            if (r + NGW < NF8) { f8_decode(r + NGW, wgu, wd, wing, WguT, WdT, WinG8, lane, s, db, ldw); f8_load(vb, s, ldw); }
            while (r < NF8) {
                f8_store(va, da, scr, lane);
                if (r + 2 * NGW < NF8) { f8_decode(r + 2 * NGW, wgu, wd, wing, WguT, WdT, WinG8, lane, s, da, ldw); f8_load(va, s, ldw); }
                if (r + NGW >= NF8) break;
                f8_store(vb, db, scr, lane);
                if (r + 3 * NGW < NF8) { f8_decode(r + 3 * NGW, wgu, wd, wing, WguT, WdT, WinG8, lane, s, db, ldw); f8_load(vb, s, ldw); }
                r += 2 * NGW;
            }
        }
        for (int m = gw; m < T; m += 2 * NGW) {
            if (m + NGW < T) rms_rows_to_bf16<2, true>(x + (size_t)m * DM, (size_t)NGW * DM, (const float*)args.in[I_GMIX], XN + (size_t)m * DM, (size_t)NGW * DM, lane, XN8 + (size_t)m * DM);
            else rms_rows_to_bf16<1, true>(x + (size_t)m * DM, 0, (const float*)args.in[I_GMIX], XN + (size_t)m * DM, 0, lane, XN8 + (size_t)m * DM); }
        for (int m = gw; m < TM; m += NGW) rms_rows_to_bf16<1>((const float*)args.in[I_MEM] + (size_t)m * DM, 0, (const float*)args.in[I_GMEM], MN + (size_t)m * DM, 0, lane);
        { const int* pos = (const int*)args.in[I_POS];
          for (int i = bx * NTHR + tid; i < T * 16; i += G * NTHR) { const int tok = i >> 4, f = i & 15; const double rev = (double)pos[tok] * ROPE_REV[f]; const float fr_ = (float)(rev - __builtin_floor(rev));
              CS[(size_t)tok * 32 + f] = __builtin_amdgcn_cosf(fr_); CS[(size_t)tok * 32 + 16 + f] = __builtin_amdgcn_sinf(fr_); } }
        for (int i = bx * NTHR + tid; i < PSLOTS; i += G * NTHR) SLOTA[i] = -1;
        { const float* wr = (const float*)args.in[I_WR]; const float* gf = (const float*)args.in[I_GFFN];
          for (int i = bx * NTHR + tid; i < 2048 * 32; i += G * NTHR) WR2[i] = wr[i] * gf[i >> 5]; }
        if (bx == 1 && tid < 128) { SCAL[1024 + tid] = ((const float*)args.in[I_DQN])[tid]; SCAL[1024 + 128 + tid] = ((const float*)args.in[I_DKN])[tid];
            SCAL[1024 + 256 + tid] = ((const float*)args.in[I_LQN])[tid]; SCAL[1024 + 384 + tid] = ((const float*)args.in[I_LKN])[tid]; }
        if (bx == 0 && wave == 0) { const float* lp = (const float*)args.in[I_DLAM];
            const float s1 = wave_sum(lp[lane] * lp[128 + lane] + lp[64 + lane] * lp[192 + lane]), s2 = wave_sum(lp[256 + lane] * lp[384 + lane] + lp[320 + lane] * lp[448 + lane]);
            if (lane == 0) SCAL[0] = __expf(s1) - __expf(s2) + LAM_INIT; }
    }
    SEAM(0);

    if (IN(1)) {
        EpiProj<1> E1; E1.out = PROJ; E1.ldc = INC; E1.memkv = 0; E1.gt = SCAL + 1024;
        E1.gmq = (const float*)args.in[I_MQN]; E1.gmk = (const float*)args.in[I_MKN]; E1.bgate = (const float*)args.in[I_BGATE]; E1.cs = CS; E1.P = (LAS float*)(lds + EPIP_OFF);
        SchedGrid S; S.A = (const char*)XN; S.B = (const char*)WinT; S.nM = 64; S.nt = 32; S.G = G; S.c = bx; S.astep = (size_t)256 * DM * 2; S.bstep = (size_t)256 * DM * 2;
        S.nN = 24; S.pn_a = 16; S.pn_skip = 8; S.pn0 = 0;
        pg8::gemm_phase<EpiProj<1>, SchedGrid>(lds + RING_OFF, DM, DM, (size_t)128 * DM * 2, S, E1);
        EpiProj<0> E0; E0.out = PROJ; E0.ldc = INC; E0.memkv = 0; E0.gt = E1.gt; E0.gmq = E1.gmq; E0.gmk = E1.gmk; E0.bgate = E1.bgate; E0.cs = CS; E0.P = E1.P;
        S.nN = 12; S.pn_a = 8; S.pn_skip = 8; S.pn0 = 16;
        { SchedGrid S8 = S; S8.A = (const char*)XN8; S8.B = (const char*)WinG8; S8.nt = 16; S8.astep = (size_t)256 * DM; S8.bstep = (size_t)256 * DM;
          pg8::gemm_phase<EpiProj<0>, SchedGrid, true>(lds + RING_OFF, DM / 2, DM / 2, (size_t)128 * DM, S8, E0); }
        EpiProj<2> E2; E2.out = PROJ; E2.ldc = INC; E2.memkv = 0; E2.gt = E1.gt; E2.gmq = E1.gmq; E2.gmk = E1.gmk; E2.bgate = E1.bgate; E2.cs = CS; E2.P = E1.P;
        S.nN = 4; S.pn_a = 4; S.pn_skip = 0; S.pn0 = 36;
        pg8::gemm_phase<EpiProj<2>, SchedGrid>(lds + RING_OFF, DM, DM, (size_t)128 * DM * 2, S, E2);
        EpiProj<3> E3; E3.out = PROJ; E3.ldc = INC; E3.memkv = 0; E3.gt = E1.gt; E3.gmq = E1.gmq; E3.gmk = E1.gmk; E3.bgate = E1.bgate; E3.cs = CS; E3.P = E1.P;
        S.nN = 24; S.pn_a = 24; S.pn_skip = 0; S.pn0 = 40;
        { SchedGrid S8 = S; S8.A = (const char*)XN8; S8.B = (const char*)WinG8; S8.nt = 16; S8.astep = (size_t)256 * DM; S8.bstep = (size_t)256 * DM;
          pg8::gemm_phase<EpiProj<3>, SchedGrid, true>(lds + RING_OFF, DM / 2, DM / 2, (size_t)128 * DM, S8, E3); }
    }
    SEAM(1);

    if (IN(2)) { LANE_CONSTS(); constexpr int qo = 0;
        const float lam = SCAL[0];
        att::DiffOut dout; dout.ob = OB; dout.subln = (const float*)args.in[I_SUBLN]; dout.lam = lam;
        for (int mu = bx; mu < 16; mu += G) {
            SchedGrid S2; S2.A = (const char*)MN; S2.B = (const char*)WmkvT; S2.nM = 2; S2.nN = 4; S2.nt = 32; S2.G = 1 << 20; S2.c = mu & 7; S2.astep = (size_t)256 * DM * 2; S2.bstep = (size_t)256 * DM * 2;
            S2.pn_a = 4; S2.pn_skip = 0; S2.pn0 = mu < 8 ? 0 : 4;
            if (mu < 8) { EpiProj<2> E2; E2.out = KVM; E2.ldc = 2048; E2.memkv = 1; E2.gt = SCAL + 1024; E2.gmq = (const float*)args.in[I_MQN]; E2.gmk = (const float*)args.in[I_MKN]; E2.bgate = (const float*)args.in[I_BGATE];
                E2.cs = CS; E2.P = (LAS float*)(lds + EPIP_OFF);
                pg8::gemm_phase<EpiProj<2>, SchedGrid>(lds + RING_OFF, DM, DM, (size_t)128 * DM * 2, S2, E2); }
            else { EpiProj<0> E0; E0.out = KVM; E0.ldc = 2048; E0.memkv = 1; E0.gt = SCAL + 1024; E0.gmq = (const float*)args.in[I_MQN]; E0.gmk = (const float*)args.in[I_MKN]; E0.bgate = (const float*)args.in[I_BGATE];
                E0.cs = CS; E0.P = (LAS float*)(lds + EPIP_OFF);
                pg8::gemm_phase<EpiProj<0>, SchedGrid>(lds + RING_OFF, DM, DM, (size_t)128 * DM * 2, S2, E0); }
            if (threadIdx.x == 0) { __builtin_amdgcn_fence(__ATOMIC_RELEASE, "agent"); asm volatile("s_waitcnt vmcnt(0)" ::: "memory"); (void)xb_add(ctl + CW_KVM + qo, 1u); }
        }
        const int xcc = (int)(xb_xcc_id() & 7u);
        auto diff_units = [&]() __attribute__((always_inline)) {
            int t_ = threadIdx.x; asm volatile("" : "+v"(t_)); const int tid = t_, lane = t_ & 63, wave = __builtin_amdgcn_readfirstlane(t_ >> 6); (void)tid; (void)lane; (void)wave;
        for (;;) {
            if (tid == 0) { int u = -1;
                for (int kq = 0; kq < 8 && u < 0; ++kq) { const int q = (xcc + kq) & 7; const unsigned v = xb_add(ctl + CW_QDIFF + qo + 64 * q, 1u); if (v < 128u) u = q * 128 + (int)v; }
                MISC[16] = (unsigned)u; }
            __syncthreads(); const int u = (int)MISC[16]; __syncthreads();
            if (u < 0) break;
            const int q = u >> 7, v = u & 127, bh = 2 * q + (v & 1), qb = 63 - (v >> 1), b = bh >> 3, h = bh & 7, s0 = qb * 128;
            att::CoopArgs a; a.q = PROJ + ((size_t)b * SEQ + s0) * INC + C_DQ + h * 256; a.k0 = PROJ + (size_t)b * SEQ * INC + C_DK + h * 256; a.k1 = a.k0 + 128;
            a.v = PROJ + (size_t)b * SEQ * INC + C_DV + h * 256; a.rsq = INC; a.rsk = INC; a.nt = 2 * (qb + 1);
            att::coop_unit<0>((LAS char*)(lds + RING_OFF), a, s0, 1.4426950408889634f * 0.08838834764831845f, 0.08838834764831845f, OB + ((size_t)b * SEQ + s0) * 4096 + h * 256, 4096, dout);
        }
        };
        auto mem_units = [&](int maxn) __attribute__((always_inline)) {
            int t_ = threadIdx.x; asm volatile("" : "+v"(t_)); const int tid = t_, lane = t_ & 63, wave = __builtin_amdgcn_readfirstlane(t_ >> 6); (void)tid; (void)lane; (void)wave;
            if (tid == 0) { XB_SPIN(xb_ld(ctl + CW_KVM + qo) < 16u, ctl + CW_BAR); __builtin_amdgcn_fence(__ATOMIC_ACQUIRE, "agent"); asm volatile("s_waitcnt vmcnt(0)" ::: "memory"); }
            __syncthreads();
            for (int n = 0; n < maxn; ++n) {
                if (tid == 0) { int u = -1;
                    for (int kq = 0; kq < 8 && u < 0; ++kq) { const int q = (xcc + kq) & 7; const unsigned v = xb_add(ctl + CW_QMEM + qo + 64 * q, 1u); if (v < 64u) u = q * 64 + (int)v; }
                    MISC[16] = (unsigned)u; }
                __syncthreads(); const int u = (int)MISC[16]; __syncthreads();
                if (u < 0) break;
                const int q = u >> 6, b = q >> 2, hm = q & 3, qg = b * 64 + (u & 63);
                att::CoopArgs a; a.q = PROJ + (size_t)qg * 128 * INC + C_MQ + hm * 256; a.k0 = KVM + (size_t)b * MEML * 2048 + hm * 256; a.k1 = a.k0 + 128;
                a.v = KVM + (size_t)b * MEML * 2048 + 1024 + hm * 256; a.rsq = INC; a.rsk = 2048; a.nt = 4;
                att::coop_unit<1>((LAS char*)(lds + RING_OFF), a, 0, 1.4426950408889634f * 0.0625f, 0.0625f, OB + (size_t)qg * 128 * 4096 + 3072 + hm * 256, 4096, dout);
            }
        };
        auto stretch = [&]() __attribute__((always_inline)) {
            int t_ = threadIdx.x; asm volatile("" : "+v"(t_)); const int tid = t_, lane = t_ & 63, wave = __builtin_amdgcn_readfirstlane(t_ >> 6); (void)tid; (void)lane; (void)wave;
        {
            const float* wgu = (const float*)args.in[I_WGU]; const float* wd = (const float*)args.in[I_WD];
            LAS unsigned* scr = (LAS unsigned*)(lds + RING_OFF + wave * 16384);
            constexpr int CBN = 16, NBATCH = (32 * 32 * 64 + 32 * 32 * 32) / CBN;
            bool dil_left = true, conv_left = true;
            auto mix_round = [&]() __attribute__((always_inline)) {
                int t_ = threadIdx.x; asm volatile("" : "+v"(t_)); const int lane = t_ & 63; (void)lane;
                if (dil_left) { int wu = -1;
                    if (lane == 0) { for (int kq = 0; kq < 8 && wu < 0; ++kq) { const int q = (xcc + kq) & 7; const unsigned v = xb_add(ctl + CW_QDIL + qo + 64 * q, 1u); if (v < 512u) wu = (2 * q + (int)(v & 1u)) * 256 + (int)(v >> 1); } }
                    wu = __builtin_amdgcn_readfirstlane(wu);
                    if (wu < 0) dil_left = false; else att::dil_wave_unit((LAS char*)scr, PROJ, OB, wu, lane); }
                for (int rep = 0; rep < 2 && conv_left; ++rep) {
                    int cb = 0; if (lane == 0) cb = (int)xb_add(ctl + CW_QCONV + qo, 1u);
                    cb = __builtin_amdgcn_readfirstlane(cb);
                    if (cb >= NBATCH) { conv_left = false; break; }
                    f32x4 va[16], vb[16]; const float* s; int ldw; unsigned char* da = nullptr; unsigned char* db = nullptr;
                    int r = cb * CBN; const int rend = r + CBN;
                    f8_decode(r, wgu, wd, nullptr, WguT, WdT, nullptr, lane, s, da, ldw); f8_load(va, s, ldw);
                    f8_decode(r + 1, wgu, wd, nullptr, WguT, WdT, nullptr, lane, s, db, ldw); f8_load(vb, s, ldw);
                    while (r < rend) {
                        f8_store(va, da, scr, lane);
                        if (r + 2 < rend) { f8_decode(r + 2, wgu, wd, nullptr, WguT, WdT, nullptr, lane, s, da, ldw); f8_load(va, s, ldw); }
                        f8_store(vb, db, scr, lane);
                        if (r + 3 < rend) { f8_decode(r + 3, wgu, wd, nullptr, WguT, WdT, nullptr, lane, s, db, ldw); f8_load(vb, s, ldw); }
                        r += 2;
                    }
                }
            };
#pragma unroll 1
            for (int it = 0; it < 4; ++it) {
                mix_round();
                if (it == (bx & 3)) { __syncthreads(); mem_units(2); __syncthreads(); }
            }
            while (dil_left || conv_left) mix_round();
        }
        __syncthreads();
        mem_units(1 << 30);
        __syncthreads();
        };
        const bool stretch_first = ((bx >> 3) & 3) == 0;
        if (stretch_first) { stretch(); diff_units(); } else { diff_units(); stretch(); }
    }
    SEAM(2);

    if (IN(3)) {
        EpiBranch E; E.proj = PROJ; E.merged = MERGED;
        SchedBranch S; S.A = (const char*)OB; S.B = (const char*)WbrT; S.G = G; S.c = bx;
        pg8::gemm_phase<EpiBranch, SchedBranch>(lds + RING_OFF, 4096, 4096, (size_t)128 * 4096 * 2, S, E);
    }
    SEAM(3);

    if (IN(4)) {
        EpiOut E; E.x = x; E.x1 = X1;
        SchedGrid S; S.A = (const char*)MERGED; S.B = (const char*)WoutT; S.nM = 64; S.nN = 8; S.nt = 32; S.G = G; S.c = bx; S.astep = (size_t)256 * DM * 2; S.bstep = (size_t)256 * DM * 2; S.pn_a = 8; S.pn_skip = 0; S.pn0 = 0;
        pg8::gemm_phase<EpiOut, SchedGrid>(lds + RING_OFF, DM, DM, (size_t)128 * DM * 2, S, E);
    }
    SEAM(4);

    if (IN(5)) { LANE_CONSTS();
        LAS float* part = (LAS float*)(lds + RING_OFF);
        LAS float* ssp = part + 8 * 32 * 33;
        LAS float* rsd = ssp + 8 * 32;
        LAS unsigned* asl = (LAS unsigned*)(rsd + 32);
        const float* brt = (const float*)args.in[I_BR];
        for (int tt = bx; tt < T / 32; tt += G) {
            const int m = lane & 31, kh = lane >> 5; const size_t tok = (size_t)tt * 32 + m;
            const float* xr = X1 + tok * DM + wave * 256 + 4 * kh; const float* wp = WR2 + (wave * 256 + 4 * kh) * 32 + m;
            f32x16 acc;
#pragma unroll
            for (int r = 0; r < 16; ++r) acc[r] = 0.f;
            float ss = 0.f;
#pragma unroll 8
            for (int c = 0; c < 32; ++c) { const f32x4 xv = *(const f32x4*)(xr + 8 * c); ss += (xv[0] * xv[0] + xv[1] * xv[1]) + (xv[2] * xv[2] + xv[3] * xv[3]);
                const float* w = wp + c * 256;
                acc = __builtin_amdgcn_mfma_f32_32x32x2f32(xv[0], w[0], acc, 0, 0, 0); acc = __builtin_amdgcn_mfma_f32_32x32x2f32(xv[1], w[32], acc, 0, 0, 0);
                acc = __builtin_amdgcn_mfma_f32_32x32x2f32(xv[2], w[64], acc, 0, 0, 0); acc = __builtin_amdgcn_mfma_f32_32x32x2f32(xv[3], w[96], acc, 0, 0, 0); }
            ss += __shfl_xor(ss, 32);
#pragma unroll
            for (int r = 0; r < 16; ++r) part[(wave * 32 + (r & 3) + 8 * (r >> 2) + 4 * kh) * 33 + m] = acc[r];
            if (lane < 32) ssp[wave * 32 + m] = ss;
            __syncthreads();
            if (lane < 4) {
                const int tl = wave * 4 + lane; const size_t tk = (size_t)tt * 32 + tl;
                float s2 = 0.f;
#pragma unroll
                for (int w8 = 0; w8 < 8; ++w8) s2 += ssp[w8 * 32 + tl];
                const float rstd = __builtin_amdgcn_rsqf(s2 * (1.f / 2048.f) + EPS);
                float lg[32];
#pragma unroll
                for (int e = 0; e < 32; ++e) { float a = 0.f;
#pragma unroll
                    for (int w8 = 0; w8 < 8; ++w8) a += part[(w8 * 32 + tl) * 33 + e];
                    lg[e] = a * rstd + brt[e]; }
                unsigned chosen = 0u; float tv[4]; int te[4];
#pragma unroll
                for (int kk = 0; kk < 4; ++kk) { float best = -__builtin_inff(); int bi = 0;
#pragma unroll
                    for (int e = 0; e < 32; ++e) { const float v = ((chosen >> e) & 1u) ? -__builtin_inff() : lg[e]; if (v > best) { best = v; bi = e; } }
                    chosen |= 1u << bi; tv[kk] = best; te[kk] = bi; }
                const float e1 = __expf(tv[1] - tv[0]), e2 = __expf(tv[2] - tv[0]), e3 = __expf(tv[3] - tv[0]); const float inv = 1.f / (1.f + e1 + e2 + e3);
                const float wv[4] = {inv, e1 * inv, e2 * inv, e3 * inv};
                rsd[tl] = rstd;
#pragma unroll
                for (int kk = 0; kk < 4; ++kk) { const unsigned pos = xb_add(ctl + CW_CNT + 64 * te[kk], 1u); const unsigned slot = (unsigned)te[kk] * ECAP + pos;
                    SLOTA[slot] = (int)(tk * 4 + kk); SLOTW[slot] = wv[kk]; asl[tl * 4 + kk] = slot; }
            }
            LDS_WAIT(); asm volatile("" ::: "memory");
            {
                const f32x4* gr = (const f32x4*)args.in[I_GFFN] + lane;
#pragma unroll 1
                for (int q = 0; q < 4; ++q) { const int tl = wave * 4 + q; const size_t tk = (size_t)tt * 32 + tl; const float rstd = rsd[tl];
                    const f32x4* xq = (const f32x4*)(X1 + tk * DM) + lane; unsigned w8[8];
#pragma unroll
                    for (int j = 0; j < 8; ++j) { const f32x4 v = xq[64 * j], g = gr[64 * j]; w8[j] = pack4_fp8(v[0] * rstd * g[0], v[1] * rstd * g[1], v[2] * rstd * g[2], v[3] * rstd * g[3]); }
#pragma unroll
                    for (int kk = 0; kk < 4; ++kk) { unsigned* o4 = (unsigned*)(XG + (size_t)asl[tl * 4 + kk] * DM) + lane;
#pragma unroll
                        for (int j = 0; j < 8; ++j) o4[64 * j] = w8[j]; } }
            }
            __syncthreads();
        }
    }
    SEAM(5);

    if (IN(6)) { LANE_CONSTS();
        LAS int* tab = (LAS int*)(lds + TAB_OFF);
        const int nrb = moe_tables(ctl, tab, tid);
        EpiSwiglu E; E.bgu = (const float*)args.in[I_BGU]; E.act = ACT;
        SchedMoE S; S.A = (const char*)XG; S.B = (const char*)WguT; S.rb2e = tab; S.nrb = nrb; S.NPN = 16; S.G = G; S.c = bx; S.nt = 16; S.apan = (size_t)256 * 2048; S.bexp = (size_t)4096 * 2048; S.bpn = (size_t)128 * 2048;
        pg8::gemm_phase<EpiSwiglu, SchedMoE, true>(lds + RING_OFF, 1024, 1024, (size_t)2048 * 2048, S, E);
    }
    SEAM(6);

    if (IN(7)) { LANE_CONSTS();
        LAS int* tab = (LAS int*)(lds + TAB_OFF);
        const int nrb = moe_tables(ctl, tab, tid);
        EpiDown E; E.bd = (const float*)args.in[I_BD]; E.slot_asg = SLOTA; E.slot_w = SLOTW; E.ybuf = YBUF;
        SchedMoE S; S.A = (const char*)ACT; S.B = (const char*)WdT; S.rb2e = tab; S.nrb = nrb; S.NPN = 8; S.G = G; S.c = bx; S.nt = 16; S.apan = (size_t)256 * 2048; S.bexp = (size_t)2048 * 2048; S.bpn = (size_t)256 * 2048;
        pg8::gemm_phase<EpiDown, SchedMoE, true>(lds + RING_OFF, 1024, 1024, (size_t)128 * 2048, S, E);
    }
    SEAM(7);

    if (IN(8)) { LANE_CONSTS();
        for (size_t i = (size_t)bx * NTHR + tid; i < (size_t)T * 256; i += (size_t)G * NTHR) {
            const size_t t = i >> 8; const int c8 = (int)(i & 255) * 8;
            f32x4 a0 = *(const f32x4*)(X1 + t * DM + c8), a1 = *(const f32x4*)(X1 + t * DM + c8 + 4);
#pragma unroll
            for (int k = 0; k < 4; ++k)
            { const u32x4 y = *(const u32x4*)(YBUF + (t * 4 + k) * DM + c8);
                a0[0] += bf_lo(y.x); a0[1] += bf_hi(y.x); a0[2] += bf_lo(y.y); a0[3] += bf_hi(y.y); a1[0] += bf_lo(y.z); a1[1] += bf_hi(y.z); a1[2] += bf_lo(y.w); a1[3] += bf_hi(y.w); }
            *(f32x4*)(X1 + t * DM + c8) = a0; *(f32x4*)(X1 + t * DM + c8 + 4) = a1;
        }
    }
#undef IN
#undef SEAM
}

#ifndef MK_N_LAUNCHES
#define MK_N_LAUNCHES 1
#endif
extern "C" void kernel_launch(void* const* d_in, const int* in_sizes, int n_in, void* d_out, int out_size, void* d_ws, size_t ws_size, hipStream_t stream) {
    static int grid = 0;
    if (grid == 0) {
        if (n_in != N_IN || out_size != T * DM || ws_size < WS_END) { fprintf(stderr, "kernel_launch: unexpected shapes (n_in %d, out %d, ws %zu)\n", n_in, out_size, ws_size); grid = -1; return; }
        int dev = 0, cus = 0, per_cu = 0;
        if (hipGetDevice(&dev) != hipSuccess || hipDeviceGetAttribute(&cus, hipDeviceAttributeMultiprocessorCount, dev) != hipSuccess) { grid = -1; return; }
        if (hipFuncSetAttribute((const void*)fwd, hipFuncAttributeMaxDynamicSharedMemorySize, LDS_BYTES) != hipSuccess) { fprintf(stderr, "kernel_launch: hipFuncSetAttribute failed\n"); grid = -1; return; }
        if (hipOccupancyMaxActiveBlocksPerMultiprocessor(&per_cu, (const void*)fwd, NTHR, LDS_BYTES) != hipSuccess || per_cu < 1) { fprintf(stderr, "kernel_launch: occupancy query reports %d\n", per_cu); }
        (void)hipGetLastError();
        grid = cus;
    }
    if (grid < 0) return;
    if (hipMemsetAsync((char*)d_ws + WS_CTL, 0, CTL_ZERO_BYTES, stream) != hipSuccess) return;
    Args a{};
    for (int i = 0; i < N_IN; ++i) a.in[i] = d_in[i];
    a.out = (float*)d_out; a.ws = (unsigned char*)d_ws; a.pad = 0;
#if MK_N_LAUNCHES == 1
    a.ph_lo = 0; a.ph_hi = N_PHASES; a.use_bar = 1;
    hipLaunchKernelGGL(fwd, dim3(grid), dim3(NTHR), LDS_BYTES, stream, a);
#else
    for (int p = 0; p < N_PHASES; ++p) { a.ph_lo = p; a.ph_hi = p + 1; a.use_bar = 0; hipLaunchKernelGGL(fwd, dim3(grid), dim3(NTHR), LDS_BYTES, stream, a); }
#endif
}
```

```cpp
#include <hip/hip_runtime.h>
#include <cstdio>
#include <cstdint>
#include <type_traits>

#define GAS __attribute__((address_space(1)))
#define LAS __attribute__((address_space(3)))
typedef unsigned short bf16_t;
typedef short bf16x8 __attribute__((ext_vector_type(8)));
typedef short s16x4 __attribute__((ext_vector_type(4)));
typedef float f32x4 __attribute__((ext_vector_type(4)));
typedef float f32x2 __attribute__((ext_vector_type(2)));
typedef float f32x16 __attribute__((ext_vector_type(16)));
typedef unsigned u32x4 __attribute__((ext_vector_type(4)));
typedef unsigned u32x2 __attribute__((ext_vector_type(2)));
#define DI __device__ __forceinline__
#define VM_WAIT() asm volatile("s_waitcnt vmcnt(0)" ::: "memory")
#define LDS_WAIT() asm volatile("s_waitcnt lgkmcnt(0)" ::: "memory")
#define SBAR() __builtin_amdgcn_sched_barrier(0)

typedef __bf16 bf16x2_t __attribute__((ext_vector_type(2)));
DI unsigned cvt_pk_bf16(float lo, float hi) { const f32x2 v = {lo, hi}; return __builtin_bit_cast(unsigned, __builtin_convertvector(v, bf16x2_t)); }
DI unsigned cvt_pk_bf16_a(float lo, float hi) { unsigned r; asm volatile("s_nop 0\n\tv_cvt_pk_bf16_f32 %0, %1, %2" : "=v"(r) : "v"(lo), "v"(hi)); return r; }
DI float bf_lo(unsigned w) { return __uint_as_float(w << 16); }
DI float bf_hi(unsigned w) { return __uint_as_float(w & 0xffff0000u); }
DI float wave_sum(float v) {
#pragma unroll
    for (int o = 1; o < 64; o <<= 1) v += __shfl_xor(v, o);
    return v;
}

constexpr int BATCH = 2, SEQ = 8192, DM = 2048, T = BATCH * SEQ;
constexpr int MEML = 256, TM = BATCH * MEML;
constexpr int INC = 16384;
constexpr int C_DQ = 0, C_DK = 2048, C_DV = 4096, C_LQ = 6144, C_LK = 7168, C_LV = 8192, C_MQ = 9216, C_G = 10240;
constexpr int NE = 32, TOPK = 4, DFF = 2048;
constexpr int NASG = T * TOPK;
constexpr int ECAP = 16384;
constexpr int PSLOTS = NE * ECAP;
constexpr int MAXRB = PSLOTS / 256;
constexpr float EPS = 1e-6f;
constexpr float LAM_INIT = 0.2f;
constexpr int NWAVES = 8, NTHR = 512;
DI unsigned pack4_fp8(float a, float b, float c, float d) { int w = __builtin_amdgcn_cvt_pk_fp8_f32(a, b, 0, false); w = __builtin_amdgcn_cvt_pk_fp8_f32(c, d, w, true); return (unsigned)w; }
namespace pg8 {
typedef int i32x4 __attribute__((ext_vector_type(4)));
constexpr int WSH = 6; constexpr int WSCALE_E8M0 = (127 - WSH) * 0x01010101;
constexpr int BM = 256, BK = 64, HALF = 128, HTB = HALF * BK * 2  , STAGE_BYTES = 8 * HTB, NXCD = 8, WGM = 8;
__host__ __device__ __forceinline__ int lds_byte(int r, int c) { const int st = (r >> 4) * 2 + (c >> 5), rr = r & 15, cc = c & 31, ob = rr * 64 + cc * 2; return st * 1024 + (ob ^ (((ob >> 9) & 1) << 5)); }
__host__ __device__ __forceinline__ void stage_rc(int b, int& R, int& C) { const int st = b / 1024, sb = b % 1024, swz = sb ^ (((sb >> 9) & 1) << 5); R = (st >> 1) * 16 + swz / 64; C = (st & 1) * 32 + (swz % 64) / 2; }
__host__ __device__ __forceinline__ int perm32(int rho) { const int n = rho >> 4, i = rho & 15; return 8 * (i >> 2) + 4 * n + (i & 3); }

struct GU { const char* A; const char* B; int nt; int pm, pn, tag; int half; };

DI void tile_order(int L, int nM, int nN, int& pm, int& pn) {
    const int nwg = nM * nN; int wgid = L;
    { const int q = nwg / NXCD, r = nwg % NXCD, xcd = wgid % NXCD, off = wgid / NXCD; wgid = (xcd < r ? xcd * (q + 1) : r * (q + 1) + (xcd - r) * q) + off; }
    const int nig = WGM * nN, gid = wgid / nig, fm = gid * WGM, gsz = (nM - fm) < WGM ? (nM - fm) : WGM;
    pm = fm + ((wgid % nig) % gsz); pn = (wgid % nig) / gsz;
}

template <class Epi, class Sched, bool FP8 = false, bool ALIGN_EPI = true, bool SP2 = true>
DI void gemm_phase(LAS unsigned char* lds, const int lda, const int ldb, const size_t hstepB, const Sched& S, const Epi& E) {
    int tid_ = threadIdx.x; asm volatile("" : "+v"(tid_));
    const int tid = tid_, wid = __builtin_amdgcn_readfirstlane(tid >> 6), lane = tid & 63, wr = wid >> 2, wc = (wid + wr) & 3  , fr = lane & 15, fq = lane >> 4;
    unsigned voffA[2], voffB[2];
#pragma unroll
    for (int i = 0; i < 2; ++i) { int R, C; stage_rc(tid * 16 + i * 8192, R, C); const int Rb = Epi::PERM ? ((R & ~31) + perm32(R & 31)) : R;
        voffA[i] = (unsigned)(R * lda + C) * 2u; voffB[i] = (unsigned)(Rb * ldb + C) * 2u; }
    const size_t kstep = (size_t)(BK * 2);
    const size_t hstepA = (size_t)HALF * lda * 2;
    const unsigned ldsw = (unsigned)wid * 1024u;
    const int aoff = lds_byte(wr * 64 + fr, fq * 8), boff = lds_byte(wc * 32 + fr, fq * 8);
#define PG8_SA(b, h) (((b) * 2 + (h)) * HTB)
#define PG8_SB(b, h) ((4 + (b) * 2 + (h)) * HTB)
#define PG8_STAGE(bufoff, gbase, voff) do { _Pragma("unroll") for (int _i = 0; _i < 2; ++_i) \
        __builtin_amdgcn_global_load_lds((const unsigned*)((const char*)(gbase) + (voff)[_i]), (LAS unsigned*)(lds + (bufoff) + ldsw + _i * 8192), 16, 0, 0); } while (0)
#define PG8_LD1(dst, i_, off) do { if constexpr (FP8) { const i32x4 _p0 = *(const LAS i32x4*)(lds + (off)), _p1 = *(const LAS i32x4*)(lds + (off) + 1024); dst##8[i_] = __builtin_shufflevector(_p0, _p1, 0, 1, 2, 3, 4, 5, 6, 7); } \
        else { dst[i_][0] = *(const LAS bf16x8*)(lds + (off)); dst[i_][1] = *(const LAS bf16x8*)(lds + (off) + 1024); } } while (0)
#define PG8_LDA(dst, b, h) do { _Pragma("unroll") for (int m = 0; m < 4; ++m) PG8_LD1(dst, m, PG8_SA(b, h) + aoff + m * 2048); } while (0)
#define PG8_LDB(dst, b, h) do { _Pragma("unroll") for (int n = 0; n < 2; ++n) PG8_LD1(dst, n, PG8_SB(b, h) + boff + n * 2048); } while (0)
#define PG8_CAT(x0, x1) __builtin_shufflevector(__builtin_bit_cast(i32x4, x0), __builtin_bit_cast(i32x4, x1), 0, 1, 2, 3, 4, 5, 6, 7)
#define PG8_MMA(ai, bj, At, Bt) do { __builtin_amdgcn_s_setprio(1); _Pragma("unroll") for (int m = 0; m < 4; ++m) _Pragma("unroll") for (int n = 0; n < 2; ++n) { \
        if constexpr (FP8) asm volatile("v_mfma_scale_f32_16x16x128_f8f6f4 %0, %1, %2, %0, %3, %4 op_sel_hi:[0,0,0]" : "+v"(acc[ai][bj][m][n]) : "v"(Bt##8[n]), "v"(At##8[m]), "v"(wscale), "v"(ascale)); \
        else { _Pragma("unroll") for (int k = 0; k < 2; ++k) acc[ai][bj][m][n] = __builtin_amdgcn_mfma_f32_16x16x32_bf16(Bt[n][k], At[m][k], acc[ai][bj][m][n], 0, 0, 0); } } __builtin_amdgcn_s_setprio(0); } while (0)
#define PG8_WAIT_V(n) asm volatile("s_waitcnt vmcnt(" #n ")" ::: "memory")
#define PG8_WAIT_L(n) asm volatile("s_waitcnt lgkmcnt(" #n ")" ::: "memory")
#define PG8_BAR __builtin_amdgcn_s_barrier()
#define PG8_SCHED __builtin_amdgcn_sched_barrier(0)
    typedef int i32x8 __attribute__((ext_vector_type(8)));
    int wscale = WSCALE_E8M0, ascale = 0x7f7f7f7f; if constexpr (FP8) asm volatile("" : "+v"(wscale), "+v"(ascale));
    GU cur, nxt; int ui = 0;
    if (!S.next(0, cur)) return;
    f32x4 acc[2][2][4][2];
#pragma unroll
    for (int a = 0; a < 2; ++a)
#pragma unroll
        for (int b = 0; b < 2; ++b)
#pragma unroll
            for (int m = 0; m < 4; ++m)
#pragma unroll
                for (int n = 0; n < 2; ++n) acc[a][b][m][n] = (f32x4){0.f, 0.f, 0.f, 0.f};
    bf16x8 At[4][2], B0[2][2], B1[2][2];
    i32x8 At8[4], B08[2], B18[2];
    const char* cA = cur.A; const char* cB = cur.B;
    if constexpr (SP2) {
        PG8_STAGE(PG8_SB(0, 0), cB, voffB); PG8_STAGE(PG8_SB(0, 1), cB + hstepB, voffB); PG8_STAGE(PG8_SA(0, 0), cA, voffA); PG8_STAGE(PG8_SA(0, 1), cA + hstepA, voffA);
        if (wr == 1) PG8_BAR;
        PG8_WAIT_V(2); PG8_BAR;
        PG8_STAGE(PG8_SB(1, 0), cB + kstep, voffB); PG8_STAGE(PG8_SA(1, 0), cA + kstep, voffA); PG8_STAGE(PG8_SB(1, 1), cB + hstepB + kstep, voffB);
        PG8_WAIT_V(6); PG8_BAR;
    } else {
        PG8_STAGE(PG8_SB(0, 0), cB, voffB); PG8_STAGE(PG8_SA(0, 0), cA, voffA); PG8_STAGE(PG8_SB(0, 1), cB + hstepB, voffB); PG8_STAGE(PG8_SA(0, 1), cA + hstepA, voffA);
        if (wr == 1) PG8_BAR;
        PG8_WAIT_V(4); PG8_BAR;
        PG8_STAGE(PG8_SB(1, 0), cB + kstep, voffB); PG8_STAGE(PG8_SA(1, 0), cA + kstep, voffA); PG8_STAGE(PG8_SB(1, 1), cB + hstepB + kstep, voffB);
        PG8_WAIT_V(6); PG8_BAR;
    }
    for (;;) {
        const bool has_next = S.next(ui + 1, nxt);
        const char* nA = has_next ? nxt.A : cA; const char* nB = has_next ? nxt.B : cB;
        const int nt = cur.nt; const bool half1 = FP8 && cur.half != 0;
        for (int t = 0; t < nt; t += 2) {
            const bool last = (t == nt - 2);
            const char* a1 = cA + (size_t)(t + 1) * kstep;
            const char* a2 = last ? nA : cA + (size_t)(t + 2) * kstep; const char* b2 = last ? nB : cB + (size_t)(t + 2) * kstep;
            const char* a3 = a2 + kstep; const char* b3 = b2 + kstep;
            if constexpr (SP2) {
            PG8_LDB(B0, 0, 0); PG8_LDB(B1, 0, 1); PG8_SCHED; PG8_LDA(At, 0, 0); PG8_STAGE(PG8_SA(1, 1), a1 + hstepA, voffA);
            PG8_WAIT_V(8); PG8_WAIT_L(0); PG8_BAR; PG8_MMA(0, 0, At, B0); PG8_MMA(0, 1, At, B1); PG8_BAR; PG8_SCHED;
            if (!half1) PG8_LDA(At, 0, 1); PG8_STAGE(PG8_SB(0, 0), b2, voffB); PG8_STAGE(PG8_SB(0, 1), b2 + hstepB, voffB); PG8_STAGE(PG8_SA(0, 0), a2, voffA);
            PG8_WAIT_V(8); PG8_WAIT_L(0); PG8_BAR; if (!half1) { PG8_MMA(1, 0, At, B0); PG8_MMA(1, 1, At, B1); } PG8_BAR; PG8_SCHED;
            PG8_LDB(B0, 1, 0); PG8_LDB(B1, 1, 1); PG8_SCHED; PG8_LDA(At, 1, 0); PG8_STAGE(PG8_SA(0, 1), a2 + hstepA, voffA);
            PG8_WAIT_V(8); PG8_WAIT_L(0); PG8_BAR; PG8_MMA(0, 0, At, B0); PG8_MMA(0, 1, At, B1); PG8_BAR; PG8_SCHED;
            if (!half1) PG8_LDA(At, 1, 1); PG8_STAGE(PG8_SB(1, 0), b3, voffB); PG8_STAGE(PG8_SB(1, 1), b3 + hstepB, voffB); PG8_STAGE(PG8_SA(1, 0), a3, voffA);
            PG8_WAIT_V(8); PG8_WAIT_L(0); PG8_BAR; if (!half1) { PG8_MMA(1, 0, At, B0); PG8_MMA(1, 1, At, B1); } PG8_BAR; PG8_SCHED;
            } else {
            PG8_LDB(B0, 0, 0); PG8_SCHED; PG8_LDA(At, 0, 0); PG8_STAGE(PG8_SA(1, 1), a1 + hstepA, voffA);
            PG8_WAIT_L(8); PG8_BAR; PG8_WAIT_L(0); PG8_MMA(0, 0, At, B0); PG8_BAR; PG8_SCHED;
            PG8_LDB(B1, 0, 1); PG8_STAGE(PG8_SB(0, 0), b2, voffB);
            PG8_BAR; PG8_WAIT_L(0); PG8_MMA(0, 1, At, B1); PG8_BAR;
            PG8_LDA(At, 0, 1); PG8_STAGE(PG8_SA(0, 0), a2, voffA);
            PG8_BAR; PG8_WAIT_L(0); PG8_MMA(1, 0, At, B0); PG8_BAR; PG8_SCHED;
            PG8_STAGE(PG8_SB(0, 1), b2 + hstepB, voffB);
            PG8_WAIT_V(6); PG8_BAR; PG8_MMA(1, 1, At, B1); PG8_BAR;
            PG8_LDB(B0, 1, 0); PG8_SCHED; PG8_LDA(At, 1, 0); PG8_STAGE(PG8_SA(0, 1), a2 + hstepA, voffA);
            PG8_WAIT_L(8); PG8_BAR; PG8_WAIT_L(0); PG8_MMA(0, 0, At, B0); PG8_BAR; PG8_SCHED;
            PG8_LDB(B1, 1, 1); PG8_STAGE(PG8_SB(1, 0), b3, voffB);
            PG8_BAR; PG8_WAIT_L(0); PG8_MMA(0, 1, At, B1); PG8_BAR;
            PG8_LDA(At, 1, 1); PG8_STAGE(PG8_SA(1, 0), a3, voffA);
            PG8_BAR; PG8_WAIT_L(0); PG8_MMA(1, 0, At, B0); PG8_BAR; PG8_SCHED;
            PG8_STAGE(PG8_SB(1, 1), b3 + hstepB, voffB);
            PG8_WAIT_V(6); PG8_BAR; PG8_MMA(1, 1, At, B1); PG8_BAR;
            }
        }
        if constexpr (ALIGN_EPI) { if (wr == 0) PG8_BAR; }
        if constexpr (FP8) {
            asm volatile("s_nop 15\n\ts_nop 15" ::: "memory");
#pragma unroll
            for (int a = 0; a < 2; ++a)
#pragma unroll
                for (int b = 0; b < 2; ++b)
#pragma unroll
                    for (int m = 0; m < 4; ++m)
#pragma unroll
                        for (int n = 0; n < 2; ++n) asm volatile("" : "+v"(acc[a][b][m][n]));
        }
        const bool keep = E(acc, cur, wr, wc, fr, fq);
        if (!has_next) break;
        if (!keep) {
#pragma unroll
            for (int a = 0; a < 2; ++a)
#pragma unroll
                for (int b = 0; b < 2; ++b)
#pragma unroll
                    for (int m = 0; m < 4; ++m)
#pragma unroll
                        for (int n = 0; n < 2; ++n) acc[a][b][m][n] = (f32x4){0.f, 0.f, 0.f, 0.f};
        }
        cur = nxt; cA = nA; cB = nB; ++ui;
        if constexpr (ALIGN_EPI) { if (wr == 1) PG8_BAR; }
    }
    PG8_WAIT_V(0);
    if constexpr (!ALIGN_EPI) { if (wr == 0) PG8_BAR; }
    PG8_BAR;
#undef PG8_SA
#undef PG8_SB
#undef PG8_STAGE
#undef PG8_LD1
#undef PG8_LDA
#undef PG8_LDB
#undef PG8_MMA
#undef PG8_CAT
#undef PG8_WAIT_V
#undef PG8_WAIT_L
#undef PG8_BAR
#undef PG8_SCHED
}
}
constexpr int RING_OFF = 0, RING_BYTES = 131072;
constexpr int EPIP_OFF = RING_BYTES;
constexpr int TAB_OFF = EPIP_OFF + 8192;
constexpr int MISC_OFF = TAB_OFF + 2048;
constexpr int LDS_BYTES = 147456;
static_assert(MISC_OFF + 128 <= LDS_BYTES, "LDS map");

struct SchedGrid {
    const char* A; const char* B; int nM, nN, nt, G, c; size_t astep, bstep;
    int pn0, pn_a, pn_skip;
    DI bool next(int i, pg8::GU& u) const {
        const long L = (long)i * G + c; if (L >= (long)nM * nN) return false;
        int pm, pn; pg8::tile_order((int)L, nM, nN, pm, pn);
        pn = pn0 + pn + (pn >= pn_a ? pn_skip : 0);
        u.pm = pm; u.pn = pn; u.tag = 0; u.half = 0; u.nt = nt; u.A = A + (size_t)pm * astep; u.B = B + (size_t)pn * bstep; return true;
    }
};
struct SchedBranch {
    const char* A; const char* B; int G, c;
    DI bool next(int i, pg8::GU& u) const {
        const int ti = i / 3, sub = i - ti * 3; const long L = (long)ti * G + c; if (L >= 64 * 8) return false;
        int pm, pn; pg8::tile_order((int)L, 64, 8, pm, pn);
        const int koff = sub == 0 ? 0 : (sub == 1 ? 2048 : 3072);
        u.pm = pm; u.pn = pn; u.tag = sub; u.half = 0; u.nt = sub == 0 ? 32 : 16;
        u.A = A + ((size_t)pm * 256 * 4096 + koff) * 2; u.B = B + ((size_t)pn * 256 * 4096 + koff) * 2; return true;
    }
};
struct SchedMoE {
    const char* A; const char* B; const LAS int* rb2e; int nrb, NPN, G, c, nt; size_t apan, bexp, bpn;
    DI bool next(int i, pg8::GU& u) const {
        const long L = (long)i * G + c; if (L >= (long)nrb * NPN) return false;
        const int rb = (int)(L / NPN), pn = (int)(L - (long)rb * NPN); const int e = rb2e[rb];
        const int pm = e * (ECAP / 256) + (rb - rb2e[300 + e]);
        u.pm = pm; u.pn = pn; u.tag = e; u.nt = nt;
        u.half = rb2e[340 + e] - (rb - rb2e[300 + e]) * 256 <= 128;
        u.A = A + (size_t)pm * apan; u.B = B + (size_t)e * bexp + (size_t)pn * bpn; return true;
    }
};

typedef f32x4 AccT[2][2][4][2];
DI float sigmoidf_(float v) { v = fmaxf(v, -80.f); return __builtin_amdgcn_rcpf(1.f + __builtin_amdgcn_exp2f(-1.4426950408889634f * v)); }

template <int TYPE  > struct EpiProj {
    static constexpr bool PERM = true;
    bf16_t* out; int ldc; int memkv;
    const float *gt, *gmq, *gmk, *bgate; const float* cs;
    LAS float* P;
    DI bool operator()(AccT& acc, const pg8::GU& u, int wr, int wc, int fr, int fq) const {
        asm volatile("" : "+v"(fr), "+v"(fq));
        const float* gain = nullptr;
        const int pn = u.pn;
        if (TYPE == 2) gain = memkv ? gmk : gmq;
        if (TYPE == 1) gain = gt + (pn < 16 ? (pn >> 3) : 2 + ((pn - 24) >> 2)) * 128;
        const int rloc0 = wr * 64 + fr, cloc0 = wc * 32 + 8 * fq;
        if (TYPE == 1 || TYPE == 2) {
            const bool dorope = (TYPE == 1) && wc == 0;
            constexpr int NS = 3;
            f32x4 cc[NS][2], ss[NS][2];
            if (dorope) {
#pragma unroll
                for (int m = 0; m < NS; ++m) { const float* cp = cs + ((size_t)u.pm * 256 + rloc0 + m * 16) * 32 + 8 * (fq & 1);
#pragma unroll
                    for (int n = 0; n < 2; ++n) { cc[m][n] = *(const f32x4*)(cp + 4 * n); ss[m][n] = *(const f32x4*)(cp + 16 + 4 * n); } } }
            constexpr int NG = TYPE == 2 ? 2 : 1;
            f32x4 g[NG][2];
#pragma unroll
            for (int bj = 0; bj < NG; ++bj)
#pragma unroll
                for (int n = 0; n < 2; ++n) g[bj][n] = *(const f32x4*)(gain + bj * 128 + cloc0 + n * 4);
            asm volatile("" ::: "memory");
#pragma unroll
            for (int ai = 0; ai < 2; ++ai)
#pragma unroll
                for (int m = 0; m < 4; ++m)
#pragma unroll
                    for (int bj = 0; bj < 2; ++bj) { float s = 0.f;
#pragma unroll
                        for (int n = 0; n < 2; ++n) { const f32x4 x = acc[ai][bj][m][n]; s += (x[0] * x[0] + x[1] * x[1]) + (x[2] * x[2] + x[3] * x[3]); }
                        s += __shfl_xor(s, 16); s += __shfl_xor(s, 32);
                        if (fq == 0) P[(ai * 128 + rloc0 + m * 16) * 8 + bj * 4 + wc] = s; }
            LDS_WAIT(); __builtin_amdgcn_s_barrier(); asm volatile("" ::: "memory");
#pragma unroll
            for (int ai = 0; ai < 2; ++ai)
#pragma unroll
                for (int m = 0; m < 4; ++m) {
                    const LAS f32x4* pr = (const LAS f32x4*)(P + (ai * 128 + rloc0 + m * 16) * 8);
                    const f32x4 p0 = pr[0], p1 = pr[1];
                    const float t0 = (p0[0] + p0[1]) + (p0[2] + p0[3]), t1 = (p1[0] + p1[1]) + (p1[2] + p1[3]);
                    float r0, r1;
                    if (TYPE == 1) { r0 = __builtin_amdgcn_rsqf(t0 * (1.f / 128.f) + EPS); r1 = __builtin_amdgcn_rsqf(t1 * (1.f / 128.f) + EPS); }
                    else { r0 = r1 = __builtin_amdgcn_rsqf((t0 + t1) * (1.f / 256.f) + EPS); }
#pragma unroll
                    for (int n = 0; n < 2; ++n) { acc[ai][0][m][n] = acc[ai][0][m][n] * r0 * g[0][n]; acc[ai][1][m][n] = acc[ai][1][m][n] * r1 * g[NG - 1][n]; }
                    if (dorope) {
#pragma unroll
                        for (int n = 0; n < 2; ++n) { const f32x4 c = cc[(ai * 4 + m) % NS][n], s = ss[(ai * 4 + m) % NS][n];
#pragma unroll
                            for (int bj = 0; bj < 2; ++bj)
#pragma unroll
                                for (int jp = 0; jp < 4; jp += 2) {
                                    const float cs_ = fq < 2 ? c[jp] : c[jp + 1], sn_ = fq < 2 ? s[jp] : s[jp + 1];
                                    auto r1 = __builtin_amdgcn_permlane32_swap(__float_as_uint(acc[ai][bj][m][n][jp]), __float_as_uint(acc[ai][bj][m][n][jp + 1]), false, false);
                                    const float u1 = __uint_as_float(r1[0]), u2 = __uint_as_float(r1[1]);
                                    const float o1 = u1 * cs_ - u2 * sn_, o2 = u2 * cs_ + u1 * sn_;
                                    auto r2 = __builtin_amdgcn_permlane32_swap(__float_as_uint(o1), __float_as_uint(o2), false, false);
                                    acc[ai][bj][m][n][jp] = __uint_as_float(r2[0]); acc[ai][bj][m][n][jp + 1] = __uint_as_float(r2[1]); } }
                        if (ai * 4 + m + NS < 8) {
                            constexpr int dummy = 0; (void)dummy; const int rn = ai * 4 + m + NS;
                            const float* cp = cs + ((size_t)u.pm * 256 + (rn >> 2) * 128 + rloc0 + (rn & 3) * 16) * 32 + 8 * (fq & 1);
#pragma unroll
                            for (int n = 0; n < 2; ++n) { cc[(ai * 4 + m) % NS][n] = *(const f32x4*)(cp + 4 * n); ss[(ai * 4 + m) % NS][n] = *(const f32x4*)(cp + 16 + 4 * n); } }
                    }
                    asm volatile("" : "+v"(acc[ai][0][m][0]), "+v"(acc[ai][0][m][1]), "+v"(acc[ai][1][m][0]), "+v"(acc[ai][1][m][1]));
#pragma unroll
                    for (int bj = 0; bj < 2; ++bj) { const f32x4 v0 = acc[ai][bj][m][0], v1 = acc[ai][bj][m][1]; u32x4 w;
                        w.x = cvt_pk_bf16(v0[0], v0[1]); w.y = cvt_pk_bf16(v0[2], v0[3]); w.z = cvt_pk_bf16(v1[0], v1[1]); w.w = cvt_pk_bf16(v1[2], v1[3]);
                        *(u32x4*)(out + ((size_t)u.pm * 256 + ai * 128 + rloc0 + m * 16) * ldc + pn * 256 + cloc0 + bj * 128) = w; }
                    asm volatile("" ::: "memory");
                }
            return false;
        } else if (TYPE == 3) {
            const int cb = pn * 256 - C_G + cloc0;
            f32x4 bvv[2][2];
#pragma unroll
            for (int bj = 0; bj < 2; ++bj)
#pragma unroll
                for (int n = 0; n < 2; ++n) bvv[bj][n] = *(const f32x4*)(bgate + cb + bj * 128 + n * 4);
            asm volatile("" ::: "memory");
#pragma unroll
            for (int ai = 0; ai < 2; ++ai)
#pragma unroll
                for (int m = 0; m < 4; ++m) {
#pragma unroll
                    for (int bj = 0; bj < 2; ++bj)
#pragma unroll
                        for (int n = 0; n < 2; ++n) { f32x4 v = acc[ai][bj][m][n] + bvv[bj][n];
                            v[0] = sigmoidf_(v[0]); v[1] = sigmoidf_(v[1]); v[2] = sigmoidf_(v[2]); v[3] = sigmoidf_(v[3]); acc[ai][bj][m][n] = v; }
#pragma unroll
                    for (int bj = 0; bj < 2; ++bj) { const f32x4 v0 = acc[ai][bj][m][0], v1 = acc[ai][bj][m][1]; u32x4 w;
                        w.x = cvt_pk_bf16(v0[0], v0[1]); w.y = cvt_pk_bf16(v0[2], v0[3]); w.z = cvt_pk_bf16(v1[0], v1[1]); w.w = cvt_pk_bf16(v1[2], v1[3]);
                        *(u32x4*)(out + ((size_t)u.pm * 256 + ai * 128 + rloc0 + m * 16) * ldc + pn * 256 + cloc0 + bj * 128) = w; }
                    asm volatile("" ::: "memory");
                }
            return false;
        }
#pragma unroll
        for (int ai = 0; ai < 2; ++ai)
#pragma unroll
            for (int m = 0; m < 4; ++m) { bf16_t* rowp = out + ((size_t)u.pm * 256 + ai * 128 + rloc0 + m * 16) * ldc + pn * 256 + cloc0;
#pragma unroll
                for (int bj = 0; bj < 2; ++bj) { const f32x4 v0 = acc[ai][bj][m][0], v1 = acc[ai][bj][m][1]; u32x4 w;
                    w.x = cvt_pk_bf16(v0[0], v0[1]); w.y = cvt_pk_bf16(v0[2], v0[3]); w.z = cvt_pk_bf16(v1[0], v1[1]); w.w = cvt_pk_bf16(v1[2], v1[3]);
                    *(u32x4*)(rowp + bj * 128) = w; } }
        return false;
    }
};

struct EpiBranch {
    static constexpr bool PERM = true; static constexpr int EB_ROWS = 4;
    const bf16_t* proj; bf16_t* merged;
    DI bool operator()(AccT& acc, const pg8::GU& u, int wr, int wc, int fr, int fq) const {
        asm volatile("" : "+v"(fr), "+v"(fq));
        const int sub = u.tag; const int rloc0 = wr * 64 + fr, col0 = u.pn * 256 + wc * 32 + 8 * fq;
        const int oa = sub * 2048, ob = (sub < 2 ? sub + 1 : 2) * 2048;
        const bool ratio = sub < 2;
#pragma unroll
        for (int am = 0; am < 8; am += EB_ROWS) {
            u32x4 A[EB_ROWS][2], B[EB_ROWS][2];
#pragma unroll
            for (int q = 0; q < EB_ROWS; ++q)
#pragma unroll
                for (int bj = 0; bj < 2; ++bj) { const int ai = (am + q) >> 2, m = (am + q) & 3; const bf16_t* gp = proj + ((size_t)u.pm * 256 + ai * 128 + rloc0 + m * 16) * INC + C_G + col0 + bj * 128;
                    A[q][bj] = *(const u32x4*)(gp + oa); B[q][bj] = *(const u32x4*)(gp + ob); }
            asm volatile("" ::: "memory");
#pragma unroll
            for (int q = 0; q < EB_ROWS; ++q) { const int ai = (am + q) >> 2, m = (am + q) & 3;
#pragma unroll
                for (int bj = 0; bj < 2; ++bj) { const u32x4 a = A[q][bj], b = B[q][bj];
#define EB_F(av, bv) ((av) * (ratio ? __builtin_amdgcn_rcpf(bv) : 1.f))
                    const f32x4 f0 = {EB_F(bf_lo(a.x), bf_lo(b.x)), EB_F(bf_hi(a.x), bf_hi(b.x)), EB_F(bf_lo(a.y), bf_lo(b.y)), EB_F(bf_hi(a.y), bf_hi(b.y))};
                    const f32x4 f1 = {EB_F(bf_lo(a.z), bf_lo(b.z)), EB_F(bf_hi(a.z), bf_hi(b.z)), EB_F(bf_lo(a.w), bf_lo(b.w)), EB_F(bf_hi(a.w), bf_hi(b.w))};
#undef EB_F
                    acc[ai][bj][m][0] = acc[ai][bj][m][0] * f0; acc[ai][bj][m][1] = acc[ai][bj][m][1] * f1; } }
            asm volatile("" ::: "memory");
        }
        if (sub == 2) {
#pragma unroll
            for (int ai = 0; ai < 2; ++ai)
#pragma unroll
                for (int m = 0; m < 4; ++m) { const size_t row = (size_t)u.pm * 256 + ai * 128 + rloc0 + m * 16;
#pragma unroll
                    for (int bj = 0; bj < 2; ++bj) { const f32x4 v0 = acc[ai][bj][m][0], v1 = acc[ai][bj][m][1]; u32x4 w;
                        w.x = cvt_pk_bf16(v0[0], v0[1]); w.y = cvt_pk_bf16(v0[2], v0[3]); w.z = cvt_pk_bf16(v1[0], v1[1]); w.w = cvt_pk_bf16(v1[2], v1[3]);
                        *(u32x4*)(merged + row * DM + col0 + bj * 128) = w; } }
        }
        return sub < 2;
    }
};

struct EpiOut {
    static constexpr bool PERM = true;
    const float* x; bf16_t* x1;
    DI bool operator()(AccT& acc, const pg8::GU& u, int wr, int wc, int fr, int fq) const {
        const int rloc0 = wr * 64 + fr, col0 = u.pn * 256 + wc * 32 + 8 * fq;
#pragma unroll
        for (int ai = 0; ai < 2; ++ai)
            { f32x4 xv[4][2][2];
#pragma unroll
              for (int m = 0; m < 4; ++m) { const size_t off = ((size_t)u.pm * 256 + ai * 128 + rloc0 + m * 16) * DM + col0;
#pragma unroll
                for (int bj = 0; bj < 2; ++bj)
#pragma unroll
                    for (int n = 0; n < 2; ++n) xv[m][bj][n] = __builtin_nontemporal_load((const f32x4*)(x + off + bj * 128 + n * 4)); }
              asm volatile("" ::: "memory");
#pragma unroll
              for (int m = 0; m < 4; ++m) { const size_t off = ((size_t)u.pm * 256 + ai * 128 + rloc0 + m * 16) * DM + col0;
#pragma unroll
                for (int bj = 0; bj < 2; ++bj) { const f32x4 v0 = xv[m][bj][0] + acc[ai][bj][m][0], v1 = xv[m][bj][1] + acc[ai][bj][m][1]; u32x4 w;
                    w.x = cvt_pk_bf16(v0[0], v0[1]); w.y = cvt_pk_bf16(v0[2], v0[3]); w.z = cvt_pk_bf16(v1[0], v1[1]); w.w = cvt_pk_bf16(v1[2], v1[3]);
                    *(u32x4*)(x1 + off + bj * 128) = w; } }
              asm volatile("" ::: "memory"); }
        return false;
    }
};

struct EpiSwiglu {
    static constexpr bool PERM = true;
    const float* bgu; unsigned char* act;
    DI bool operator()(AccT& acc, const pg8::GU& u, int wr, int wc, int fr, int fq) const {
        const int rloc0 = wr * 64 + fr, cc = wc * 32 + 8 * fq, gcol = u.pn * 128 + cc; const float* bp = bgu + (size_t)u.tag * 4096 + gcol;
        const f32x4 bg0 = *(const f32x4*)bp, bg1 = *(const f32x4*)(bp + 4), bu0 = *(const f32x4*)(bp + 2048), bu1 = *(const f32x4*)(bp + 2052);
#pragma unroll
        for (int ai = 0; ai < 2; ++ai)
#pragma unroll
            for (int m = 0; m < 4; ++m) { const size_t row = (size_t)u.pm * 256 + ai * 128 + rloc0 + m * 16;
                f32x4 r[2];
#pragma unroll
                for (int n = 0; n < 2; ++n) { const f32x4 gt = acc[ai][0][m][n] + (n ? bg1 : bg0), up = acc[ai][1][m][n] + (n ? bu1 : bu0);
#pragma unroll
                    for (int j = 0; j < 4; ++j) { const float g = fminf(gt[j], 7.f), uu = fminf(fmaxf(up[j], -7.f), 7.f);
                        r[n][j] = (uu + 1.f) * g * __builtin_amdgcn_rcpf(1.f + __builtin_amdgcn_exp2f(-1.702f * 1.4426950408889634f * g)); } }
                u32x2 w; w.x = pack4_fp8(r[0][0], r[0][1], r[0][2], r[0][3]); w.y = pack4_fp8(r[1][0], r[1][1], r[1][2], r[1][3]);
                *(u32x2*)(act + row * DFF + gcol) = w; }
        return false;
    }
};

struct EpiDown {
    static constexpr bool PERM = true;
    const float* bd; const int* slot_asg; const float* slot_w; bf16_t* ybuf;
    DI bool operator()(AccT& acc, const pg8::GU& u, int wr, int wc, int fr, int fq) const {
        const int rloc0 = wr * 64 + fr, col0 = u.pn * 256 + wc * 32 + 8 * fq; const float* bp = bd + (size_t)u.tag * DM + col0;
        f32x4 bv[2][2];
#pragma unroll
        for (int bj = 0; bj < 2; ++bj)
#pragma unroll
            for (int n = 0; n < 2; ++n) bv[bj][n] = *(const f32x4*)(bp + bj * 128 + 4 * n);
        int av[2][4]; float wv[2][4];
#pragma unroll
        for (int ai = 0; ai < 2; ++ai)
#pragma unroll
            for (int m = 0; m < 4; ++m) { const size_t slot = (size_t)u.pm * 256 + ai * 128 + rloc0 + m * 16; av[ai][m] = slot_asg[slot]; wv[ai][m] = slot_w[slot]; }
        asm volatile("" ::: "memory");
#pragma unroll
        for (int ai = 0; ai < 2; ++ai)
#pragma unroll
            for (int m = 0; m < 4; ++m) { const int a = av[ai][m]; const float wgt = wv[ai][m];
                if (a >= 0) {
#pragma unroll
                    for (int bj = 0; bj < 2; ++bj) { const f32x4 v0 = (acc[ai][bj][m][0] + bv[bj][0]) * wgt, v1 = (acc[ai][bj][m][1] + bv[bj][1]) * wgt; u32x4 w;
                        w.x = cvt_pk_bf16(v0[0], v0[1]); w.y = cvt_pk_bf16(v0[2], v0[3]); w.z = cvt_pk_bf16(v1[0], v1[1]); w.w = cvt_pk_bf16(v1[2], v1[3]);
                        *(u32x4*)(ybuf + (size_t)a * DM + col0 + bj * 128) = w; } } }
        return false;
    }
};
namespace att {
constexpr int SHM_K = 64 * 128 * 2, SHM_V = 64 * 256 * 2, STG = 2 * SHM_K + SHM_V;
#define KSWZ(row, colB) ((row) * 256 + ((colB) ^ (((row) & 7) << 4)))
DI int swap23(int k) { return (k & ~0xC) | ((k & 4) << 1) | ((k & 8) >> 1); }
DI int v_rd_base(int lane) { return ((lane & 3) << 3) | (((lane >> 2) & 3) << 6) | (((lane >> 4) & 1) << 5) | (((lane >> 5) & 1) << 8); }
DI int crow(int r, int hi) { return (r & 3) + 8 * (r >> 2) + 4 * hi; }

DI void mask_causal(f32x16& p0, f32x16& p1, int dq) {
    const float NEG = -__builtin_inff();
#pragma unroll
    for (int r = 0; r < 16; ++r) { const int c = (r & 3) + 8 * (r >> 2);
        if (dq - c < 0) p0[r] = NEG;
        if (dq - c - 32 < 0) p1[r] = NEG; }
}
template <int NP>
DI void partialSM(f32x16& p0, f32x16& p1, float& m_reg, float& alpha, const float C2, const float SCALE) {
    float pmax = p0[0];
#pragma unroll
    for (int r = 1; r < 16; ++r) pmax = fmaxf(pmax, p0[r]);
    if (NP == 2) {
#pragma unroll
        for (int r = 0; r < 16; ++r) pmax = fmaxf(pmax, p1[r]); }
    { auto rr = __builtin_amdgcn_permlane32_swap(__float_as_uint(pmax), __float_as_uint(pmax), false, false);
      pmax = fmaxf(__uint_as_float(rr[0]), __uint_as_float(rr[1])); }
    float mn;
    if (__builtin_expect(__all((pmax - m_reg) * SCALE <= 8.f), 1)) { mn = m_reg; alpha = 1.f; }
    else { mn = fmaxf(m_reg, pmax); alpha = __builtin_amdgcn_exp2f((m_reg - mn) * C2); m_reg = mn; }
    const float mnL = -mn * C2;
#pragma unroll
    for (int r = 0; r < 16; ++r) p0[r] = __builtin_amdgcn_exp2f(fmaf(p0[r], C2, mnL));
    if (NP == 2) {
#pragma unroll
        for (int r = 0; r < 16; ++r) p1[r] = __builtin_amdgcn_exp2f(fmaf(p1[r], C2, mnL)); }
}
#define PK4(P, B_, OUT) do { unsigned a0 = cvt_pk_bf16_a(P[B_+0], P[B_+1]), a1 = cvt_pk_bf16_a(P[B_+2], P[B_+3]);                          \
        unsigned b0 = cvt_pk_bf16_a(P[B_+4], P[B_+5]), b1 = cvt_pk_bf16_a(P[B_+6], P[B_+7]);                                             \
        asm volatile("s_nop 1" : "+v"(a0), "+v"(a1), "+v"(b0), "+v"(b1));                                                                                                         \
        auto r0 = __builtin_amdgcn_permlane32_swap(a0, b0, false, false); auto r1 = __builtin_amdgcn_permlane32_swap(a1, b1, false, false); \
        u32x4 w = {r0[0], r1[0], r0[1], r1[1]}; OUT = *reinterpret_cast<bf16x8*>(&w); } while (0)
template <int NP>
DI void finishSM(f32x16& p0, f32x16& p1, float alpha, float& l_reg, bf16x8& pa0, bf16x8& pa1, bf16x8& pa2, bf16x8& pa3) {
    float ps = 0.f;
#pragma unroll
    for (int r = 0; r < 16; ++r) ps += p0[r];
    if (NP == 2) {
#pragma unroll
        for (int r = 0; r < 16; ++r) ps += p1[r]; }
    { auto rr = __builtin_amdgcn_permlane32_swap(__float_as_uint(ps), __float_as_uint(ps), false, false);
      ps = __uint_as_float(rr[0]) + __uint_as_float(rr[1]); }
    l_reg = l_reg * alpha + ps;
    PK4(p0, 0, pa0); PK4(p0, 8, pa1);
    if (NP == 2) { PK4(p1, 0, pa2); PK4(p1, 8, pa3); }
}
DI void qkt(f32x16& p0, f32x16& p1, const LAS char* Kt, int r32, int hi, const bf16x8* qr) {
    const LAS char* kb[4];
#pragma unroll
    for (int dd = 0; dd < 4; ++dd) kb[dd] = Kt + KSWZ(r32, (dd * 16 + hi * 8) * 2);
#pragma unroll
    for (int d0 = 0; d0 < 8; ++d0) { const LAS char* a = kb[d0 & 3] + (d0 >> 2) * 128;
        const bf16x8 b0 = *reinterpret_cast<const LAS bf16x8*>(a);
        const bf16x8 b1 = *reinterpret_cast<const LAS bf16x8*>(a + 32 * 256);
        p0 = __builtin_amdgcn_mfma_f32_32x32x16_bf16(b0, qr[d0], p0, 0, 0, 0);
        p1 = __builtin_amdgcn_mfma_f32_32x32x16_bf16(b1, qr[d0], p1, 0, 0, 0); }
}
#define TRRD(dst, vb, off) asm volatile("ds_read_b64_tr_b16 %0, %1 offset:%2" : "=&v"(dst) : "v"(vb), "i"(off) : "memory")
#define TR8_64(S_, vb, base_, NCB) do { constexpr int b_ = (base_); \
        TRRD(S_##l0, vb, b_); TRRD(S_##h0, vb, b_ + NCB * 512); TRRD(S_##l1, vb, b_ + 2 * NCB * 512); TRRD(S_##h1, vb, b_ + 3 * NCB * 512);               \
        TRRD(S_##l2, vb, b_ + 4 * NCB * 512); TRRD(S_##h2, vb, b_ + 5 * NCB * 512); TRRD(S_##l3, vb, b_ + 6 * NCB * 512); TRRD(S_##h3, vb, b_ + 7 * NCB * 512); } while (0)
#define MMA4_64(o_, S_) do { \
        o_ = __builtin_amdgcn_mfma_f32_32x32x16_bf16((bf16x8){S_##l0[0], S_##l0[1], S_##l0[2], S_##l0[3], S_##h0[0], S_##h0[1], S_##h0[2], S_##h0[3]}, pa0, o_, 0, 0, 0);   \
        o_ = __builtin_amdgcn_mfma_f32_32x32x16_bf16((bf16x8){S_##l1[0], S_##l1[1], S_##l1[2], S_##l1[3], S_##h1[0], S_##h1[1], S_##h1[2], S_##h1[3]}, pa1, o_, 0, 0, 0);   \
        o_ = __builtin_amdgcn_mfma_f32_32x32x16_bf16((bf16x8){S_##l2[0], S_##l2[1], S_##l2[2], S_##l2[3], S_##h2[0], S_##h2[1], S_##h2[2], S_##h2[3]}, pa2, o_, 0, 0, 0);   \
        o_ = __builtin_amdgcn_mfma_f32_32x32x16_bf16((bf16x8){S_##l3[0], S_##l3[1], S_##l3[2], S_##l3[3], S_##h3[0], S_##h3[1], S_##h3[2], S_##h3[3]}, pa3, o_, 0, 0, 0); } while (0)
#define LGKM_WAIT(n) asm volatile("s_waitcnt lgkmcnt(" #n ")" ::: "memory")
#define PV_STEP(o_, Scur, Snxt, vb, nbase, NCB) do { TR8_64(Snxt, vb, nbase, NCB); LGKM_WAIT(8); SBAR(); MMA4_64(o_, Scur); SBAR(); } while (0)
#define PV_LAST(o_, Scur) do { LGKM_WAIT(0); SBAR(); MMA4_64(o_, Scur); SBAR(); } while (0)
#define PV_DECL() s16x4 fAl0, fAl1, fAl2, fAl3, fAh0, fAh1, fAh2, fAh3, fBl0, fBl1, fBl2, fBl3, fBh0, fBh1, fBh2, fBh3
#define PV_D0_32(o_, vb, base_, NCB) do { s16x4 l0, l1, h0, h1; constexpr int b_ = (base_);                                                   \
        TRRD(l0, vb, b_); TRRD(h0, vb, b_ + NCB * 512); TRRD(l1, vb, b_ + 2 * NCB * 512); TRRD(h1, vb, b_ + 3 * NCB * 512);               \
        asm volatile("s_waitcnt lgkmcnt(0)" ::: "memory"); SBAR();                                                                          \
        o_ = __builtin_amdgcn_mfma_f32_32x32x16_bf16((bf16x8){l0[0], l0[1], l0[2], l0[3], h0[0], h0[1], h0[2], h0[3]}, pa0, o_, 0, 0, 0);   \
        o_ = __builtin_amdgcn_mfma_f32_32x32x16_bf16((bf16x8){l1[0], l1[1], l1[2], l1[3], h1[0], h1[1], h1[2], h1[3]}, pa1, o_, 0, 0, 0); } while (0)

#define PV_JOUTER_64_DIFF(o, vb) do { s16x4 jl0, jl1, jl2, jl3, jl4, jh0, jh1, jh2, jh3, jh4; \
        TRRD(jl0, vb, 0); TRRD(jh0, vb, 4096); \
        TRRD(jl1, vb, 512); TRRD(jh1, vb, 4608); \
        TRRD(jl2, vb, 1024); TRRD(jh2, vb, 5120); \
        TRRD(jl3, vb, 1536); TRRD(jh3, vb, 5632); \
        TRRD(jl4, vb, 2048); TRRD(jh4, vb, 6144); LGKM_WAIT(8); SBAR(); o[0] = __builtin_amdgcn_mfma_f32_32x32x16_bf16((bf16x8){jl0[0], jl0[1], jl0[2], jl0[3], jh0[0], jh0[1], jh0[2], jh0[3]}, pa0, o[0], 0, 0, 0); SBAR(); \
        TRRD(jl0, vb, 2560); TRRD(jh0, vb, 6656); LGKM_WAIT(8); SBAR(); o[1] = __builtin_amdgcn_mfma_f32_32x32x16_bf16((bf16x8){jl1[0], jl1[1], jl1[2], jl1[3], jh1[0], jh1[1], jh1[2], jh1[3]}, pa0, o[1], 0, 0, 0); SBAR(); \
        TRRD(jl1, vb, 3072); TRRD(jh1, vb, 7168); LGKM_WAIT(8); SBAR(); o[2] = __builtin_amdgcn_mfma_f32_32x32x16_bf16((bf16x8){jl2[0], jl2[1], jl2[2], jl2[3], jh2[0], jh2[1], jh2[2], jh2[3]}, pa0, o[2], 0, 0, 0); SBAR(); \
        TRRD(jl2, vb, 3584); TRRD(jh2, vb, 7680); LGKM_WAIT(8); SBAR(); o[3] = __builtin_amdgcn_mfma_f32_32x32x16_bf16((bf16x8){jl3[0], jl3[1], jl3[2], jl3[3], jh3[0], jh3[1], jh3[2], jh3[3]}, pa0, o[3], 0, 0, 0); SBAR(); \
        TRRD(jl3, vb, 8192); TRRD(jh3, vb, 12288); LGKM_WAIT(8); SBAR(); o[4] = __builtin_amdgcn_mfma_f32_32x32x16_bf16((bf16x8){jl4[0], jl4[1], jl4[2], jl4[3], jh4[0], jh4[1], jh4[2], jh4[3]}, pa0, o[4], 0, 0, 0); SBAR(); \
        TRRD(jl4, vb, 8704); TRRD(jh4, vb, 12800); LGKM_WAIT(8); SBAR(); o[5] = __builtin_amdgcn_mfma_f32_32x32x16_bf16((bf16x8){jl0[0], jl0[1], jl0[2], jl0[3], jh0[0], jh0[1], jh0[2], jh0[3]}, pa0, o[5], 0, 0, 0); SBAR(); \
        TRRD(jl0, vb, 9216); TRRD(jh0, vb, 13312); LGKM_WAIT(8); SBAR(); o[6] = __builtin_amdgcn_mfma_f32_32x32x16_bf16((bf16x8){jl1[0], jl1[1], jl1[2], jl1[3], jh1[0], jh1[1], jh1[2], jh1[3]}, pa0, o[6], 0, 0, 0); SBAR(); \
        TRRD(jl1, vb, 9728); TRRD(jh1, vb, 13824); LGKM_WAIT(8); SBAR(); o[7] = __builtin_amdgcn_mfma_f32_32x32x16_bf16((bf16x8){jl2[0], jl2[1], jl2[2], jl2[3], jh2[0], jh2[1], jh2[2], jh2[3]}, pa0, o[7], 0, 0, 0); SBAR(); \
        TRRD(jl2, vb, 10240); TRRD(jh2, vb, 14336); LGKM_WAIT(8); SBAR(); o[0] = __builtin_amdgcn_mfma_f32_32x32x16_bf16((bf16x8){jl3[0], jl3[1], jl3[2], jl3[3], jh3[0], jh3[1], jh3[2], jh3[3]}, pa1, o[0], 0, 0, 0); SBAR(); \
        TRRD(jl3, vb, 10752); TRRD(jh3, vb, 14848); LGKM_WAIT(8); SBAR(); o[1] = __builtin_amdgcn_mfma_f32_32x32x16_bf16((bf16x8){jl4[0], jl4[1], jl4[2], jl4[3], jh4[0], jh4[1], jh4[2], jh4[3]}, pa1, o[1], 0, 0, 0); SBAR(); \
        TRRD(jl4, vb, 11264); TRRD(jh4, vb, 15360); LGKM_WAIT(8); SBAR(); o[2] = __builtin_amdgcn_mfma_f32_32x32x16_bf16((bf16x8){jl0[0], jl0[1], jl0[2], jl0[3], jh0[0], jh0[1], jh0[2], jh0[3]}, pa1, o[2], 0, 0, 0); SBAR(); \
        TRRD(jl0, vb, 11776); TRRD(jh0, vb, 15872); LGKM_WAIT(8); SBAR(); o[3] = __builtin_amdgcn_mfma_f32_32x32x16_bf16((bf16x8){jl1[0], jl1[1], jl1[2], jl1[3], jh1[0], jh1[1], jh1[2], jh1[3]}, pa1, o[3], 0, 0, 0); SBAR(); \
        TRRD(jl1, vb, 16384); TRRD(jh1, vb, 20480); LGKM_WAIT(8); SBAR(); o[4] = __builtin_amdgcn_mfma_f32_32x32x16_bf16((bf16x8){jl2[0], jl2[1], jl2[2], jl2[3], jh2[0], jh2[1], jh2[2], jh2[3]}, pa1, o[4], 0, 0, 0); SBAR(); \
        TRRD(jl2, vb, 16896); TRRD(jh2, vb, 20992); LGKM_WAIT(8); SBAR(); o[5] = __builtin_amdgcn_mfma_f32_32x32x16_bf16((bf16x8){jl3[0], jl3[1], jl3[2], jl3[3], jh3[0], jh3[1], jh3[2], jh3[3]}, pa1, o[5], 0, 0, 0); SBAR(); \
        TRRD(jl3, vb, 17408); TRRD(jh3, vb, 21504); LGKM_WAIT(8); SBAR(); o[6] = __builtin_amdgcn_mfma_f32_32x32x16_bf16((bf16x8){jl4[0], jl4[1], jl4[2], jl4[3], jh4[0], jh4[1], jh4[2], jh4[3]}, pa1, o[6], 0, 0, 0); SBAR(); \
        TRRD(jl4, vb, 17920); TRRD(jh4, vb, 22016); LGKM_WAIT(8); SBAR(); o[7] = __builtin_amdgcn_mfma_f32_32x32x16_bf16((bf16x8){jl0[0], jl0[1], jl0[2], jl0[3], jh0[0], jh0[1], jh0[2], jh0[3]}, pa1, o[7], 0, 0, 0); SBAR(); \
        TRRD(jl0, vb, 18432); TRRD(jh0, vb, 22528); LGKM_WAIT(8); SBAR(); o[0] = __builtin_amdgcn_mfma_f32_32x32x16_bf16((bf16x8){jl1[0], jl1[1], jl1[2], jl1[3], jh1[0], jh1[1], jh1[2], jh1[3]}, pa2, o[0], 0, 0, 0); SBAR(); \
        TRRD(jl1, vb, 18944); TRRD(jh1, vb, 23040); LGKM_WAIT(8); SBAR(); o[1] = __builtin_amdgcn_mfma_f32_32x32x16_bf16((bf16x8){jl2[0], jl2[1], jl2[2], jl2[3], jh2[0], jh2[1], jh2[2], jh2[3]}, pa2, o[1], 0, 0, 0); SBAR(); \
        TRRD(jl2, vb, 19456); TRRD(jh2, vb, 23552); LGKM_WAIT(8); SBAR(); o[2] = __builtin_amdgcn_mfma_f32_32x32x16_bf16((bf16x8){jl3[0], jl3[1], jl3[2], jl3[3], jh3[0], jh3[1], jh3[2], jh3[3]}, pa2, o[2], 0, 0, 0); SBAR(); \
        TRRD(jl3, vb, 19968); TRRD(jh3, vb, 24064); LGKM_WAIT(8); SBAR(); o[3] = __builtin_amdgcn_mfma_f32_32x32x16_bf16((bf16x8){jl4[0], jl4[1], jl4[2], jl4[3], jh4[0], jh4[1], jh4[2], jh4[3]}, pa2, o[3], 0, 0, 0); SBAR(); \
        TRRD(jl4, vb, 24576); TRRD(jh4, vb, 28672); LGKM_WAIT(8); SBAR(); o[4] = __builtin_amdgcn_mfma_f32_32x32x16_bf16((bf16x8){jl0[0], jl0[1], jl0[2], jl0[3], jh0[0], jh0[1], jh0[2], jh0[3]}, pa2, o[4], 0, 0, 0); SBAR(); \
        TRRD(jl0, vb, 25088); TRRD(jh0, vb, 29184); LGKM_WAIT(8); SBAR(); o[5] = __builtin_amdgcn_mfma_f32_32x32x16_bf16((bf16x8){jl1[0], jl1[1], jl1[2], jl1[3], jh1[0], jh1[1], jh1[2], jh1[3]}, pa2, o[5], 0, 0, 0); SBAR(); \
        TRRD(jl1, vb, 25600); TRRD(jh1, vb, 29696); LGKM_WAIT(8); SBAR(); o[6] = __builtin_amdgcn_mfma_f32_32x32x16_bf16((bf16x8){jl2[0], jl2[1], jl2[2], jl2[3], jh2[0], jh2[1], jh2[2], jh2[3]}, pa2, o[6], 0, 0, 0); SBAR(); \
        TRRD(jl2, vb, 26112); TRRD(jh2, vb, 30208); LGKM_WAIT(8); SBAR(); o[7] = __builtin_amdgcn_mfma_f32_32x32x16_bf16((bf16x8){jl3[0], jl3[1], jl3[2], jl3[3], jh3[0], jh3[1], jh3[2], jh3[3]}, pa2, o[7], 0, 0, 0); SBAR(); \
        TRRD(jl3, vb, 26624); TRRD(jh3, vb, 30720); LGKM_WAIT(8); SBAR(); o[0] = __builtin_amdgcn_mfma_f32_32x32x16_bf16((bf16x8){jl4[0], jl4[1], jl4[2], jl4[3], jh4[0], jh4[1], jh4[2], jh4[3]}, pa3, o[0], 0, 0, 0); SBAR(); \
        TRRD(jl4, vb, 27136); TRRD(jh4, vb, 31232); LGKM_WAIT(8); SBAR(); o[1] = __builtin_amdgcn_mfma_f32_32x32x16_bf16((bf16x8){jl0[0], jl0[1], jl0[2], jl0[3], jh0[0], jh0[1], jh0[2], jh0[3]}, pa3, o[1], 0, 0, 0); SBAR(); \
        TRRD(jl0, vb, 27648); TRRD(jh0, vb, 31744); LGKM_WAIT(8); SBAR(); o[2] = __builtin_amdgcn_mfma_f32_32x32x16_bf16((bf16x8){jl1[0], jl1[1], jl1[2], jl1[3], jh1[0], jh1[1], jh1[2], jh1[3]}, pa3, o[2], 0, 0, 0); SBAR(); \
        TRRD(jl1, vb, 28160); TRRD(jh1, vb, 32256); LGKM_WAIT(8); SBAR(); o[3] = __builtin_amdgcn_mfma_f32_32x32x16_bf16((bf16x8){jl2[0], jl2[1], jl2[2], jl2[3], jh2[0], jh2[1], jh2[2], jh2[3]}, pa3, o[3], 0, 0, 0); SBAR(); \
        LGKM_WAIT(6); SBAR(); o[4] = __builtin_amdgcn_mfma_f32_32x32x16_bf16((bf16x8){jl3[0], jl3[1], jl3[2], jl3[3], jh3[0], jh3[1], jh3[2], jh3[3]}, pa3, o[4], 0, 0, 0); SBAR(); \
        LGKM_WAIT(4); SBAR(); o[5] = __builtin_amdgcn_mfma_f32_32x32x16_bf16((bf16x8){jl4[0], jl4[1], jl4[2], jl4[3], jh4[0], jh4[1], jh4[2], jh4[3]}, pa3, o[5], 0, 0, 0); SBAR(); \
        LGKM_WAIT(2); SBAR(); o[6] = __builtin_amdgcn_mfma_f32_32x32x16_bf16((bf16x8){jl0[0], jl0[1], jl0[2], jl0[3], jh0[0], jh0[1], jh0[2], jh0[3]}, pa3, o[6], 0, 0, 0); SBAR(); \
        LGKM_WAIT(0); SBAR(); o[7] = __builtin_amdgcn_mfma_f32_32x32x16_bf16((bf16x8){jl1[0], jl1[1], jl1[2], jl1[3], jh1[0], jh1[1], jh1[2], jh1[3]}, pa3, o[7], 0, 0, 0); SBAR(); \
    } while (0)
DI void store_pair16(bf16_t* p, float a0, float a1, float a2, float a3, float b0, float b1, float b2, float b3) {
    unsigned gx = cvt_pk_bf16_a(a0, a1), gy = cvt_pk_bf16_a(a2, a3), hx = cvt_pk_bf16_a(b0, b1), hy = cvt_pk_bf16_a(b2, b3);
    asm volatile("s_nop 1" : "+v"(gx), "+v"(gy), "+v"(hx), "+v"(hy));
    auto rx = __builtin_amdgcn_permlane32_swap(gx, hx, false, false); auto ry = __builtin_amdgcn_permlane32_swap(gy, hy, false, false);
    u32x4 w = {rx[0], ry[0], rx[1], ry[1]};
    *(u32x4*)p = w;
}
struct CoopArgs {
    const bf16_t* q;
    const bf16_t* k0; const bf16_t* k1; const bf16_t* v;
    int rsq, rsk, nt;
};
DI void stage_k(LAS char* st, const CoopArgs& a, int kb0, int wid, int lane) {
    const int l16 = lane & 15, lr = lane >> 4;
#pragma unroll
    for (int i = 0; i < 2; ++i) { const int piece = 2 * wid + i, row = piece * 4 + lr, ch = l16 ^ (row & 7);
        const size_t go = (size_t)(kb0 + row) * a.rsk + ch * 8;
        __builtin_amdgcn_global_load_lds((const unsigned*)(a.k0 + go), (LAS unsigned*)(st + piece * 1024), 16, 0, 0);
        __builtin_amdgcn_global_load_lds((const unsigned*)(a.k1 + go), (LAS unsigned*)(st + SHM_K + piece * 1024), 16, 0, 0); }
}
DI void stage_v(LAS char* st, const CoopArgs& a, int kb0, int wid, int lane) {
    const int sub = lane >> 5, kr = (lane & 31) >> 2, ch4 = lane & 3; const int key = swap23(8 * wid + kr);
    const bf16_t* vp = a.v + (size_t)(kb0 + key) * a.rsk + sub * 32 + ch4 * 8;
#pragma unroll
    for (int j = 0; j < 4; ++j)
        __builtin_amdgcn_global_load_lds((const unsigned*)(vp + j * 64), (LAS unsigned*)(st + 2 * SHM_K + wid * 4096 + j * 1024), 16, 0, 0);
}
}
namespace att {
struct DiffOut { bf16_t* ob; const float* subln; float lam; };
template <int MODE>
DI void coop_unit(LAS char* lds, const CoopArgs& a, int qpos0  , const float C2, const float SCALE,
                  bf16_t* orow  , int ors, const DiffOut& dout) {
    const int tid = threadIdx.x, wid = __builtin_amdgcn_readfirstlane(tid >> 6), lane = tid & 63, r32 = lane & 31, hi = lane >> 5;
    const int c = wid >> 2, wq = wid & 3;
    constexpr int NQ = MODE == 0 ? 8 : 16, NO = MODE == 0 ? 8 : 4;
    bf16x8 qr[NQ];
    { const bf16_t* qp = a.q + (MODE == 0 ? c * 128 : 0) + (size_t)(wq * 32 + r32) * a.rsq + hi * 8;
#pragma unroll
      for (int d0 = 0; d0 < NQ; ++d0) qr[d0] = *(const bf16x8*)(qp + d0 * 16); }
    f32x16 o[NO];
#pragma unroll
    for (int d = 0; d < NO; ++d)
#pragma unroll
        for (int r = 0; r < 16; ++r) o[d][r] = 0.f;
    float m_reg = -1e30f, l_reg = 0.f;
    const int NT = a.nt;
    const int qlo = qpos0 + wq * 32;
    stage_k(lds, a, 0, wid, lane); stage_v(lds, a, 0, wid, lane);
    for (int t = 0; t < NT; ++t) {
        VM_WAIT(); __syncthreads();
        LAS char* st = lds + (t & 1) * STG;
        if (t + 1 < NT) { stage_k(lds + ((t + 1) & 1) * STG, a, (t + 1) * 64, wid, lane); stage_v(lds + ((t + 1) & 1) * STG, a, (t + 1) * 64, wid, lane); }
        const int kb0 = t * 64;
        if (MODE == 1 || kb0 <= qlo + 31) {
            f32x16 p0, p1;
#pragma unroll
            for (int r = 0; r < 16; ++r) { p0[r] = 0.f; p1[r] = 0.f; }
            if (MODE == 0) qkt(p0, p1, st + c * SHM_K, r32, hi, qr);
            else { qkt(p0, p1, st, r32, hi, qr); qkt(p0, p1, st + SHM_K, r32, hi, qr + 8); }
            if (MODE == 0 && kb0 + 63 > qlo) mask_causal(p0, p1, qlo + r32 - kb0 - 4 * hi);
            float alpha;
            partialSM<2>(p0, p1, m_reg, alpha, C2, SCALE);
            if (__any(alpha < 1.f)) {
#pragma unroll
                for (int d = 0; d < NO; ++d)
#pragma unroll
                    for (int r = 0; r < 16; ++r) o[d][r] *= alpha; }
            bf16x8 pa0, pa1, pa2, pa3;
            finishSM<2>(p0, p1, alpha, l_reg, pa0, pa1, pa2, pa3);
            const int vb = (int)(uintptr_t)(st + 2 * SHM_K) + v_rd_base(lane) + (MODE == 1 ? c * 4 * 512 : 0);
            if constexpr (MODE == 0) { PV_JOUTER_64_DIFF(o, vb); }
            else { PV_DECL();
                TR8_64(fA, vb, 0 * 512, 8);
                PV_STEP(o[0], fA, fB, vb, 1 * 512, 8); PV_STEP(o[1], fB, fA, vb, 2 * 512, 8); PV_STEP(o[2], fA, fB, vb, 3 * 512, 8); PV_LAST(o[3], fB); }
        }
    }
    const float il = __builtin_amdgcn_rcpf(l_reg);
    if constexpr (MODE == 1) {
        bf16_t* op = orow + (size_t)(wq * 32 + r32) * ors + c * 128 + 8 * hi;
#pragma unroll
        for (int d = 0; d < 4; ++d)
#pragma unroll
            for (int g = 0; g < 4; g += 2)
                store_pair16(op + d * 32 + 8 * g, o[d][4 * g] * il, o[d][4 * g + 1] * il, o[d][4 * g + 2] * il, o[d][4 * g + 3] * il,
                             o[d][4 * g + 4] * il, o[d][4 * g + 5] * il, o[d][4 * g + 6] * il, o[d][4 * g + 7] * il);
        __syncthreads();
    } else {
        __syncthreads();
        LAS float* X = (LAS float*)lds + wq * 8192 + lane;
        if (c == 1) { const float sc = il * dout.lam;
#pragma unroll
            for (int d = 0; d < 8; ++d)
#pragma unroll
                for (int r = 0; r < 16; ++r) X[(d * 16 + r) * 64] = o[d][r] * sc; }
        __syncthreads();
        if (c == 0) {
            float ss = 0.f;
#pragma unroll
            for (int d = 0; d < 8; ++d)
#pragma unroll
                for (int r = 0; r < 16; ++r) { const float v = o[d][r] * il - X[(d * 16 + r) * 64]; o[d][r] = v; ss += v * v; }
            { auto rr = __builtin_amdgcn_permlane32_swap(__float_as_uint(ss), __float_as_uint(ss), false, false); ss = __uint_as_float(rr[0]) + __uint_as_float(rr[1]); }
            const float rs = __builtin_amdgcn_rsqf(ss * (1.f / 256.f) + EPS) * (1.f - LAM_INIT);
            bf16_t* op = orow + (size_t)(wq * 32 + r32) * ors + 8 * hi;
#pragma unroll
            for (int d = 0; d < 8; ++d)
#pragma unroll
                for (int g = 0; g < 4; g += 2) { const f32x4 ga = *(const f32x4*)(dout.subln + d * 32 + 8 * g + 4 * hi), gb = *(const f32x4*)(dout.subln + d * 32 + 8 * g + 8 + 4 * hi);
                    store_pair16(op + d * 32 + 8 * g, o[d][4 * g] * rs * ga[0], o[d][4 * g + 1] * rs * ga[1], o[d][4 * g + 2] * rs * ga[2], o[d][4 * g + 3] * rs * ga[3],
                                 o[d][4 * g + 4] * rs * gb[0], o[d][4 * g + 5] * rs * gb[1], o[d][4 * g + 6] * rs * gb[2], o[d][4 * g + 7] * rs * gb[3]); }
        }
        __syncthreads();
    }
}

DI void dil_wave_unit(LAS char* wl  , const bf16_t* proj, bf16_t* ob, int wu, int lane) {
    const int r32 = lane & 31, hi = lane >> 5;
    const int bh = wu >> 8, j = wu & 255, b = bh >> 3, h = bh & 7;
    const int tq0 = (j >> 3) * 256 + ((j >> 2) & 1) * 128 + (j & 3);
    const int tq = tq0 + 4 * r32;
    const size_t rowb = (size_t)b * SEQ;
    constexpr float SCALE = 0.08838834764831845f, C2 = 1.4426950408889634f * SCALE;
    bf16x8 qr[8];
    { const bf16_t* qp = proj + (rowb + tq) * INC + C_LQ + h * 128 + hi * 8;
#pragma unroll
      for (int d0 = 0; d0 < 8; ++d0) qr[d0] = *(const bf16x8*)(qp + d0 * 16); }
    f32x16 o[4];
#pragma unroll
    for (int d = 0; d < 4; ++d)
#pragma unroll
        for (int r = 0; r < 16; ++r) o[d][r] = 0.f;
    float m_reg = -1e30f, l_reg = 0.f;
    const bf16_t* kcol = proj + C_LK + h * 128 + hi * 8;
    const bf16_t* vcol = proj + C_LV + h * 128 + (lane >> 5) * 32 + (lane & 3) * 8;
    const int kr = (lane & 31) >> 2;
    for (int tau = 0; tau < 30; ++tau) {
        int ks, dmask, W, kbase;
        if (tau < 5) { ks = 4; dmask = 3; W = 512; kbase = tq0 - 512 + 128 * tau; }
        else if (tau < 22) { ks = 4; dmask = 15; W = 2048; kbase = tq0 - 2048 + 128 * (tau - 5); }
        else { ks = 1; dmask = 0; W = 128; kbase = tq0 - 128 + 32 * (tau - 22); }
        if (kbase + 31 * ks < 0) continue;
        int kp = kbase + ks * r32; kp = kp < 0 ? 0 : (kp > SEQ - 1 ? SEQ - 1 : kp);
        const bf16_t* krow = kcol + (rowb + kp) * INC;
        bf16x8 kf[8];
#pragma unroll
        for (int d0 = 0; d0 < 8; ++d0) kf[d0] = *(const bf16x8*)(krow + d0 * 16);
#pragma unroll
        for (int kg = 0; kg < 4; ++kg) { int vp = kbase + ks * swap23(8 * kg + kr); vp = vp < 0 ? 0 : (vp > SEQ - 1 ? SEQ - 1 : vp);
            const bf16_t* vr = vcol + (rowb + vp) * INC;
            __builtin_amdgcn_global_load_lds((const unsigned*)vr, (LAS unsigned*)(wl + (2 * kg) * 1024), 16, 0, 0);
            __builtin_amdgcn_global_load_lds((const unsigned*)(vr + 64), (LAS unsigned*)(wl + (2 * kg + 1) * 1024), 16, 0, 0); }
        VM_WAIT();
        f32x16 p0, p1;
#pragma unroll
        for (int r = 0; r < 16; ++r) p0[r] = 0.f;
#pragma unroll
        for (int d0 = 0; d0 < 8; ++d0) p0 = __builtin_amdgcn_mfma_f32_32x32x16_bf16(kf[d0], qr[d0], p0, 0, 0, 0);
        { const float NEG = -__builtin_inff(); const int lim = W < tq ? W : tq;
          const int d0v = tq - kbase - ks * 4 * hi;
#pragma unroll
          for (int r = 0; r < 16; ++r) { const int delta = d0v - ks * ((r & 3) + 8 * (r >> 2));
              if ((unsigned)delta > (unsigned)lim || (delta & dmask) != 0) p0[r] = NEG; } }
        float alpha;
        partialSM<1>(p0, p1, m_reg, alpha, C2, SCALE);
        if (__any(alpha < 1.f)) {
#pragma unroll
            for (int d = 0; d < 4; ++d)
#pragma unroll
                for (int r = 0; r < 16; ++r) o[d][r] *= alpha; }
        bf16x8 pa0, pa1, pa2, pa3;
        finishSM<1>(p0, p1, alpha, l_reg, pa0, pa1, pa2, pa3);
        const int vb = (int)(uintptr_t)wl + v_rd_base(lane);
        PV_D0_32(o[0], vb, 0 * 512, 4); PV_D0_32(o[1], vb, 1 * 512, 4); PV_D0_32(o[2], vb, 2 * 512, 4); PV_D0_32(o[3], vb, 3 * 512, 4);
    }
    const float il = __builtin_amdgcn_rcpf(l_reg);
    bf16_t* op = ob + (rowb + tq) * 4096 + 2048 + h * 128 + 8 * hi;
#pragma unroll
    for (int d = 0; d < 4; ++d)
#pragma unroll
        for (int g = 0; g < 4; g += 2)
            store_pair16(op + d * 32 + 8 * g, o[d][4 * g] * il, o[d][4 * g + 1] * il, o[d][4 * g + 2] * il, o[d][4 * g + 3] * il,
                         o[d][4 * g + 4] * il, o[d][4 * g + 5] * il, o[d][4 * g + 6] * il, o[d][4 * g + 7] * il);
}
}
constexpr size_t MiB = 1u << 20;
constexpr size_t WS_CTL = 0, CTL_ZERO_BYTES = 1 * MiB;
constexpr size_t WS_SCAL = 1 * MiB, WS_SLOTA = 116 * MiB, WS_SLOTW = 118 * MiB, WS_CS = 8 * MiB, WS_WR2 = 10 * MiB;
constexpr size_t WS_WIN = 16 * MiB, WS_WMKV = 80 * MiB, WS_WBR = 88 * MiB, WS_WOUT = 104 * MiB, WS_MN = 112 * MiB, WS_KVM = 114 * MiB;
constexpr size_t WS_XN = 128 * MiB, WS_OB = 192 * MiB, WS_MERGED = 320 * MiB, WS_PROJ = 384 * MiB, WS_WGU = 896 * MiB, WS_WD = 1152 * MiB;
constexpr size_t WS_YBUF = 1280 * MiB, WS_XG = 1536 * MiB, WS_ACT = 2560 * MiB, WS_XN8 = 3584 * MiB  , WS_WING8 = 3616 * MiB  , WS_X1B = 3648 * MiB  , WS_END = 3712 * MiB;
constexpr int CW_QDIFF = 8192, CW_QDIL = 8192 + 512, CW_QMEM = 8192 + 1024  , CW_CNT = 256  , CW_BAR = 4096, CW_JUNK = 3700, CW_KVM = 12288  , CW_QCONV = 12352  ;

#define XB_TMO      128
#define XB_XCNT(j)  (256  + 64 * (j))
#define XB_XSUB(j)  (1280 + 64 * (j))
#define XB_XGEN(j)  (2304 + 64 * (j))
#define XB_TOP      3328
#define XB_TOPGEN   3392
#define XCD_BAR_WORDS 3456
#define XB_SPIN_CAP (1u << 23)
DI unsigned xb_ld(unsigned* p)              { return __hip_atomic_load(p, __ATOMIC_RELAXED, __HIP_MEMORY_SCOPE_AGENT); }
DI unsigned xb_add(unsigned* p, unsigned v) { return __hip_atomic_fetch_add(p, v, __ATOMIC_RELAXED, __HIP_MEMORY_SCOPE_AGENT); }
DI unsigned xb_xcc_id() { return (unsigned)__builtin_amdgcn_s_getreg((3 << 11) | 20) & 0xFu; }
#define XB_SPIN(cond, bar) do { unsigned _sp = 0; while (cond) { __builtin_amdgcn_s_sleep(1); \
    if ((++_sp & 255u) == 0u) { if (xb_ld(&(bar)[XB_TMO])) break; if (_sp > XB_SPIN_CAP) { atomicAdd(&(bar)[XB_TMO], 1u); break; } } } } while (0)
struct XcdBarrier { unsigned* bar; unsigned x; volatile LAS unsigned* st; };
DI XcdBarrier xcd_barrier_post(unsigned* bar, volatile LAS unsigned* st) {
    XcdBarrier b; b.bar = bar; b.x = xb_xcc_id(); b.st = st;
    if (threadIdx.x == 0) (void)xb_add(&bar[XB_XCNT(b.x)], 1u);
    return b;
}
DI void xcd_barrier_complete(unsigned* bar, unsigned x, unsigned& nloc, unsigned& nx) {
    const unsigned G = gridDim.x * gridDim.y * gridDim.z;
    unsigned sum, cnt, mine, sp = 0u;
    for (;;) {
        sum = 0u; cnt = 0u; mine = 0u;
#pragma unroll
        for (unsigned j = 0; j < 16; ++j) { const unsigned c = xb_ld(&bar[XB_XCNT(j)]); sum += c; cnt += (c > 0u) ? 1u : 0u; mine = (j == x) ? c : mine; }
        if (sum == G) break;
        __builtin_amdgcn_s_sleep(1);
        if ((++sp & 255u) == 0u) { if (xb_ld(&bar[XB_TMO])) break; if (sp > XB_SPIN_CAP) { atomicAdd(&bar[XB_TMO], 1u); break; } }
    }
    nloc = mine > 0u ? mine : 1u; nx = cnt > 0u ? cnt : 1u;
}
DI void xcd_barrier(const XcdBarrier& b) {
    asm volatile("s_waitcnt vmcnt(0)" ::: "memory");
    __syncthreads();
    if (threadIdx.x == 0) {
        unsigned* bar = b.bar;
        __builtin_amdgcn_s_waitcnt(0);
        unsigned nloc = b.st[0], nx = b.st[1];
        if (nloc == 0u) { xcd_barrier_complete(bar, b.x, nloc, nx); b.st[0] = nloc; b.st[1] = nx; }
        const unsigned old = xb_add(&bar[XB_XSUB(b.x)], 1u);
        const unsigned gen = old / nloc;
        if (old + 1u == (gen + 1u) * nloc) {
            __builtin_amdgcn_fence(__ATOMIC_RELEASE, "agent");
            asm volatile("s_waitcnt vmcnt(0)" ::: "memory");
            const unsigned og = xb_add(&bar[XB_TOP], 1u);
            const unsigned tg = og / nx;
            if (og + 1u == (tg + 1u) * nx) xb_add(&bar[XB_TOPGEN], 1u);
            else XB_SPIN(xb_ld(&bar[XB_TOPGEN]) == tg, bar);
            __builtin_amdgcn_fence(__ATOMIC_ACQUIRE, "agent");
            xb_add(&bar[XB_XGEN(b.x)], 1u);
            asm volatile("s_waitcnt vmcnt(0)" ::: "memory");
        } else {
            XB_SPIN(xb_ld(&bar[XB_XGEN(b.x)]) == gen, bar);
            __builtin_amdgcn_fence(__ATOMIC_ACQUIRE, "agent");
            asm volatile("s_waitcnt vmcnt(0)" ::: "memory");
        }
    }
    __syncthreads();
}

__device__ const double ROPE_REV[16] = {0.15915494309189535, 0.0700865215877985, 0.03086376340470123, 0.013591370636193905, 0.005985185712713705, 0.002635675898667414, 0.001160663641240061, 0.0005111175045375439, 0.00022507907903927653, 9.911730936901935e-05, 4.364795279280289e-05, 1.9221100684944863e-05, 8.464330808241401e-06, 3.727408601915352e-06, 1.6414262627950345e-06, 7.228293068832865e-07};

DI void t16_load(f32x4 (&v)[16], const float* src, int ldw) {
#pragma unroll
    for (int j = 0; j < 16; ++j) v[j] = __builtin_nontemporal_load((const f32x4*)(src + (size_t)(8 * (j >> 1) + (j & 1)) * ldw));
}
DI void t16_store(const f32x4 (&v)[16], bf16_t* dst, int ldt, LAS unsigned* scr, int lane) {
    const int l15 = lane & 15, l4 = lane >> 4;
#pragma unroll
    for (int jj = 0; jj < 8; ++jj) { const int kp = 4 * jj + l4;
#pragma unroll
        for (int i = 0; i < 4; ++i) scr[(4 * l15 + i) * 33 + kp] = cvt_pk_bf16(v[2 * jj][i], v[2 * jj + 1][i]); }
    LDS_WAIT(); asm volatile("" ::: "memory");
    const int ch = lane & 7, nr = lane >> 3;
#pragma unroll
    for (int i = 0; i < 8; ++i) { const int n = 8 * i + nr; const LAS unsigned* s = scr + n * 33 + 4 * ch; u32x4 w; w.x = s[0]; w.y = s[1]; w.z = s[2]; w.w = s[3];
        *(u32x4*)(dst + (size_t)n * ldt + 8 * ch) = w; }
    LDS_WAIT(); asm volatile("" ::: "memory");
}
DI void f8_decode(int r, const float* wgu, const float* wd, const float* wing, unsigned char* WguT, unsigned char* WdT, unsigned char* WinG8, int lane, const float*& src, unsigned char*& dst, int& ldw) {
    const int l7 = lane & 7, l8 = lane >> 3;
    if (r >= 98304) { r -= 98304; const int k0 = (r / 288) * 128, g = r % 288; ldw = INC;
        const int n0 = g < 64 ? C_DV + 32 * g : (g < 96 ? C_LV + 32 * (g - 64) : C_G + 32 * (g - 96));
        src = wing + (size_t)(k0 + 4 * l8) * INC + n0 + 4 * l7; dst = WinG8 + (size_t)n0 * 2048 + k0; }
    else if (r < 65536) { const int e = r >> 11, q = r & 2047, k0 = (q >> 7) * 128, n0 = (q & 127) * 32; ldw = 4096;
        src = wgu + (size_t)e * 2048 * 4096 + (size_t)(k0 + 4 * l8) * 4096 + n0 + 4 * l7; dst = WguT + (size_t)e * 4096 * 2048 + (size_t)n0 * 2048 + k0; }
    else { r -= 65536; const int e = r >> 10, q = r & 1023, k0 = (q >> 6) * 128, n0 = (q & 63) * 32; ldw = 2048;
        src = wd + (size_t)e * 2048 * 2048 + (size_t)(k0 + 4 * l8) * 2048 + n0 + 4 * l7; dst = WdT + (size_t)e * 2048 * 2048 + (size_t)n0 * 2048 + k0; }
}
DI void f8_load(f32x4 (&v)[16], const float* src, int ldw) {
#pragma unroll
    for (int j = 0; j < 16; ++j) v[j] = __builtin_nontemporal_load((const f32x4*)(src + (size_t)(32 * (j >> 2) + (j & 3)) * ldw));
}
DI void f8_store(const f32x4 (&v)[16], unsigned char* dst, LAS unsigned* scr, int lane) {
    const int l7 = lane & 7, l8 = lane >> 3; constexpr float SC = (float)(1 << pg8::WSH);
#pragma unroll
    for (int jj = 0; jj < 4; ++jj) { const int kq = 8 * jj + l8;
#pragma unroll
        for (int i = 0; i < 4; ++i) scr[(4 * l7 + i) * 33 + kq] = pack4_fp8(v[4 * jj][i] * SC, v[4 * jj + 1][i] * SC, v[4 * jj + 2][i] * SC, v[4 * jj + 3][i] * SC); }
    LDS_WAIT(); asm volatile("" ::: "memory");
    const int ch = lane & 7, nr = lane >> 3;
#pragma unroll
    for (int i = 0; i < 4; ++i) { const int n = 8 * i + nr; const LAS unsigned* s = scr + n * 33 + 4 * ch; u32x4 w; w.x = s[0]; w.y = s[1]; w.z = s[2]; w.w = s[3];
        __builtin_nontemporal_store(w, (u32x4*)(dst + (size_t)n * 2048 + 16 * ch)); }
    LDS_WAIT(); asm volatile("" ::: "memory");
}
template <int NR, bool F8 = false>
DI void rms_rows_to_bf16(const float* xrow, size_t rs, const float* gain, bf16_t* orow, size_t os, int lane, unsigned char* orow8 = nullptr) {
    const f32x4* gr = (const f32x4*)gain + lane;
    f32x4 v[NR][8];
#pragma unroll
    for (int q = 0; q < NR; ++q) { const f32x4* xr = (const f32x4*)(xrow + q * rs) + lane;
#pragma unroll
        for (int j = 0; j < 8; ++j) v[q][j] = __builtin_nontemporal_load(xr + 64 * j); }
#pragma unroll
    for (int q = 0; q < NR; ++q) { float s = 0.f;
#pragma unroll
        for (int j = 0; j < 8; ++j) s += (v[q][j][0] * v[q][j][0] + v[q][j][1] * v[q][j][1]) + (v[q][j][2] * v[q][j][2] + v[q][j][3] * v[q][j][3]);
        const float rstd = __builtin_amdgcn_rsqf(wave_sum(s) * (1.f / 2048.f) + EPS);
        u32x2* o8 = (u32x2*)(orow + q * os) + lane;
#pragma unroll
        for (int j = 0; j < 8; ++j) { const f32x4 g = gr[64 * j]; const float a = v[q][j][0] * rstd * g[0], b = v[q][j][1] * rstd * g[1], c = v[q][j][2] * rstd * g[2], d = v[q][j][3] * rstd * g[3];
            u32x2 w; w.x = cvt_pk_bf16(a, b); w.y = cvt_pk_bf16(c, d); o8[64 * j] = w;
            if (F8) ((unsigned*)(orow8 + q * os) + lane)[64 * j] = pack4_fp8(a, b, c, d); } }
}
enum { I_X = 0, I_MEM, I_POS, I_GMIX, I_WIN, I_BGATE, I_DQN, I_DKN, I_DLAM, I_SUBLN, I_LQN, I_LKN, I_GMEM, I_WMKV, I_MQN, I_MKN, I_WBD, I_WBL, I_WBM, I_WOUT, I_GFFN, I_WR, I_BR, I_WGU, I_BGU, I_WD, I_BD, N_IN };
constexpr int N_PHASES = 9;
struct Args { const void* in[N_IN]; float* out; unsigned char* ws; int ph_lo, ph_hi; int use_bar, pad; };

DI int moe_tables(const unsigned* ctl, LAS int* tab  , int tid) {
    if (tid < 64) { const int e = tid & 31; const unsigned c = __hip_atomic_load(ctl + CW_CNT + 64 * e, __ATOMIC_RELAXED, __HIP_MEMORY_SCOPE_AGENT); int n = (int)((c + 255u) >> 8), s = n;
#pragma unroll
        for (int o = 1; o < 32; o <<= 1) { const int t = __shfl_up(s, o, 32); if ((tid & 31) >= o) s += t; }
        if (tid < 32) { tab[300 + tid + 1] = s; tab[340 + tid] = (int)c; if (tid == 0) tab[300] = 0; } }
    __syncthreads();
    const int nrb = tab[332];
    for (int rb = tid; rb < nrb; rb += NTHR) { int e = 0;
#pragma unroll 1
        for (int k = 1; k < 32; ++k) if (rb >= tab[300 + k]) e = k;
        tab[rb] = e; }
    __syncthreads();
    return nrb;
}

__global__ void __launch_bounds__(NTHR, 2) fwd(Args args) {
    extern __shared__ __attribute__((aligned(16))) unsigned char lds_raw[];
    LAS unsigned char* lds = (LAS unsigned char*)lds_raw;
    volatile LAS unsigned* MISC = (volatile LAS unsigned*)(lds + MISC_OFF);
    const int G = gridDim.x, bx = blockIdx.x, NGW = G * NWAVES;
#define LANE_CONSTS() int tid_ = threadIdx.x; asm volatile("" : "+v"(tid_)); const int tid = tid_, lane = tid & 63, wave = __builtin_amdgcn_readfirstlane(tid >> 6), gw = bx * NWAVES + wave; (void)lane; (void)gw
    unsigned char* ws = args.ws;
    unsigned* ctl = (unsigned*)(ws + WS_CTL);
    if (threadIdx.x < 32) MISC[threadIdx.x] = 0u;
    __syncthreads();
    XcdBarrier bar; bar.bar = ctl + CW_BAR; bar.x = 0; bar.st = nullptr;
    if (args.use_bar) bar = xcd_barrier_post(ctl + CW_BAR, MISC + 8);
    const int lo = args.ph_lo, hi = args.ph_hi;
#ifndef PHASE_MASK
#define PHASE_MASK 0x1ff
#endif
#define IN(k) (((PHASE_MASK >> (k)) & 1) && lo <= (k) && (k) < hi)
#define SEAM(k) do { if (IN(k) && IN((k) + 1)) xcd_barrier(bar); } while (0)

    const float* x = (const float*)args.in[I_X];
    bf16_t* WinT = (bf16_t*)(ws + WS_WIN); bf16_t* WmkvT = (bf16_t*)(ws + WS_WMKV); bf16_t* WbrT = (bf16_t*)(ws + WS_WBR); bf16_t* WoutT = (bf16_t*)(ws + WS_WOUT);
    unsigned char* WguT = ws + WS_WGU; unsigned char* WdT = ws + WS_WD;
    unsigned char* XN8 = ws + WS_XN8; unsigned char* WinG8 = ws + WS_WING8;
    bf16_t* XN = (bf16_t*)(ws + WS_XN); bf16_t* MN = (bf16_t*)(ws + WS_MN); bf16_t* KVM = (bf16_t*)(ws + WS_KVM); bf16_t* PROJ = (bf16_t*)(ws + WS_PROJ);
    bf16_t* OB = (bf16_t*)(ws + WS_OB); bf16_t* MERGED = (bf16_t*)(ws + WS_MERGED); unsigned char* XG = ws + WS_XG; unsigned char* ACT = ws + WS_ACT;
    bf16_t* YBUF = (bf16_t*)(ws + WS_YBUF);
    float* CS = (float*)(ws + WS_CS); float* WR2 = (float*)(ws + WS_WR2); float* SCAL = (float*)(ws + WS_SCAL);
    int* SLOTA = (int*)(ws + WS_SLOTA); float* SLOTW = (float*)(ws + WS_SLOTW);
    bf16_t* X1 = (bf16_t*)(ws + WS_X1B);

    if (IN(0)) { LANE_CONSTS();
        LAS unsigned* scr = (LAS unsigned*)(lds + RING_OFF + wave * 16384);
        constexpr int I_IN = 32 * 112  , I_MKV = 32 * 32, I_BD = 32 * 32, I_BL = 16 * 32, I_BM = 16 * 32, I_OUT = 32 * 32, I_GU = 32 * 32 * 64, I_DN = 32 * 32 * 32;
        constexpr int NITEMS = I_IN + I_MKV + I_BD + I_BL + I_BM + I_OUT;
        {
            auto dec = [&](int r, const float*& src, int& ldw, bf16_t*& dst, int& ldt) {
                const float* W; bf16_t* WT; int k0, n0, ko = 0;
                if (r < I_IN) { W = (const float*)args.in[I_WIN]; ldw = INC; WT = WinT; ldt = DM; k0 = (r / 112) * 64; const int j = r % 112; n0 = j < 64 ? 64 * j : (j < 96 ? C_LQ + 64 * (j - 64) : C_MQ + 64 * (j - 96)); }
                else { r -= I_IN; k0 = ((r & 1023) >> 5) * 64; n0 = (r & 31) * 64; ldw = 2048;
                    if (r < 1024) { W = (const float*)args.in[I_WMKV]; WT = WmkvT; ldt = DM; }
                    else if (r < 2048) { W = (const float*)args.in[I_WBD]; WT = WbrT; ldt = 4096; }
                    else if (r < 2560) { W = (const float*)args.in[I_WBL]; WT = WbrT; ldt = 4096; ko = 2048; }
                    else if (r < 3072) { W = (const float*)args.in[I_WBM]; WT = WbrT; ldt = 4096; ko = 3072; k0 = (((r - 2560) & 511) >> 5) * 64; }
                    else { W = (const float*)args.in[I_WOUT]; WT = WoutT; ldt = DM; } }
                src = W + (size_t)(k0 + 2 * (lane >> 4)) * ldw + n0 + 4 * (lane & 15); dst = WT + (size_t)n0 * ldt + ko + k0; };
            f32x4 va[16], vb[16]; const float* s; int ldw, lta = 0, ltb = 0; bf16_t* da = nullptr; bf16_t* db = nullptr;
            int r = gw;
            if (r < NITEMS) { dec(r, s, ldw, da, lta); t16_load(va, s, ldw); }
            if (r + NGW < NITEMS) { dec(r + NGW, s, ldw, db, ltb); t16_load(vb, s, ldw); }
            while (r < NITEMS) {
                t16_store(va, da, lta, scr, lane);
                if (r + 2 * NGW < NITEMS) { dec(r + 2 * NGW, s, ldw, da, lta); t16_load(va, s, ldw); }
                if (r + NGW >= NITEMS) break;
                t16_store(vb, db, ltb, scr, lane);
                if (r + 3 * NGW < NITEMS) { dec(r + 3 * NGW, s, ldw, db, ltb); t16_load(vb, s, ldw); }
                r += 2 * NGW;
            }
        }
        {
            const float* wgu = (const float*)args.in[I_WGU]; const float* wd = (const float*)args.in[I_WD];
            constexpr int F8_LO = I_GU + I_DN, NF8 = I_GU + I_DN + 16 * 288;
            const float* wing = (const float*)args.in[I_WIN];
            f32x4 va[16], vb[16]; const float* s; int ldw; unsigned char* da = nullptr; unsigned char* db = nullptr;
            int r = F8_LO + gw;
            if (r < NF8) { f8_decode(r, wgu, wd, wing, WguT, WdT, WinG8, lane, s, da, ldw); f8_load(va, s, ldw); }
            if (r + NGW < NF8) { f8_decode(r + NGW, wgu, wd, wing, WguT, WdT, WinG8, lane, s, db, ldw); f8_load(vb, s, ldw); }
            while (r < NF8) {
                f8_store(va, da, scr, lane);
                if (r + 2 * NGW < NF8) { f8_decode(r + 2 * NGW, wgu, wd, wing, WguT, WdT, WinG8, lane, s, da, ldw); f8_load(va, s, ldw); }
                if (r + NGW >= NF8) break;
                f8_store(vb, db, scr, lane);
                if (r + 3 * NGW < NF8) { f8_decode(r + 3 * NGW, wgu, wd, wing, WguT, WdT, WinG8, lane, s, db, ldw); f8_load(vb, s, ldw); }
                r += 2 * NGW;
            }
        }
        for (int m = gw; m < T; m += 2 * NGW) {
            if (m + NGW < T) rms_rows_to_bf16<2, true>(x + (size_t)m * DM, (size_t)NGW * DM, (const float*)args.in[I_GMIX], XN + (size_t)m * DM, (size_t)NGW * DM, lane, XN8 + (size_t)m * DM);
            else rms_rows_to_bf16<1, true>(x + (size_t)m * DM, 0, (const float*)args.in[I_GMIX], XN + (size_t)m * DM, 0, lane, XN8 + (size_t)m * DM); }
        for (int m = gw; m < TM; m += NGW) rms_rows_to_bf16<1>((const float*)args.in[I_MEM] + (size_t)m * DM, 0, (const float*)args.in[I_GMEM], MN + (size_t)m * DM, 0, lane);
        { const int* pos = (const int*)args.in[I_POS];
          for (int i = bx * NTHR + tid; i < T * 16; i += G * NTHR) { const int tok = i >> 4, f = i & 15; const double rev = (double)pos[tok] * ROPE_REV[f]; const float fr_ = (float)(rev - __builtin_floor(rev));
              CS[(size_t)tok * 32 + f] = __builtin_amdgcn_cosf(fr_); CS[(size_t)tok * 32 + 16 + f] = __builtin_amdgcn_sinf(fr_); } }
        for (int i = bx * NTHR + tid; i < PSLOTS; i += G * NTHR) SLOTA[i] = -1;
        { const float* wr = (const float*)args.in[I_WR]; const float* gf = (const float*)args.in[I_GFFN];
          for (int i = bx * NTHR + tid; i < 2048 * 32; i += G * NTHR) WR2[i] = wr[i] * gf[i >> 5]; }
        if (bx == 1 && tid < 128) { SCAL[1024 + tid] = ((const float*)args.in[I_DQN])[tid]; SCAL[1024 + 128 + tid] = ((const float*)args.in[I_DKN])[tid];
            SCAL[1024 + 256 + tid] = ((const float*)args.in[I_LQN])[tid]; SCAL[1024 + 384 + tid] = ((const float*)args.in[I_LKN])[tid]; }
        if (bx == 0 && wave == 0) { const float* lp = (const float*)args.in[I_DLAM];
            const float s1 = wave_sum(lp[lane] * lp[128 + lane] + lp[64 + lane] * lp[192 + lane]), s2 = wave_sum(lp[256 + lane] * lp[384 + lane] + lp[320 + lane] * lp[448 + lane]);
            if (lane == 0) SCAL[0] = __expf(s1) - __expf(s2) + LAM_INIT; }
    }
    SEAM(0);

    if (IN(1)) {
        EpiProj<1> E1; E1.out = PROJ; E1.ldc = INC; E1.memkv = 0; E1.gt = SCAL + 1024;
        E1.gmq = (const float*)args.in[I_MQN]; E1.gmk = (const float*)args.in[I_MKN]; E1.bgate = (const float*)args.in[I_BGATE]; E1.cs = CS; E1.P = (LAS float*)(lds + EPIP_OFF);
        SchedGrid S; S.A = (const char*)XN; S.B = (const char*)WinT; S.nM = 64; S.nt = 32; S.G = G; S.c = bx; S.astep = (size_t)256 * DM * 2; S.bstep = (size_t)256 * DM * 2;
        S.nN = 24; S.pn_a = 16; S.pn_skip = 8; S.pn0 = 0;
        pg8::gemm_phase<EpiProj<1>, SchedGrid>(lds + RING_OFF, DM, DM, (size_t)128 * DM * 2, S, E1);
        EpiProj<0> E0; E0.out = PROJ; E0.ldc = INC; E0.memkv = 0; E0.gt = E1.gt; E0.gmq = E1.gmq; E0.gmk = E1.gmk; E0.bgate = E1.bgate; E0.cs = CS; E0.P = E1.P;
        S.nN = 12; S.pn_a = 8; S.pn_skip = 8; S.pn0 = 16;
        { SchedGrid S8 = S; S8.A = (const char*)XN8; S8.B = (const char*)WinG8; S8.nt = 16; S8.astep = (size_t)256 * DM; S8.bstep = (size_t)256 * DM;
          pg8::gemm_phase<EpiProj<0>, SchedGrid, true>(lds + RING_OFF, DM / 2, DM / 2, (size_t)128 * DM, S8, E0); }
        EpiProj<2> E2; E2.out = PROJ; E2.ldc = INC; E2.memkv = 0; E2.gt = E1.gt; E2.gmq = E1.gmq; E2.gmk = E1.gmk; E2.bgate = E1.bgate; E2.cs = CS; E2.P = E1.P;
        S.nN = 4; S.pn_a = 4; S.pn_skip = 0; S.pn0 = 36;
        pg8::gemm_phase<EpiProj<2>, SchedGrid>(lds + RING_OFF, DM, DM, (size_t)128 * DM * 2, S, E2);
        EpiProj<3> E3; E3.out = PROJ; E3.ldc = INC; E3.memkv = 0; E3.gt = E1.gt; E3.gmq = E1.gmq; E3.gmk = E1.gmk; E3.bgate = E1.bgate; E3.cs = CS; E3.P = E1.P;
        S.nN = 24; S.pn_a = 24; S.pn_skip = 0; S.pn0 = 40;
        { SchedGrid S8 = S; S8.A = (const char*)XN8; S8.B = (const char*)WinG8; S8.nt = 16; S8.astep = (size_t)256 * DM; S8.bstep = (size_t)256 * DM;
          pg8::gemm_phase<EpiProj<3>, SchedGrid, true>(lds + RING_OFF, DM / 2, DM / 2, (size_t)128 * DM, S8, E3); }
    }
    SEAM(1);

    if (IN(2)) { LANE_CONSTS(); constexpr int qo = 0;
        const float lam = SCAL[0];
        att::DiffOut dout; dout.ob = OB; dout.subln = (const float*)args.in[I_SUBLN]; dout.lam = lam;
        for (int mu = bx; mu < 16; mu += G) {
            SchedGrid S2; S2.A = (const char*)MN; S2.B = (const char*)WmkvT; S2.nM = 2; S2.nN = 4; S2.nt = 32; S2.G = 1 << 20; S2.c = mu & 7; S2.astep = (size_t)256 * DM * 2; S2.bstep = (size_t)256 * DM * 2;
            S2.pn_a = 4; S2.pn_skip = 0; S2.pn0 = mu < 8 ? 0 : 4;
            if (mu < 8) { EpiProj<2> E2; E2.out = KVM; E2.ldc = 2048; E2.memkv = 1; E2.gt = SCAL + 1024; E2.gmq = (const float*)args.in[I_MQN]; E2.gmk = (const float*)args.in[I_MKN]; E2.bgate = (const float*)args.in[I_BGATE];
                E2.cs = CS; E2.P = (LAS float*)(lds + EPIP_OFF);
                pg8::gemm_phase<EpiProj<2>, SchedGrid>(lds + RING_OFF, DM, DM, (size_t)128 * DM * 2, S2, E2); }
            else { EpiProj<0> E0; E0.out = KVM; E0.ldc = 2048; E0.memkv = 1; E0.gt = SCAL + 1024; E0.gmq = (const float*)args.in[I_MQN]; E0.gmk = (const float*)args.in[I_MKN]; E0.bgate = (const float*)args.in[I_BGATE];
                E0.cs = CS; E0.P = (LAS float*)(lds + EPIP_OFF);
                pg8::gemm_phase<EpiProj<0>, SchedGrid>(lds + RING_OFF, DM, DM, (size_t)128 * DM * 2, S2, E0); }
            if (threadIdx.x == 0) { __builtin_amdgcn_fence(__ATOMIC_RELEASE, "agent"); asm volatile("s_waitcnt vmcnt(0)" ::: "memory"); (void)xb_add(ctl + CW_KVM + qo, 1u); }
        }
        const int xcc = (int)(xb_xcc_id() & 7u);
        auto diff_units = [&]() __attribute__((always_inline)) {
            int t_ = threadIdx.x; asm volatile("" : "+v"(t_)); const int tid = t_, lane = t_ & 63, wave = __builtin_amdgcn_readfirstlane(t_ >> 6); (void)tid; (void)lane; (void)wave;
        for (;;) {
            if (tid == 0) { int u = -1;
                for (int kq = 0; kq < 8 && u < 0; ++kq) { const int q = (xcc + kq) & 7; const unsigned v = xb_add(ctl + CW_QDIFF + qo + 64 * q, 1u); if (v < 128u) u = q * 128 + (int)v; }
                MISC[16] = (unsigned)u; }
            __syncthreads(); const int u = (int)MISC[16]; __syncthreads();
            if (u < 0) break;
            const int q = u >> 7, v = u & 127, bh = 2 * q + (v & 1), qb = 63 - (v >> 1), b = bh >> 3, h = bh & 7, s0 = qb * 128;
            att::CoopArgs a; a.q = PROJ + ((size_t)b * SEQ + s0) * INC + C_DQ + h * 256; a.k0 = PROJ + (size_t)b * SEQ * INC + C_DK + h * 256; a.k1 = a.k0 + 128;
            a.v = PROJ + (size_t)b * SEQ * INC + C_DV + h * 256; a.rsq = INC; a.rsk = INC; a.nt = 2 * (qb + 1);
            att::coop_unit<0>((LAS char*)(lds + RING_OFF), a, s0, 1.4426950408889634f * 0.08838834764831845f, 0.08838834764831845f, OB + ((size_t)b * SEQ + s0) * 4096 + h * 256, 4096, dout);
        }
        };
        auto mem_units = [&](int maxn) __attribute__((always_inline)) {
            int t_ = threadIdx.x; asm volatile("" : "+v"(t_)); const int tid = t_, lane = t_ & 63, wave = __builtin_amdgcn_readfirstlane(t_ >> 6); (void)tid; (void)lane; (void)wave;
            if (tid == 0) { XB_SPIN(xb_ld(ctl + CW_KVM + qo) < 16u, ctl + CW_BAR); __builtin_amdgcn_fence(__ATOMIC_ACQUIRE, "agent"); asm volatile("s_waitcnt vmcnt(0)" ::: "memory"); }
            __syncthreads();
            for (int n = 0; n < maxn; ++n) {
                if (tid == 0) { int u = -1;
                    for (int kq = 0; kq < 8 && u < 0; ++kq) { const int q = (xcc + kq) & 7; const unsigned v = xb_add(ctl + CW_QMEM + qo + 64 * q, 1u); if (v < 64u) u = q * 64 + (int)v; }
                    MISC[16] = (unsigned)u; }
                __syncthreads(); const int u = (int)MISC[16]; __syncthreads();
                if (u < 0) break;
                const int q = u >> 6, b = q >> 2, hm = q & 3, qg = b * 64 + (u & 63);
                att::CoopArgs a; a.q = PROJ + (size_t)qg * 128 * INC + C_MQ + hm * 256; a.k0 = KVM + (size_t)b * MEML * 2048 + hm * 256; a.k1 = a.k0 + 128;
                a.v = KVM + (size_t)b * MEML * 2048 + 1024 + hm * 256; a.rsq = INC; a.rsk = 2048; a.nt = 4;
                att::coop_unit<1>((LAS char*)(lds + RING_OFF), a, 0, 1.4426950408889634f * 0.0625f, 0.0625f, OB + (size_t)qg * 128 * 4096 + 3072 + hm * 256, 4096, dout);
            }
        };
        auto stretch = [&]() __attribute__((always_inline)) {
            int t_ = threadIdx.x; asm volatile("" : "+v"(t_)); const int tid = t_, lane = t_ & 63, wave = __builtin_amdgcn_readfirstlane(t_ >> 6); (void)tid; (void)lane; (void)wave;
        {
            const float* wgu = (const float*)args.in[I_WGU]; const float* wd = (const float*)args.in[I_WD];
            LAS unsigned* scr = (LAS unsigned*)(lds + RING_OFF + wave * 16384);
            constexpr int CBN = 16, NBATCH = (32 * 32 * 64 + 32 * 32 * 32) / CBN;
            bool dil_left = true, conv_left = true;
            auto mix_round = [&]() __attribute__((always_inline)) {
                int t_ = threadIdx.x; asm volatile("" : "+v"(t_)); const int lane = t_ & 63; (void)lane;
                if (dil_left) { int wu = -1;
                    if (lane == 0) { for (int kq = 0; kq < 8 && wu < 0; ++kq) { const int q = (xcc + kq) & 7; const unsigned v = xb_add(ctl + CW_QDIL + qo + 64 * q, 1u); if (v < 512u) wu = (2 * q + (int)(v & 1u)) * 256 + (int)(v >> 1); } }
                    wu = __builtin_amdgcn_readfirstlane(wu);
                    if (wu < 0) dil_left = false; else att::dil_wave_unit((LAS char*)scr, PROJ, OB, wu, lane); }
                for (int rep = 0; rep < 2 && conv_left; ++rep) {
                    int cb = 0; if (lane == 0) cb = (int)xb_add(ctl + CW_QCONV + qo, 1u);
                    cb = __builtin_amdgcn_readfirstlane(cb);
                    if (cb >= NBATCH) { conv_left = false; break; }
                    f32x4 va[16], vb[16]; const float* s; int ldw; unsigned char* da = nullptr; unsigned char* db = nullptr;
                    int r = cb * CBN; const int rend = r + CBN;
                    f8_decode(r, wgu, wd, nullptr, WguT, WdT, nullptr, lane, s, da, ldw); f8_load(va, s, ldw);
                    f8_decode(r + 1, wgu, wd, nullptr, WguT, WdT, nullptr, lane, s, db, ldw); f8_load(vb, s, ldw);
                    while (r < rend) {
                        f8_store(va, da, scr, lane);
                        if (r + 2 < rend) { f8_decode(r + 2, wgu, wd, nullptr, WguT, WdT, nullptr, lane, s, da, ldw); f8_load(va, s, ldw); }
                        f8_store(vb, db, scr, lane);
                        if (r + 3 < rend) { f8_decode(r + 3, wgu, wd, nullptr, WguT, WdT, nullptr, lane, s, db, ldw); f8_load(vb, s, ldw); }
                        r += 2;
                    }
                }
            };
#pragma unroll 1
            for (int it = 0; it < 4; ++it) {
                mix_round();
                if (it == (bx & 3)) { __syncthreads(); mem_units(2); __syncthreads(); }
            }
            while (dil_left || conv_left) mix_round();
        }
        __syncthreads();
        mem_units(1 << 30);
        __syncthreads();
        };
        const bool stretch_first = ((bx >> 3) & 3) == 0;
        if (stretch_first) { stretch(); diff_units(); } else { diff_units(); stretch(); }
    }
    SEAM(2);

    if (IN(3)) {
        EpiBranch E; E.proj = PROJ; E.merged = MERGED;
        SchedBranch S; S.A = (const char*)OB; S.B = (const char*)WbrT; S.G = G; S.c = bx;
        pg8::gemm_phase<EpiBranch, SchedBranch>(lds + RING_OFF, 4096, 4096, (size_t)128 * 4096 * 2, S, E);
    }
    SEAM(3);

    if (IN(4)) {
        EpiOut E; E.x = x; E.x1 = X1;
        SchedGrid S; S.A = (const char*)MERGED; S.B = (const char*)WoutT; S.nM = 64; S.nN = 8; S.nt = 32; S.G = G; S.c = bx; S.astep = (size_t)256 * DM * 2; S.bstep = (size_t)256 * DM * 2; S.pn_a = 8; S.pn_skip = 0; S.pn0 = 0;
        pg8::gemm_phase<EpiOut, SchedGrid>(lds + RING_OFF, DM, DM, (size_t)128 * DM * 2, S, E);
    }
    SEAM(4);

    if (IN(5)) { LANE_CONSTS();
        LAS float* part = (LAS float*)(lds + RING_OFF);
        LAS float* ssp = part + 8 * 32 * 33;
        LAS float* rsd = ssp + 8 * 32;
        LAS unsigned* asl = (LAS unsigned*)(rsd + 32);
        const float* brt = (const float*)args.in[I_BR];
        for (int tt = bx; tt < T / 32; tt += G) {
            const int m = lane & 31, kh = lane >> 5; const size_t tok = (size_t)tt * 32 + m;
            const bf16_t* xr = X1 + tok * DM + wave * 256 + 4 * kh; const float* wp = WR2 + (wave * 256 + 4 * kh) * 32 + m;
            f32x16 acc;
#pragma unroll
            for (int r = 0; r < 16; ++r) acc[r] = 0.f;
            float ss = 0.f;
#pragma unroll 8
            for (int c = 0; c < 32; ++c) { const u32x2 xw = *(const u32x2*)(xr + 8 * c); const f32x4 xv = {bf_lo(xw.x), bf_hi(xw.x), bf_lo(xw.y), bf_hi(xw.y)}; ss += (xv[0] * xv[0] + xv[1] * xv[1]) + (xv[2] * xv[2] + xv[3] * xv[3]);
                const float* w = wp + c * 256;
                acc = __builtin_amdgcn_mfma_f32_32x32x2f32(xv[0], w[0], acc, 0, 0, 0); acc = __builtin_amdgcn_mfma_f32_32x32x2f32(xv[1], w[32], acc, 0, 0, 0);
                acc = __builtin_amdgcn_mfma_f32_32x32x2f32(xv[2], w[64], acc, 0, 0, 0); acc = __builtin_amdgcn_mfma_f32_32x32x2f32(xv[3], w[96], acc, 0, 0, 0); }
            ss += __shfl_xor(ss, 32);
#pragma unroll
            for (int r = 0; r < 16; ++r) part[(wave * 32 + (r & 3) + 8 * (r >> 2) + 4 * kh) * 33 + m] = acc[r];
            if (lane < 32) ssp[wave * 32 + m] = ss;
            __syncthreads();
            if (lane < 4) {
                const int tl = wave * 4 + lane; const size_t tk = (size_t)tt * 32 + tl;
                float s2 = 0.f;
#pragma unroll
                for (int w8 = 0; w8 < 8; ++w8) s2 += ssp[w8 * 32 + tl];
                const float rstd = __builtin_amdgcn_rsqf(s2 * (1.f / 2048.f) + EPS);
                float lg[32];
#pragma unroll
                for (int e = 0; e < 32; ++e) { float a = 0.f;
#pragma unroll
                    for (int w8 = 0; w8 < 8; ++w8) a += part[(w8 * 32 + tl) * 33 + e];
                    lg[e] = a * rstd + brt[e]; }
                unsigned chosen = 0u; float tv[4]; int te[4];
#pragma unroll
                for (int kk = 0; kk < 4; ++kk) { float best = -__builtin_inff(); int bi = 0;
#pragma unroll
                    for (int e = 0; e < 32; ++e) { const float v = ((chosen >> e) & 1u) ? -__builtin_inff() : lg[e]; if (v > best) { best = v; bi = e; } }
                    chosen |= 1u << bi; tv[kk] = best; te[kk] = bi; }
                const float e1 = __expf(tv[1] - tv[0]), e2 = __expf(tv[2] - tv[0]), e3 = __expf(tv[3] - tv[0]); const float inv = 1.f / (1.f + e1 + e2 + e3);
                const float wv[4] = {inv, e1 * inv, e2 * inv, e3 * inv};
                rsd[tl] = rstd;
#pragma unroll
                for (int kk = 0; kk < 4; ++kk) { const unsigned pos = xb_add(ctl + CW_CNT + 64 * te[kk], 1u); const unsigned slot = (unsigned)te[kk] * ECAP + pos;
                    SLOTA[slot] = (int)(tk * 4 + kk); SLOTW[slot] = wv[kk]; asl[tl * 4 + kk] = slot; }
            }
            LDS_WAIT(); asm volatile("" ::: "memory");
            {
                const f32x4* gr = (const f32x4*)args.in[I_GFFN] + lane;
#pragma unroll 1
                for (int q = 0; q < 4; ++q) { const int tl = wave * 4 + q; const size_t tk = (size_t)tt * 32 + tl; const float rstd = rsd[tl];
                    const u32x2* xq = (const u32x2*)(X1 + tk * DM) + lane; unsigned w8[8];
#pragma unroll
                    for (int j = 0; j < 8; ++j) { const u32x2 xw = xq[64 * j]; const f32x4 v = {bf_lo(xw.x), bf_hi(xw.x), bf_lo(xw.y), bf_hi(xw.y)}, g = gr[64 * j]; w8[j] = pack4_fp8(v[0] * rstd * g[0], v[1] * rstd * g[1], v[2] * rstd * g[2], v[3] * rstd * g[3]); }
#pragma unroll
                    for (int kk = 0; kk < 4; ++kk) { unsigned* o4 = (unsigned*)(XG + (size_t)asl[tl * 4 + kk] * DM) + lane;
#pragma unroll
                        for (int j = 0; j < 8; ++j) o4[64 * j] = w8[j]; } }
            }
            __syncthreads();
        }
    }
    SEAM(5);

    if (IN(6)) { LANE_CONSTS();
        LAS int* tab = (LAS int*)(lds + TAB_OFF);
        const int nrb = moe_tables(ctl, tab, tid);
        EpiSwiglu E; E.bgu = (const float*)args.in[I_BGU]; E.act = ACT;
        SchedMoE S; S.A = (const char*)XG; S.B = (const char*)WguT; S.rb2e = tab; S.nrb = nrb; S.NPN = 16; S.G = G; S.c = bx; S.nt = 16; S.apan = (size_t)256 * 2048; S.bexp = (size_t)4096 * 2048; S.bpn = (size_t)128 * 2048;
        pg8::gemm_phase<EpiSwiglu, SchedMoE, true>(lds + RING_OFF, 1024, 1024, (size_t)2048 * 2048, S, E);
    }
    SEAM(6);

    if (IN(7)) { LANE_CONSTS();
        LAS int* tab = (LAS int*)(lds + TAB_OFF);
        const int nrb = moe_tables(ctl, tab, tid);
        EpiDown E; E.bd = (const float*)args.in[I_BD]; E.slot_asg = SLOTA; E.slot_w = SLOTW; E.ybuf = YBUF;
        SchedMoE S; S.A = (const char*)ACT; S.B = (const char*)WdT; S.rb2e = tab; S.nrb = nrb; S.NPN = 8; S.G = G; S.c = bx; S.nt = 16; S.apan = (size_t)256 * 2048; S.bexp = (size_t)2048 * 2048; S.bpn = (size_t)256 * 2048;
        pg8::gemm_phase<EpiDown, SchedMoE, true>(lds + RING_OFF, 1024, 1024, (size_t)128 * 2048, S, E);
    }
    SEAM(7);

    if (IN(8)) { LANE_CONSTS();
        for (size_t i = (size_t)bx * NTHR + tid; i < (size_t)T * 256; i += (size_t)G * NTHR) {
            const size_t t = i >> 8; const int c8 = (int)(i & 255) * 8;
            const u32x4 xw = *(const u32x4*)(X1 + t * DM + c8); f32x4 a0 = {bf_lo(xw.x), bf_hi(xw.x), bf_lo(xw.y), bf_hi(xw.y)}, a1 = {bf_lo(xw.z), bf_hi(xw.z), bf_lo(xw.w), bf_hi(xw.w)};
#pragma unroll
            for (int k = 0; k < 4; ++k)
            { const u32x4 y = *(const u32x4*)(YBUF + (t * 4 + k) * DM + c8);
                a0[0] += bf_lo(y.x); a0[1] += bf_hi(y.x); a0[2] += bf_lo(y.y); a0[3] += bf_hi(y.y); a1[0] += bf_lo(y.z); a1[1] += bf_hi(y.z); a1[2] += bf_lo(y.w); a1[3] += bf_hi(y.w); }
            *(f32x4*)(args.out + t * DM + c8) = a0; *(f32x4*)(args.out + t * DM + c8 + 4) = a1;
        }
    }
#undef IN
#undef SEAM
}

#ifndef MK_N_LAUNCHES
#define MK_N_LAUNCHES 1
#endif
extern "C" void kernel_launch(void* const* d_in, const int* in_sizes, int n_in, void* d_out, int out_size, void* d_ws, size_t ws_size, hipStream_t stream) {
    static int grid = 0;
    if (grid == 0) {
        if (n_in != N_IN || out_size != T * DM || ws_size < WS_END) { fprintf(stderr, "kernel_launch: unexpected shapes (n_in %d, out %d, ws %zu)\n", n_in, out_size, ws_size); grid = -1; return; }
        int dev = 0, cus = 0, per_cu = 0;
        if (hipGetDevice(&dev) != hipSuccess || hipDeviceGetAttribute(&cus, hipDeviceAttributeMultiprocessorCount, dev) != hipSuccess) { grid = -1; return; }
        if (hipFuncSetAttribute((const void*)fwd, hipFuncAttributeMaxDynamicSharedMemorySize, LDS_BYTES) != hipSuccess) { fprintf(stderr, "kernel_launch: hipFuncSetAttribute failed\n"); grid = -1; return; }
        if (hipOccupancyMaxActiveBlocksPerMultiprocessor(&per_cu, (const void*)fwd, NTHR, LDS_BYTES) != hipSuccess || per_cu < 1) { fprintf(stderr, "kernel_launch: occupancy query reports %d\n", per_cu); }
        (void)hipGetLastError();
        grid = cus;
    }
    if (grid < 0) return;
    if (hipMemsetAsync((char*)d_ws + WS_CTL, 0, CTL_ZERO_BYTES, stream) != hipSuccess) return;
    Args a{};
    for (int i = 0; i < N_IN; ++i) a.in[i] = d_in[i];
    a.out = (float*)d_out; a.ws = (unsigned char*)d_ws; a.pad = 0;
#if MK_N_LAUNCHES == 1
    a.ph_lo = 0; a.ph_hi = N_PHASES; a.use_bar = 1;
    hipLaunchKernelGGL(fwd, dim3(grid), dim3(NTHR), LDS_BYTES, stream, a);
#else
    for (int p = 0; p < N_PHASES; ++p) { a.ph_lo = p; a.ph_hi = p + 1; a.use_bar = 0; hipLaunchKernelGGL(fwd, dim3(grid), dim3(NTHR), LDS_BYTES, stream, a); }
#endif
}
```

```cpp
#include <hip/hip_runtime.h>
#include <cstdio>
#include <cstdint>
#include <type_traits>

#define GAS __attribute__((address_space(1)))
#define LAS __attribute__((address_space(3)))
typedef unsigned short bf16_t;
typedef short bf16x8 __attribute__((ext_vector_type(8)));
typedef short s16x4 __attribute__((ext_vector_type(4)));
typedef float f32x4 __attribute__((ext_vector_type(4)));
typedef float f32x2 __attribute__((ext_vector_type(2)));
typedef float f32x16 __attribute__((ext_vector_type(16)));
typedef unsigned u32x4 __attribute__((ext_vector_type(4)));
typedef unsigned u32x2 __attribute__((ext_vector_type(2)));
#define DI __device__ __forceinline__
#define VM_WAIT() asm volatile("s_waitcnt vmcnt(0)" ::: "memory")
#define LDS_WAIT() asm volatile("s_waitcnt lgkmcnt(0)" ::: "memory")
#define SBAR() __builtin_amdgcn_sched_barrier(0)

typedef __bf16 bf16x2_t __attribute__((ext_vector_type(2)));
DI unsigned cvt_pk_bf16(float lo, float hi) { const f32x2 v = {lo, hi}; return __builtin_bit_cast(unsigned, __builtin_convertvector(v, bf16x2_t)); }
DI unsigned cvt_pk_bf16_a(float lo, float hi) { unsigned r; asm volatile("s_nop 0\n\tv_cvt_pk_bf16_f32 %0, %1, %2" : "=v"(r) : "v"(lo), "v"(hi)); return r; }
DI float bf_lo(unsigned w) { return __uint_as_float(w << 16); }
DI float bf_hi(unsigned w) { return __uint_as_float(w & 0xffff0000u); }
DI float wave_sum(float v) {
#pragma unroll
    for (int o = 1; o < 64; o <<= 1) v += __shfl_xor(v, o);
    return v;
}

constexpr int BATCH = 2, SEQ = 8192, DM = 2048, T = BATCH * SEQ;
constexpr int MEML = 256, TM = BATCH * MEML;
constexpr int INC = 16384;
constexpr int C_DQ = 0, C_DK = 2048, C_DV = 4096, C_LQ = 6144, C_LK = 7168, C_LV = 8192, C_MQ = 9216, C_G = 10240;
constexpr int NE = 32, TOPK = 4, DFF = 2048;
constexpr int NASG = T * TOPK;
constexpr int ECAP = 16384;
constexpr int PSLOTS = NE * ECAP;
constexpr int MAXRB = PSLOTS / 256;
constexpr float EPS = 1e-6f;
constexpr float LAM_INIT = 0.2f;
constexpr int NWAVES = 8, NTHR = 512;
DI unsigned pack4_fp8(float a, float b, float c, float d) { int w = __builtin_amdgcn_cvt_pk_fp8_f32(a, b, 0, false); w = __builtin_amdgcn_cvt_pk_fp8_f32(c, d, w, true); return (unsigned)w; }
namespace pg8 {
typedef int i32x4 __attribute__((ext_vector_type(4)));
constexpr int WSH = 6; constexpr int WSCALE_E8M0 = (127 - WSH) * 0x01010101;
constexpr int BM = 256, BK = 64, HALF = 128, HTB = HALF * BK * 2  , STAGE_BYTES = 8 * HTB, NXCD = 8, WGM = 8;
__host__ __device__ __forceinline__ int lds_byte(int r, int c) { const int st = (r >> 4) * 2 + (c >> 5), rr = r & 15, cc = c & 31, ob = rr * 64 + cc * 2; return st * 1024 + (ob ^ (((ob >> 9) & 1) << 5)); }
__host__ __device__ __forceinline__ void stage_rc(int b, int& R, int& C) { const int st = b / 1024, sb = b % 1024, swz = sb ^ (((sb >> 9) & 1) << 5); R = (st >> 1) * 16 + swz / 64; C = (st & 1) * 32 + (swz % 64) / 2; }
__host__ __device__ __forceinline__ int perm32(int rho) { const int n = rho >> 4, i = rho & 15; return 8 * (i >> 2) + 4 * n + (i & 3); }

struct GU { const char* A; const char* B; int nt; int pm, pn, tag; int half; };

DI void tile_order(int L, int nM, int nN, int& pm, int& pn) {
    const int nwg = nM * nN; int wgid = L;
    { const int q = nwg / NXCD, r = nwg % NXCD, xcd = wgid % NXCD, off = wgid / NXCD; wgid = (xcd < r ? xcd * (q + 1) : r * (q + 1) + (xcd - r) * q) + off; }
    const int nig = WGM * nN, gid = wgid / nig, fm = gid * WGM, gsz = (nM - fm) < WGM ? (nM - fm) : WGM;
    pm = fm + ((wgid % nig) % gsz); pn = (wgid % nig) / gsz;
}

template <class Epi, class Sched, bool FP8 = false, bool ALIGN_EPI = true, bool SP2 = true>
DI void gemm_phase(LAS unsigned char* lds, const int lda, const int ldb, const size_t hstepB, const Sched& S, const Epi& E) {
    int tid_ = threadIdx.x; asm volatile("" : "+v"(tid_));
    const int tid = tid_, wid = __builtin_amdgcn_readfirstlane(tid >> 6), lane = tid & 63, wr = wid >> 2, wc = (wid + wr) & 3  , fr = lane & 15, fq = lane >> 4;
    unsigned voffA[2], voffB[2];
#pragma unroll
    for (int i = 0; i < 2; ++i) { int R, C; stage_rc(tid * 16 + i * 8192, R, C); const int Rb = Epi::PERM ? ((R & ~31) + perm32(R & 31)) : R;
        voffA[i] = (unsigned)(R * lda + C) * 2u; voffB[i] = (unsigned)(Rb * ldb + C) * 2u; }
    const size_t kstep = (size_t)(BK * 2);
    const size_t hstepA = (size_t)HALF * lda * 2;
    const unsigned ldsw = (unsigned)wid * 1024u;
    const int aoff = lds_byte(wr * 64 + fr, fq * 8), boff = lds_byte(wc * 32 + fr, fq * 8);
#define PG8_SA(b, h) (((b) * 2 + (h)) * HTB)
#define PG8_SB(b, h) ((4 + (b) * 2 + (h)) * HTB)
#define PG8_STAGE(bufoff, gbase, voff) do { _Pragma("unroll") for (int _i = 0; _i < 2; ++_i) \
        __builtin_amdgcn_global_load_lds((const unsigned*)((const char*)(gbase) + (voff)[_i]), (LAS unsigned*)(lds + (bufoff) + ldsw + _i * 8192), 16, 0, 0); } while (0)
#define PG8_LD1(dst, i_, off) do { if constexpr (FP8) { const i32x4 _p0 = *(const LAS i32x4*)(lds + (off)), _p1 = *(const LAS i32x4*)(lds + (off) + 1024); dst##8[i_] = __builtin_shufflevector(_p0, _p1, 0, 1, 2, 3, 4, 5, 6, 7); } \
        else { dst[i_][0] = *(const LAS bf16x8*)(lds + (off)); dst[i_][1] = *(const LAS bf16x8*)(lds + (off) + 1024); } } while (0)
#define PG8_LDA(dst, b, h) do { _Pragma("unroll") for (int m = 0; m < 4; ++m) PG8_LD1(dst, m, PG8_SA(b, h) + aoff + m * 2048); } while (0)
#define PG8_LDB(dst, b, h) do { _Pragma("unroll") for (int n = 0; n < 2; ++n) PG8_LD1(dst, n, PG8_SB(b, h) + boff + n * 2048); } while (0)
#define PG8_CAT(x0, x1) __builtin_shufflevector(__builtin_bit_cast(i32x4, x0), __builtin_bit_cast(i32x4, x1), 0, 1, 2, 3, 4, 5, 6, 7)
#define PG8_MMA(ai, bj, At, Bt) do { __builtin_amdgcn_s_setprio(1); _Pragma("unroll") for (int m = 0; m < 4; ++m) _Pragma("unroll") for (int n = 0; n < 2; ++n) { \
        if constexpr (FP8) asm volatile("v_mfma_scale_f32_16x16x128_f8f6f4 %0, %1, %2, %0, %3, %4 op_sel_hi:[0,0,0]" : "+v"(acc[ai][bj][m][n]) : "v"(Bt##8[n]), "v"(At##8[m]), "v"(wscale), "v"(ascale)); \
        else { _Pragma("unroll") for (int k = 0; k < 2; ++k) acc[ai][bj][m][n] = __builtin_amdgcn_mfma_f32_16x16x32_bf16(Bt[n][k], At[m][k], acc[ai][bj][m][n], 0, 0, 0); } } __builtin_amdgcn_s_setprio(0); } while (0)
#define PG8_WAIT_V(n) asm volatile("s_waitcnt vmcnt(" #n ")" ::: "memory")
#define PG8_WAIT_L(n) asm volatile("s_waitcnt lgkmcnt(" #n ")" ::: "memory")
#define PG8_BAR __builtin_amdgcn_s_barrier()
#define PG8_SCHED __builtin_amdgcn_sched_barrier(0)
    typedef int i32x8 __attribute__((ext_vector_type(8)));
    int wscale = WSCALE_E8M0, ascale = 0x7f7f7f7f; if constexpr (FP8) asm volatile("" : "+v"(wscale), "+v"(ascale));
    GU cur, nxt; int ui = 0;
    if (!S.next(0, cur)) return;
    f32x4 acc[2][2][4][2];
#pragma unroll
    for (int a = 0; a < 2; ++a)
#pragma unroll
        for (int b = 0; b < 2; ++b)
#pragma unroll
            for (int m = 0; m < 4; ++m)
#pragma unroll
                for (int n = 0; n < 2; ++n) acc[a][b][m][n] = (f32x4){0.f, 0.f, 0.f, 0.f};
    bf16x8 At[4][2], B0[2][2], B1[2][2];
    i32x8 At8[4], B08[2], B18[2];
    const char* cA = cur.A; const char* cB = cur.B;
    if constexpr (SP2) {
        PG8_STAGE(PG8_SB(0, 0), cB, voffB); PG8_STAGE(PG8_SB(0, 1), cB + hstepB, voffB); PG8_STAGE(PG8_SA(0, 0), cA, voffA); PG8_STAGE(PG8_SA(0, 1), cA + hstepA, voffA);
        if (wr == 1) PG8_BAR;
        PG8_WAIT_V(2); PG8_BAR;
        PG8_STAGE(PG8_SB(1, 0), cB + kstep, voffB); PG8_STAGE(PG8_SA(1, 0), cA + kstep, voffA); PG8_STAGE(PG8_SB(1, 1), cB + hstepB + kstep, voffB);
        PG8_WAIT_V(6); PG8_BAR;
    } else {
        PG8_STAGE(PG8_SB(0, 0), cB, voffB); PG8_STAGE(PG8_SA(0, 0), cA, voffA); PG8_STAGE(PG8_SB(0, 1), cB + hstepB, voffB); PG8_STAGE(PG8_SA(0, 1), cA + hstepA, voffA);
        if (wr == 1) PG8_BAR;
        PG8_WAIT_V(4); PG8_BAR;
        PG8_STAGE(PG8_SB(1, 0), cB + kstep, voffB); PG8_STAGE(PG8_SA(1, 0), cA + kstep, voffA); PG8_STAGE(PG8_SB(1, 1), cB + hstepB + kstep, voffB);
        PG8_WAIT_V(6); PG8_BAR;
    }
    for (;;) {
        const bool has_next = S.next(ui + 1, nxt);
        const char* nA = has_next ? nxt.A : cA; const char* nB = has_next ? nxt.B : cB;
        const int nt = cur.nt; const bool half1 = FP8 && cur.half != 0;
        for (int t = 0; t < nt; t += 2) {
            const bool last = (t == nt - 2);
            const char* a1 = cA + (size_t)(t + 1) * kstep;
            const char* a2 = last ? nA : cA + (size_t)(t + 2) * kstep; const char* b2 = last ? nB : cB + (size_t)(t + 2) * kstep;
            const char* a3 = a2 + kstep; const char* b3 = b2 + kstep;
            if constexpr (SP2) {
            PG8_LDB(B0, 0, 0); PG8_LDB(B1, 0, 1); PG8_SCHED; PG8_LDA(At, 0, 0); PG8_STAGE(PG8_SA(1, 1), a1 + hstepA, voffA);
            PG8_WAIT_V(8); PG8_WAIT_L(0); PG8_BAR; PG8_MMA(0, 0, At, B0); PG8_MMA(0, 1, At, B1); PG8_BAR; PG8_SCHED;
            if (!half1) PG8_LDA(At, 0, 1); PG8_STAGE(PG8_SB(0, 0), b2, voffB); PG8_STAGE(PG8_SB(0, 1), b2 + hstepB, voffB); PG8_STAGE(PG8_SA(0, 0), a2, voffA);
            PG8_WAIT_V(8); PG8_WAIT_L(0); PG8_BAR; if (!half1) { PG8_MMA(1, 0, At, B0); PG8_MMA(1, 1, At, B1); } PG8_BAR; PG8_SCHED;
            PG8_LDB(B0, 1, 0); PG8_LDB(B1, 1, 1); PG8_SCHED; PG8_LDA(At, 1, 0); PG8_STAGE(PG8_SA(0, 1), a2 + hstepA, voffA);
            PG8_WAIT_V(8); PG8_WAIT_L(0); PG8_BAR; PG8_MMA(0, 0, At, B0); PG8_MMA(0, 1, At, B1); PG8_BAR; PG8_SCHED;
            if (!half1) PG8_LDA(At, 1, 1); PG8_STAGE(PG8_SB(1, 0), b3, voffB); PG8_STAGE(PG8_SB(1, 1), b3 + hstepB, voffB); PG8_STAGE(PG8_SA(1, 0), a3, voffA);
            PG8_WAIT_V(8); PG8_WAIT_L(0); PG8_BAR; if (!half1) { PG8_MMA(1, 0, At, B0); PG8_MMA(1, 1, At, B1); } PG8_BAR; PG8_SCHED;
            } else {
            PG8_LDB(B0, 0, 0); PG8_SCHED; PG8_LDA(At, 0, 0); PG8_STAGE(PG8_SA(1, 1), a1 + hstepA, voffA);
            PG8_WAIT_L(8); PG8_BAR; PG8_WAIT_L(0); PG8_MMA(0, 0, At, B0); PG8_BAR; PG8_SCHED;
            PG8_LDB(B1, 0, 1); PG8_STAGE(PG8_SB(0, 0), b2, voffB);
            PG8_BAR; PG8_WAIT_L(0); PG8_MMA(0, 1, At, B1); PG8_BAR;
            PG8_LDA(At, 0, 1); PG8_STAGE(PG8_SA(0, 0), a2, voffA);
            PG8_BAR; PG8_WAIT_L(0); PG8_MMA(1, 0, At, B0); PG8_BAR; PG8_SCHED;
            PG8_STAGE(PG8_SB(0, 1), b2 + hstepB, voffB);
            PG8_WAIT_V(6); PG8_BAR; PG8_MMA(1, 1, At, B1); PG8_BAR;
            PG8_LDB(B0, 1, 0); PG8_SCHED; PG8_LDA(At, 1, 0); PG8_STAGE(PG8_SA(0, 1), a2 + hstepA, voffA);
            PG8_WAIT_L(8); PG8_BAR; PG8_WAIT_L(0); PG8_MMA(0, 0, At, B0); PG8_BAR; PG8_SCHED;
            PG8_LDB(B1, 1, 1); PG8_STAGE(PG8_SB(1, 0), b3, voffB);
            PG8_BAR; PG8_WAIT_L(0); PG8_MMA(0, 1, At, B1); PG8_BAR;
            PG8_LDA(At, 1, 1); PG8_STAGE(PG8_SA(1, 0), a3, voffA);
            PG8_BAR; PG8_WAIT_L(0); PG8_MMA(1, 0, At, B0); PG8_BAR; PG8_SCHED;
            PG8_STAGE(PG8_SB(1, 1), b3 + hstepB, voffB);
            PG8_WAIT_V(6); PG8_BAR; PG8_MMA(1, 1, At, B1); PG8_BAR;
            }
        }
        if constexpr (ALIGN_EPI) { if (wr == 0) PG8_BAR; }
        if constexpr (FP8) {
            asm volatile("s_nop 15\n\ts_nop 15" ::: "memory");
#pragma unroll
            for (int a = 0; a < 2; ++a)
#pragma unroll
                for (int b = 0; b < 2; ++b)
#pragma unroll
                    for (int m = 0; m < 4; ++m)
#pragma unroll
                        for (int n = 0; n < 2; ++n) asm volatile("" : "+v"(acc[a][b][m][n]));
        }
        const bool keep = E(acc, cur, wr, wc, fr, fq);
        if (!has_next) break;
        if (!keep) {
#pragma unroll
            for (int a = 0; a < 2; ++a)
#pragma unroll
                for (int b = 0; b < 2; ++b)
#pragma unroll
                    for (int m = 0; m < 4; ++m)
#pragma unroll
                        for (int n = 0; n < 2; ++n) acc[a][b][m][n] = (f32x4){0.f, 0.f, 0.f, 0.f};
        }
        cur = nxt; cA = nA; cB = nB; ++ui;
        if constexpr (ALIGN_EPI) { if (wr == 1) PG8_BAR; }
    }
    PG8_WAIT_V(0);
    if constexpr (!ALIGN_EPI) { if (wr == 0) PG8_BAR; }
    PG8_BAR;
#undef PG8_SA
#undef PG8_SB
#undef PG8_STAGE
#undef PG8_LD1
#undef PG8_LDA
#undef PG8_LDB
#undef PG8_MMA
#undef PG8_CAT
#undef PG8_WAIT_V
#undef PG8_WAIT_L
#undef PG8_BAR
#undef PG8_SCHED
}
}
constexpr int RING_OFF = 0, RING_BYTES = 131072;
constexpr int EPIP_OFF = RING_BYTES;
constexpr int TAB_OFF = EPIP_OFF + 8192;
constexpr int MISC_OFF = TAB_OFF + 2048;
constexpr int LDS_BYTES = 147456;
static_assert(MISC_OFF + 128 <= LDS_BYTES, "LDS map");

struct SchedGrid {
    const char* A; const char* B; int nM, nN, nt, G, c; size_t astep, bstep;
    int pn0, pn_a, pn_skip;
    DI bool next(int i, pg8::GU& u) const {
        const long L = (long)i * G + c; if (L >= (long)nM * nN) return false;
        int pm, pn; pg8::tile_order((int)L, nM, nN, pm, pn);
        pn = pn0 + pn + (pn >= pn_a ? pn_skip : 0);
        u.pm = pm; u.pn = pn; u.tag = 0; u.half = 0; u.nt = nt; u.A = A + (size_t)pm * astep; u.B = B + (size_t)pn * bstep; return true;
    }
};
struct SchedBranch {
    const char* A; const char* B; int G, c;
    DI bool next(int i, pg8::GU& u) const {
        const int ti = i / 3, sub = i - ti * 3; const long L = (long)ti * G + c; if (L >= 64 * 8) return false;
        int pm, pn; pg8::tile_order((int)L, 64, 8, pm, pn);
        const int koff = sub == 0 ? 0 : (sub == 1 ? 2048 : 3072);
        u.pm = pm; u.pn = pn; u.tag = sub; u.half = 0; u.nt = sub == 0 ? 32 : 16;
        u.A = A + ((size_t)pm * 256 * 4096 + koff) * 2; u.B = B + ((size_t)pn * 256 * 4096 + koff) * 2; return true;
    }
};
struct SchedMoE {
    const char* A; const char* B; const LAS int* rb2e; int nrb, NPN, G, c, nt; size_t apan, bexp, bpn;
    DI bool next(int i, pg8::GU& u) const {
        const long L = (long)i * G + c; if (L >= (long)nrb * NPN) return false;
        const int rb = (int)(L / NPN), pn = (int)(L - (long)rb * NPN); const int e = rb2e[rb];
        const int pm = e * (ECAP / 256) + (rb - rb2e[300 + e]);
        u.pm = pm; u.pn = pn; u.tag = e; u.nt = nt;
        u.half = rb2e[340 + e] - (rb - rb2e[300 + e]) * 256 <= 128;
        u.A = A + (size_t)pm * apan; u.B = B + (size_t)e * bexp + (size_t)pn * bpn; return true;
    }
};

typedef f32x4 AccT[2][2][4][2];
DI float sigmoidf_(float v) { v = fmaxf(v, -80.f); return __builtin_amdgcn_rcpf(1.f + __builtin_amdgcn_exp2f(-1.4426950408889634f * v)); }

template <int TYPE  > struct EpiProj {
    static constexpr bool PERM = true;
    bf16_t* out; int ldc; int memkv;
    const float *gt, *gmq, *gmk, *bgate; const float* cs;
    LAS float* P;
    DI bool operator()(AccT& acc, const pg8::GU& u, int wr, int wc, int fr, int fq) const {
        asm volatile("" : "+v"(fr), "+v"(fq));
        const float* gain = nullptr;
        const int pn = u.pn;
        if (TYPE == 2) gain = memkv ? gmk : gmq;
        if (TYPE == 1) gain = gt + (pn < 16 ? (pn >> 3) : 2 + ((pn - 24) >> 2)) * 128;
        const int rloc0 = wr * 64 + fr, cloc0 = wc * 32 + 8 * fq;
        if (TYPE == 1 || TYPE == 2) {
            const bool dorope = (TYPE == 1) && wc == 0;
            constexpr int NS = 3;
            f32x4 cc[NS][2], ss[NS][2];
            if (dorope) {
#pragma unroll
                for (int m = 0; m < NS; ++m) { const float* cp = cs + ((size_t)u.pm * 256 + rloc0 + m * 16) * 32 + 8 * (fq & 1);
#pragma unroll
                    for (int n = 0; n < 2; ++n) { cc[m][n] = *(const f32x4*)(cp + 4 * n); ss[m][n] = *(const f32x4*)(cp + 16 + 4 * n); } } }
            constexpr int NG = TYPE == 2 ? 2 : 1;
            f32x4 g[NG][2];
#pragma unroll
            for (int bj = 0; bj < NG; ++bj)
#pragma unroll
                for (int n = 0; n < 2; ++n) g[bj][n] = *(const f32x4*)(gain + bj * 128 + cloc0 + n * 4);
            asm volatile("" ::: "memory");
#pragma unroll
            for (int ai = 0; ai < 2; ++ai)
#pragma unroll
                for (int m = 0; m < 4; ++m)
#pragma unroll
                    for (int bj = 0; bj < 2; ++bj) { float s = 0.f;
#pragma unroll
                        for (int n = 0; n < 2; ++n) { const f32x4 x = acc[ai][bj][m][n]; s += (x[0] * x[0] + x[1] * x[1]) + (x[2] * x[2] + x[3] * x[3]); }
                        s += __shfl_xor(s, 16); s += __shfl_xor(s, 32);
                        if (fq == 0) P[(ai * 128 + rloc0 + m * 16) * 8 + bj * 4 + wc] = s; }
            LDS_WAIT(); __builtin_amdgcn_s_barrier(); asm volatile("" ::: "memory");
#pragma unroll
            for (int ai = 0; ai < 2; ++ai)
#pragma unroll
                for (int m = 0; m < 4; ++m) {
                    const LAS f32x4* pr = (const LAS f32x4*)(P + (ai * 128 + rloc0 + m * 16) * 8);
                    const f32x4 p0 = pr[0], p1 = pr[1];
                    const float t0 = (p0[0] + p0[1]) + (p0[2] + p0[3]), t1 = (p1[0] + p1[1]) + (p1[2] + p1[3]);
                    float r0, r1;
                    if (TYPE == 1) { r0 = __builtin_amdgcn_rsqf(t0 * (1.f / 128.f) + EPS); r1 = __builtin_amdgcn_rsqf(t1 * (1.f / 128.f) + EPS); }
                    else { r0 = r1 = __builtin_amdgcn_rsqf((t0 + t1) * (1.f / 256.f) + EPS); }
#pragma unroll
                    for (int n = 0; n < 2; ++n) { acc[ai][0][m][n] = acc[ai][0][m][n] * r0 * g[0][n]; acc[ai][1][m][n] = acc[ai][1][m][n] * r1 * g[NG - 1][n]; }
                    if (dorope) {
#pragma unroll
                        for (int n = 0; n < 2; ++n) { const f32x4 c = cc[(ai * 4 + m) % NS][n], s = ss[(ai * 4 + m) % NS][n];
#pragma unroll
                            for (int bj = 0; bj < 2; ++bj)
#pragma unroll
                                for (int jp = 0; jp < 4; jp += 2) {
                                    const float cs_ = fq < 2 ? c[jp] : c[jp + 1], sn_ = fq < 2 ? s[jp] : s[jp + 1];
                                    auto r1 = __builtin_amdgcn_permlane32_swap(__float_as_uint(acc[ai][bj][m][n][jp]), __float_as_uint(acc[ai][bj][m][n][jp + 1]), false, false);
                                    const float u1 = __uint_as_float(r1[0]), u2 = __uint_as_float(r1[1]);
                                    const float o1 = u1 * cs_ - u2 * sn_, o2 = u2 * cs_ + u1 * sn_;
                                    auto r2 = __builtin_amdgcn_permlane32_swap(__float_as_uint(o1), __float_as_uint(o2), false, false);
                                    acc[ai][bj][m][n][jp] = __uint_as_float(r2[0]); acc[ai][bj][m][n][jp + 1] = __uint_as_float(r2[1]); } }
                        if (ai * 4 + m + NS < 8) {
                            constexpr int dummy = 0; (void)dummy; const int rn = ai * 4 + m + NS;
                            const float* cp = cs + ((size_t)u.pm * 256 + (rn >> 2) * 128 + rloc0 + (rn & 3) * 16) * 32 + 8 * (fq & 1);
#pragma unroll
                            for (int n = 0; n < 2; ++n) { cc[(ai * 4 + m) % NS][n] = *(const f32x4*)(cp + 4 * n); ss[(ai * 4 + m) % NS][n] = *(const f32x4*)(cp + 16 + 4 * n); } }
                    }
                    asm volatile("" : "+v"(acc[ai][0][m][0]), "+v"(acc[ai][0][m][1]), "+v"(acc[ai][1][m][0]), "+v"(acc[ai][1][m][1]));
#pragma unroll
                    for (int bj = 0; bj < 2; ++bj) { const f32x4 v0 = acc[ai][bj][m][0], v1 = acc[ai][bj][m][1]; u32x4 w;
                        w.x = cvt_pk_bf16(v0[0], v0[1]); w.y = cvt_pk_bf16(v0[2], v0[3]); w.z = cvt_pk_bf16(v1[0], v1[1]); w.w = cvt_pk_bf16(v1[2], v1[3]);
                        *(u32x4*)(out + ((size_t)u.pm * 256 + ai * 128 + rloc0 + m * 16) * ldc + pn * 256 + cloc0 + bj * 128) = w; }
                    asm volatile("" ::: "memory");
                }
            return false;
        } else if (TYPE == 3) {
            const int cb = pn * 256 - C_G + cloc0;
            f32x4 bvv[2][2];
#pragma unroll
            for (int bj = 0; bj < 2; ++bj)
#pragma unroll
                for (int n = 0; n < 2; ++n) bvv[bj][n] = *(const f32x4*)(bgate + cb + bj * 128 + n * 4);
            asm volatile("" ::: "memory");
#pragma unroll
            for (int ai = 0; ai < 2; ++ai)
#pragma unroll
                for (int m = 0; m < 4; ++m) {
#pragma unroll
                    for (int bj = 0; bj < 2; ++bj)
#pragma unroll
                        for (int n = 0; n < 2; ++n) { f32x4 v = acc[ai][bj][m][n] + bvv[bj][n];
                            v[0] = sigmoidf_(v[0]); v[1] = sigmoidf_(v[1]); v[2] = sigmoidf_(v[2]); v[3] = sigmoidf_(v[3]); acc[ai][bj][m][n] = v; }
#pragma unroll
                    for (int bj = 0; bj < 2; ++bj) { const f32x4 v0 = acc[ai][bj][m][0], v1 = acc[ai][bj][m][1]; u32x4 w;
                        w.x = cvt_pk_bf16(v0[0], v0[1]); w.y = cvt_pk_bf16(v0[2], v0[3]); w.z = cvt_pk_bf16(v1[0], v1[1]); w.w = cvt_pk_bf16(v1[2], v1[3]);
                        *(u32x4*)(out + ((size_t)u.pm * 256 + ai * 128 + rloc0 + m * 16) * ldc + pn * 256 + cloc0 + bj * 128) = w; }
                    asm volatile("" ::: "memory");
                }
            return false;
        }
#pragma unroll
        for (int ai = 0; ai < 2; ++ai)
#pragma unroll
            for (int m = 0; m < 4; ++m) { bf16_t* rowp = out + ((size_t)u.pm * 256 + ai * 128 + rloc0 + m * 16) * ldc + pn * 256 + cloc0;
#pragma unroll
                for (int bj = 0; bj < 2; ++bj) { const f32x4 v0 = acc[ai][bj][m][0], v1 = acc[ai][bj][m][1]; u32x4 w;
                    w.x = cvt_pk_bf16(v0[0], v0[1]); w.y = cvt_pk_bf16(v0[2], v0[3]); w.z = cvt_pk_bf16(v1[0], v1[1]); w.w = cvt_pk_bf16(v1[2], v1[3]);
                    *(u32x4*)(rowp + bj * 128) = w; } }
        return false;
    }
};

struct EpiBranch {
    static constexpr bool PERM = true; static constexpr int EB_ROWS = 4;
    const bf16_t* proj; bf16_t* merged;
    DI bool operator()(AccT& acc, const pg8::GU& u, int wr, int wc, int fr, int fq) const {
        asm volatile("" : "+v"(fr), "+v"(fq));
        const int sub = u.tag; const int rloc0 = wr * 64 + fr, col0 = u.pn * 256 + wc * 32 + 8 * fq;
        const int oa = sub * 2048, ob = (sub < 2 ? sub + 1 : 2) * 2048;
        const bool ratio = sub < 2;
#pragma unroll
        for (int am = 0; am < 8; am += EB_ROWS) {
            u32x4 A[EB_ROWS][2], B[EB_ROWS][2];
#pragma unroll
            for (int q = 0; q < EB_ROWS; ++q)
#pragma unroll
                for (int bj = 0; bj < 2; ++bj) { const int ai = (am + q) >> 2, m = (am + q) & 3; const bf16_t* gp = proj + ((size_t)u.pm * 256 + ai * 128 + rloc0 + m * 16) * INC + C_G + col0 + bj * 128;
                    A[q][bj] = *(const u32x4*)(gp + oa); B[q][bj] = *(const u32x4*)(gp + ob); }
            asm volatile("" ::: "memory");
#pragma unroll
            for (int q = 0; q < EB_ROWS; ++q) { const int ai = (am + q) >> 2, m = (am + q) & 3;
#pragma unroll
                for (int bj = 0; bj < 2; ++bj) { const u32x4 a = A[q][bj], b = B[q][bj];
#define EB_F(av, bv) ((av) * (ratio ? __builtin_amdgcn_rcpf(bv) : 1.f))
                    const f32x4 f0 = {EB_F(bf_lo(a.x), bf_lo(b.x)), EB_F(bf_hi(a.x), bf_hi(b.x)), EB_F(bf_lo(a.y), bf_lo(b.y)), EB_F(bf_hi(a.y), bf_hi(b.y))};
                    const f32x4 f1 = {EB_F(bf_lo(a.z), bf_lo(b.z)), EB_F(bf_hi(a.z), bf_hi(b.z)), EB_F(bf_lo(a.w), bf_lo(b.w)), EB_F(bf_hi(a.w), bf_hi(b.w))};
#undef EB_F
                    acc[ai][bj][m][0] = acc[ai][bj][m][0] * f0; acc[ai][bj][m][1] = acc[ai][bj][m][1] * f1; } }
            asm volatile("" ::: "memory");
        }
        if (sub == 2) {
#pragma unroll
            for (int ai = 0; ai < 2; ++ai)
#pragma unroll
                for (int m = 0; m < 4; ++m) { const size_t row = (size_t)u.pm * 256 + ai * 128 + rloc0 + m * 16;
#pragma unroll
                    for (int bj = 0; bj < 2; ++bj) { const f32x4 v0 = acc[ai][bj][m][0], v1 = acc[ai][bj][m][1]; u32x4 w;
                        w.x = cvt_pk_bf16(v0[0], v0[1]); w.y = cvt_pk_bf16(v0[2], v0[3]); w.z = cvt_pk_bf16(v1[0], v1[1]); w.w = cvt_pk_bf16(v1[2], v1[3]);
                        *(u32x4*)(merged + row * DM + col0 + bj * 128) = w; } }
        }
        return sub < 2;
    }
};

struct EpiOut {
    static constexpr bool PERM = true;
    const float* x; bf16_t* x1;
    DI bool operator()(AccT& acc, const pg8::GU& u, int wr, int wc, int fr, int fq) const {
        const int rloc0 = wr * 64 + fr, col0 = u.pn * 256 + wc * 32 + 8 * fq;
#pragma unroll
        for (int ai = 0; ai < 2; ++ai)
            { f32x4 xv[4][2][2];
#pragma unroll
              for (int m = 0; m < 4; ++m) { const size_t off = ((size_t)u.pm * 256 + ai * 128 + rloc0 + m * 16) * DM + col0;
#pragma unroll
                for (int bj = 0; bj < 2; ++bj)
#pragma unroll
                    for (int n = 0; n < 2; ++n) xv[m][bj][n] = __builtin_nontemporal_load((const f32x4*)(x + off + bj * 128 + n * 4)); }
              asm volatile("" ::: "memory");
#pragma unroll
              for (int m = 0; m < 4; ++m) { const size_t off = ((size_t)u.pm * 256 + ai * 128 + rloc0 + m * 16) * DM + col0;
#pragma unroll
                for (int bj = 0; bj < 2; ++bj) { const f32x4 v0 = xv[m][bj][0] + acc[ai][bj][m][0], v1 = xv[m][bj][1] + acc[ai][bj][m][1]; u32x4 w;
                    w.x = cvt_pk_bf16(v0[0], v0[1]); w.y = cvt_pk_bf16(v0[2], v0[3]); w.z = cvt_pk_bf16(v1[0], v1[1]); w.w = cvt_pk_bf16(v1[2], v1[3]);
                    *(u32x4*)(x1 + off + bj * 128) = w; } }
              asm volatile("" ::: "memory"); }
        return false;
    }
};

struct EpiSwiglu {
    static constexpr bool PERM = true;
    const float* bgu; unsigned char* act;
    DI bool operator()(AccT& acc, const pg8::GU& u, int wr, int wc, int fr, int fq) const {
        const int rloc0 = wr * 64 + fr, cc = wc * 32 + 8 * fq, gcol = u.pn * 128 + cc; const float* bp = bgu + (size_t)u.tag * 4096 + gcol;
        const f32x4 bg0 = *(const f32x4*)bp, bg1 = *(const f32x4*)(bp + 4), bu0 = *(const f32x4*)(bp + 2048), bu1 = *(const f32x4*)(bp + 2052);
#pragma unroll
        for (int ai = 0; ai < 2; ++ai)
#pragma unroll
            for (int m = 0; m < 4; ++m) { const size_t row = (size_t)u.pm * 256 + ai * 128 + rloc0 + m * 16;
                f32x4 r[2];
#pragma unroll
                for (int n = 0; n < 2; ++n) { const f32x4 gt = acc[ai][0][m][n] + (n ? bg1 : bg0), up = acc[ai][1][m][n] + (n ? bu1 : bu0);
#pragma unroll
                    for (int j = 0; j < 4; ++j) { const float g = fminf(gt[j], 7.f), uu = fminf(fmaxf(up[j], -7.f), 7.f);
                        r[n][j] = (uu + 1.f) * g * __builtin_amdgcn_rcpf(1.f + __builtin_amdgcn_exp2f(-1.702f * 1.4426950408889634f * g)); } }
                u32x2 w; w.x = pack4_fp8(r[0][0], r[0][1], r[0][2], r[0][3]); w.y = pack4_fp8(r[1][0], r[1][1], r[1][2], r[1][3]);
                *(u32x2*)(act + row * DFF + gcol) = w; }
        return false;
    }
};

struct EpiDown {
    static constexpr bool PERM = true;
    const float* bd; const int* slot_asg; const float* slot_w; bf16_t* ybuf;
    DI bool operator()(AccT& acc, const pg8::GU& u, int wr, int wc, int fr, int fq) const {
        const int rloc0 = wr * 64 + fr, col0 = u.pn * 256 + wc * 32 + 8 * fq; const float* bp = bd + (size_t)u.tag * DM + col0;
        f32x4 bv[2][2];
#pragma unroll
        for (int bj = 0; bj < 2; ++bj)
#pragma unroll
            for (int n = 0; n < 2; ++n) bv[bj][n] = *(const f32x4*)(bp + bj * 128 + 4 * n);
        int av[2][4]; float wv[2][4];
#pragma unroll
        for (int ai = 0; ai < 2; ++ai)
#pragma unroll
            for (int m = 0; m < 4; ++m) { const size_t slot = (size_t)u.pm * 256 + ai * 128 + rloc0 + m * 16; av[ai][m] = slot_asg[slot]; wv[ai][m] = slot_w[slot]; }
        asm volatile("" ::: "memory");
#pragma unroll
        for (int ai = 0; ai < 2; ++ai)
#pragma unroll
            for (int m = 0; m < 4; ++m) { const int a = av[ai][m]; const float wgt = wv[ai][m];
                if (a >= 0) {
#pragma unroll
                    for (int bj = 0; bj < 2; ++bj) { const f32x4 v0 = (acc[ai][bj][m][0] + bv[bj][0]) * wgt, v1 = (acc[ai][bj][m][1] + bv[bj][1]) * wgt; u32x4 w;
                        w.x = cvt_pk_bf16(v0[0], v0[1]); w.y = cvt_pk_bf16(v0[2], v0[3]); w.z = cvt_pk_bf16(v1[0], v1[1]); w.w = cvt_pk_bf16(v1[2], v1[3]);
                        *(u32x4*)(ybuf + (size_t)a * DM + col0 + bj * 128) = w; } } }
        return false;
    }
};
namespace att {
constexpr int SHM_K = 64 * 128 * 2, SHM_V = 64 * 256 * 2, STG = 2 * SHM_K + SHM_V;
#define KSWZ(row, colB) ((row) * 256 + ((colB) ^ (((row) & 7) << 4)))
DI int swap23(int k) { return (k & ~0xC) | ((k & 4) << 1) | ((k & 8) >> 1); }
DI int v_rd_base(int lane) { return ((lane & 3) << 3) | (((lane >> 2) & 3) << 6) | (((lane >> 4) & 1) << 5) | (((lane >> 5) & 1) << 8); }
DI int crow(int r, int hi) { return (r & 3) + 8 * (r >> 2) + 4 * hi; }

DI void mask_causal(f32x16& p0, f32x16& p1, int dq) {
    const float NEG = -__builtin_inff();
#pragma unroll
    for (int r = 0; r < 16; ++r) { const int c = (r & 3) + 8 * (r >> 2);
        if (dq - c < 0) p0[r] = NEG;
        if (dq - c - 32 < 0) p1[r] = NEG; }
}
template <int NP>
DI void partialSM(f32x16& p0, f32x16& p1, float& m_reg, float& alpha, const float C2, const float SCALE) {
    float pmax = p0[0];
#pragma unroll
    for (int r = 1; r < 16; ++r) pmax = fmaxf(pmax, p0[r]);
    if (NP == 2) {
#pragma unroll
        for (int r = 0; r < 16; ++r) pmax = fmaxf(pmax, p1[r]); }
    { auto rr = __builtin_amdgcn_permlane32_swap(__float_as_uint(pmax), __float_as_uint(pmax), false, false);
      pmax = fmaxf(__uint_as_float(rr[0]), __uint_as_float(rr[1])); }
    float mn;
    if (__builtin_expect(__all((pmax - m_reg) * SCALE <= 8.f), 1)) { mn = m_reg; alpha = 1.f; }
    else { mn = fmaxf(m_reg, pmax); alpha = __builtin_amdgcn_exp2f((m_reg - mn) * C2); m_reg = mn; }
    const float mnL = -mn * C2;
#pragma unroll
    for (int r = 0; r < 16; ++r) p0[r] = __builtin_amdgcn_exp2f(fmaf(p0[r], C2, mnL));
    if (NP == 2) {
#pragma unroll
        for (int r = 0; r < 16; ++r) p1[r] = __builtin_amdgcn_exp2f(fmaf(p1[r], C2, mnL)); }
}
#define PK4(P, B_, OUT) do { unsigned a0 = cvt_pk_bf16_a(P[B_+0], P[B_+1]), a1 = cvt_pk_bf16_a(P[B_+2], P[B_+3]);                          \
        unsigned b0 = cvt_pk_bf16_a(P[B_+4], P[B_+5]), b1 = cvt_pk_bf16_a(P[B_+6], P[B_+7]);                                             \
        asm volatile("s_nop 1" : "+v"(a0), "+v"(a1), "+v"(b0), "+v"(b1));                                                                                                         \
        auto r0 = __builtin_amdgcn_permlane32_swap(a0, b0, false, false); auto r1 = __builtin_amdgcn_permlane32_swap(a1, b1, false, false); \
        u32x4 w = {r0[0], r1[0], r0[1], r1[1]}; OUT = *reinterpret_cast<bf16x8*>(&w); } while (0)
template <int NP>
DI void finishSM(f32x16& p0, f32x16& p1, float alpha, float& l_reg, bf16x8& pa0, bf16x8& pa1, bf16x8& pa2, bf16x8& pa3) {
    float ps = 0.f;
#pragma unroll
    for (int r = 0; r < 16; ++r) ps += p0[r];
    if (NP == 2) {
#pragma unroll
        for (int r = 0; r < 16; ++r) ps += p1[r]; }
    { auto rr = __builtin_amdgcn_permlane32_swap(__float_as_uint(ps), __float_as_uint(ps), false, false);
      ps = __uint_as_float(rr[0]) + __uint_as_float(rr[1]); }
    l_reg = l_reg * alpha + ps;
    PK4(p0, 0, pa0); PK4(p0, 8, pa1);
    if (NP == 2) { PK4(p1, 0, pa2); PK4(p1, 8, pa3); }
}
DI void qkt(f32x16& p0, f32x16& p1, const LAS char* Kt, int r32, int hi, const bf16x8* qr) {
    const LAS char* kb[4];
#pragma unroll
    for (int dd = 0; dd < 4; ++dd) kb[dd] = Kt + KSWZ(r32, (dd * 16 + hi * 8) * 2);
#pragma unroll
    for (int d0 = 0; d0 < 8; ++d0) { const LAS char* a = kb[d0 & 3] + (d0 >> 2) * 128;
        const bf16x8 b0 = *reinterpret_cast<const LAS bf16x8*>(a);
        const bf16x8 b1 = *reinterpret_cast<const LAS bf16x8*>(a + 32 * 256);
        p0 = __builtin_amdgcn_mfma_f32_32x32x16_bf16(b0, qr[d0], p0, 0, 0, 0);
        p1 = __builtin_amdgcn_mfma_f32_32x32x16_bf16(b1, qr[d0], p1, 0, 0, 0); }
}
#define TRRD(dst, vb, off) asm volatile("ds_read_b64_tr_b16 %0, %1 offset:%2" : "=&v"(dst) : "v"(vb), "i"(off) : "memory")
#define TR8_64(S_, vb, base_, NCB) do { constexpr int b_ = (base_); \
        TRRD(S_##l0, vb, b_); TRRD(S_##h0, vb, b_ + NCB * 512); TRRD(S_##l1, vb, b_ + 2 * NCB * 512); TRRD(S_##h1, vb, b_ + 3 * NCB * 512);               \
        TRRD(S_##l2, vb, b_ + 4 * NCB * 512); TRRD(S_##h2, vb, b_ + 5 * NCB * 512); TRRD(S_##l3, vb, b_ + 6 * NCB * 512); TRRD(S_##h3, vb, b_ + 7 * NCB * 512); } while (0)
#define MMA4_64(o_, S_) do { \
        o_ = __builtin_amdgcn_mfma_f32_32x32x16_bf16((bf16x8){S_##l0[0], S_##l0[1], S_##l0[2], S_##l0[3], S_##h0[0], S_##h0[1], S_##h0[2], S_##h0[3]}, pa0, o_, 0, 0, 0);   \
        o_ = __builtin_amdgcn_mfma_f32_32x32x16_bf16((bf16x8){S_##l1[0], S_##l1[1], S_##l1[2], S_##l1[3], S_##h1[0], S_##h1[1], S_##h1[2], S_##h1[3]}, pa1, o_, 0, 0, 0);   \
        o_ = __builtin_amdgcn_mfma_f32_32x32x16_bf16((bf16x8){S_##l2[0], S_##l2[1], S_##l2[2], S_##l2[3], S_##h2[0], S_##h2[1], S_##h2[2], S_##h2[3]}, pa2, o_, 0, 0, 0);   \
        o_ = __builtin_amdgcn_mfma_f32_32x32x16_bf16((bf16x8){S_##l3[0], S_##l3[1], S_##l3[2], S_##l3[3], S_##h3[0], S_##h3[1], S_##h3[2], S_##h3[3]}, pa3, o_, 0, 0, 0); } while (0)
#define LGKM_WAIT(n) asm volatile("s_waitcnt lgkmcnt(" #n ")" ::: "memory")
#define PV_STEP(o_, Scur, Snxt, vb, nbase, NCB) do { TR8_64(Snxt, vb, nbase, NCB); LGKM_WAIT(8); SBAR(); MMA4_64(o_, Scur); SBAR(); } while (0)
#define PV_LAST(o_, Scur) do { LGKM_WAIT(0); SBAR(); MMA4_64(o_, Scur); SBAR(); } while (0)
#define PV_DECL() s16x4 fAl0, fAl1, fAl2, fAl3, fAh0, fAh1, fAh2, fAh3, fBl0, fBl1, fBl2, fBl3, fBh0, fBh1, fBh2, fBh3
#define PV_D0_32(o_, vb, base_, NCB) do { s16x4 l0, l1, h0, h1; constexpr int b_ = (base_);                                                   \
        TRRD(l0, vb, b_); TRRD(h0, vb, b_ + NCB * 512); TRRD(l1, vb, b_ + 2 * NCB * 512); TRRD(h1, vb, b_ + 3 * NCB * 512);               \
        asm volatile("s_waitcnt lgkmcnt(0)" ::: "memory"); SBAR();                                                                          \
        o_ = __builtin_amdgcn_mfma_f32_32x32x16_bf16((bf16x8){l0[0], l0[1], l0[2], l0[3], h0[0], h0[1], h0[2], h0[3]}, pa0, o_, 0, 0, 0);   \
        o_ = __builtin_amdgcn_mfma_f32_32x32x16_bf16((bf16x8){l1[0], l1[1], l1[2], l1[3], h1[0], h1[1], h1[2], h1[3]}, pa1, o_, 0, 0, 0); } while (0)

#define PV_JOUTER_64_DIFF(o, vb) do { s16x4 jl0, jl1, jl2, jl3, jl4, jh0, jh1, jh2, jh3, jh4; \
        TRRD(jl0, vb, 0); TRRD(jh0, vb, 4096); \
        TRRD(jl1, vb, 512); TRRD(jh1, vb, 4608); \
        TRRD(jl2, vb, 1024); TRRD(jh2, vb, 5120); \
        TRRD(jl3, vb, 1536); TRRD(jh3, vb, 5632); \
        TRRD(jl4, vb, 2048); TRRD(jh4, vb, 6144); LGKM_WAIT(8); SBAR(); o[0] = __builtin_amdgcn_mfma_f32_32x32x16_bf16((bf16x8){jl0[0], jl0[1], jl0[2], jl0[3], jh0[0], jh0[1], jh0[2], jh0[3]}, pa0, o[0], 0, 0, 0); SBAR(); \
        TRRD(jl0, vb, 2560); TRRD(jh0, vb, 6656); LGKM_WAIT(8); SBAR(); o[1] = __builtin_amdgcn_mfma_f32_32x32x16_bf16((bf16x8){jl1[0], jl1[1], jl1[2], jl1[3], jh1[0], jh1[1], jh1[2], jh1[3]}, pa0, o[1], 0, 0, 0); SBAR(); \
        TRRD(jl1, vb, 3072); TRRD(jh1, vb, 7168); LGKM_WAIT(8); SBAR(); o[2] = __builtin_amdgcn_mfma_f32_32x32x16_bf16((bf16x8){jl2[0], jl2[1], jl2[2], jl2[3], jh2[0], jh2[1], jh2[2], jh2[3]}, pa0, o[2], 0, 0, 0); SBAR(); \
        TRRD(jl2, vb, 3584); TRRD(jh2, vb, 7680); LGKM_WAIT(8); SBAR(); o[3] = __builtin_amdgcn_mfma_f32_32x32x16_bf16((bf16x8){jl3[0], jl3[1], jl3[2], jl3[3], jh3[0], jh3[1], jh3[2], jh3[3]}, pa0, o[3], 0, 0, 0); SBAR(); \
        TRRD(jl3, vb, 8192); TRRD(jh3, vb, 12288); LGKM_WAIT(8); SBAR(); o[4] = __builtin_amdgcn_mfma_f32_32x32x16_bf16((bf16x8){jl4[0], jl4[1], jl4[2], jl4[3], jh4[0], jh4[1], jh4[2], jh4[3]}, pa0, o[4], 0, 0, 0); SBAR(); \
        TRRD(jl4, vb, 8704); TRRD(jh4, vb, 12800); LGKM_WAIT(8); SBAR(); o[5] = __builtin_amdgcn_mfma_f32_32x32x16_bf16((bf16x8){jl0[0], jl0[1], jl0[2], jl0[3], jh0[0], jh0[1], jh0[2], jh0[3]}, pa0, o[5], 0, 0, 0); SBAR(); \
        TRRD(jl0, vb, 9216); TRRD(jh0, vb, 13312); LGKM_WAIT(8); SBAR(); o[6] = __builtin_amdgcn_mfma_f32_32x32x16_bf16((bf16x8){jl1[0], jl1[1], jl1[2], jl1[3], jh1[0], jh1[1], jh1[2], jh1[3]}, pa0, o[6], 0, 0, 0); SBAR(); \
        TRRD(jl1, vb, 9728); TRRD(jh1, vb, 13824); LGKM_WAIT(8); SBAR(); o[7] = __builtin_amdgcn_mfma_f32_32x32x16_bf16((bf16x8){jl2[0], jl2[1], jl2[2], jl2[3], jh2[0], jh2[1], jh2[2], jh2[3]}, pa0, o[7], 0, 0, 0); SBAR(); \
        TRRD(jl2, vb, 10240); TRRD(jh2, vb, 14336); LGKM_WAIT(8); SBAR(); o[0] = __builtin_amdgcn_mfma_f32_32x32x16_bf16((bf16x8){jl3[0], jl3[1], jl3[2], jl3[3], jh3[0], jh3[1], jh3[2], jh3[3]}, pa1, o[0], 0, 0, 0); SBAR(); \
        TRRD(jl3, vb, 10752); TRRD(jh3, vb, 14848); LGKM_WAIT(8); SBAR(); o[1] = __builtin_amdgcn_mfma_f32_32x32x16_bf16((bf16x8){jl4[0], jl4[1], jl4[2], jl4[3], jh4[0], jh4[1], jh4[2], jh4[3]}, pa1, o[1], 0, 0, 0); SBAR(); \
        TRRD(jl4, vb, 11264); TRRD(jh4, vb, 15360); LGKM_WAIT(8); SBAR(); o[2] = __builtin_amdgcn_mfma_f32_32x32x16_bf16((bf16x8){jl0[0], jl0[1], jl0[2], jl0[3], jh0[0], jh0[1], jh0[2], jh0[3]}, pa1, o[2], 0, 0, 0); SBAR(); \
        TRRD(jl0, vb, 11776); TRRD(jh0, vb, 15872); LGKM_WAIT(8); SBAR(); o[3] = __builtin_amdgcn_mfma_f32_32x32x16_bf16((bf16x8){jl1[0], jl1[1], jl1[2], jl1[3], jh1[0], jh1[1], jh1[2], jh1[3]}, pa1, o[3], 0, 0, 0); SBAR(); \
        TRRD(jl1, vb, 16384); TRRD(jh1, vb, 20480); LGKM_WAIT(8); SBAR(); o[4] = __builtin_amdgcn_mfma_f32_32x32x16_bf16((bf16x8){jl2[0], jl2[1], jl2[2], jl2[3], jh2[0], jh2[1], jh2[2], jh2[3]}, pa1, o[4], 0, 0, 0); SBAR(); \
        TRRD(jl2, vb, 16896); TRRD(jh2, vb, 20992); LGKM_WAIT(8); SBAR(); o[5] = __builtin_amdgcn_mfma_f32_32x32x16_bf16((bf16x8){jl3[0], jl3[1], jl3[2], jl3[3], jh3[0], jh3[1], jh3[2], jh3[3]}, pa1, o[5], 0, 0, 0); SBAR(); \
        TRRD(jl3, vb, 17408); TRRD(jh3, vb, 21504); LGKM_WAIT(8); SBAR(); o[6] = __builtin_amdgcn_mfma_f32_32x32x16_bf16((bf16x8){jl4[0], jl4[1], jl4[2], jl4[3], jh4[0], jh4[1], jh4[2], jh4[3]}, pa1, o[6], 0, 0, 0); SBAR(); \
        TRRD(jl4, vb, 17920); TRRD(jh4, vb, 22016); LGKM_WAIT(8); SBAR(); o[7] = __builtin_amdgcn_mfma_f32_32x32x16_bf16((bf16x8){jl0[0], jl0[1], jl0[2], jl0[3], jh0[0], jh0[1], jh0[2], jh0[3]}, pa1, o[7], 0, 0, 0); SBAR(); \
        TRRD(jl0, vb, 18432); TRRD(jh0, vb, 22528); LGKM_WAIT(8); SBAR(); o[0] = __builtin_amdgcn_mfma_f32_32x32x16_bf16((bf16x8){jl1[0], jl1[1], jl1[2], jl1[3], jh1[0], jh1[1], jh1[2], jh1[3]}, pa2, o[0], 0, 0, 0); SBAR(); \
        TRRD(jl1, vb, 18944); TRRD(jh1, vb, 23040); LGKM_WAIT(8); SBAR(); o[1] = __builtin_amdgcn_mfma_f32_32x32x16_bf16((bf16x8){jl2[0], jl2[1], jl2[2], jl2[3], jh2[0], jh2[1], jh2[2], jh2[3]}, pa2, o[1], 0, 0, 0); SBAR(); \
        TRRD(jl2, vb, 19456); TRRD(jh2, vb, 23552); LGKM_WAIT(8); SBAR(); o[2] = __builtin_amdgcn_mfma_f32_32x32x16_bf16((bf16x8){jl3[0], jl3[1], jl3[2], jl3[3], jh3[0], jh3[1], jh3[2], jh3[3]}, pa2, o[2], 0, 0, 0); SBAR(); \
        TRRD(jl3, vb, 19968); TRRD(jh3, vb, 24064); LGKM_WAIT(8); SBAR(); o[3] = __builtin_amdgcn_mfma_f32_32x32x16_bf16((bf16x8){jl4[0], jl4[1], jl4[2], jl4[3], jh4[0], jh4[1], jh4[2], jh4[3]}, pa2, o[3], 0, 0, 0); SBAR(); \
        TRRD(jl4, vb, 24576); TRRD(jh4, vb, 28672); LGKM_WAIT(8); SBAR(); o[4] = __builtin_amdgcn_mfma_f32_32x32x16_bf16((bf16x8){jl0[0], jl0[1], jl0[2], jl0[3], jh0[0], jh0[1], jh0[2], jh0[3]}, pa2, o[4], 0, 0, 0); SBAR(); \
        TRRD(jl0, vb, 25088); TRRD(jh0, vb, 29184); LGKM_WAIT(8); SBAR(); o[5] = __builtin_amdgcn_mfma_f32_32x32x16_bf16((bf16x8){jl1[0], jl1[1], jl1[2], jl1[3], jh1[0], jh1[1], jh1[2], jh1[3]}, pa2, o[5], 0, 0, 0); SBAR(); \
        TRRD(jl1, vb, 25600); TRRD(jh1, vb, 29696); LGKM_WAIT(8); SBAR(); o[6] = __builtin_amdgcn_mfma_f32_32x32x16_bf16((bf16x8){jl2[0], jl2[1], jl2[2], jl2[3], jh2[0], jh2[1], jh2[2], jh2[3]}, pa2, o[6], 0, 0, 0); SBAR(); \
        TRRD(jl2, vb, 26112); TRRD(jh2, vb, 30208); LGKM_WAIT(8); SBAR(); o[7] = __builtin_amdgcn_mfma_f32_32x32x16_bf16((bf16x8){jl3[0], jl3[1], jl3[2], jl3[3], jh3[0], jh3[1], jh3[2], jh3[3]}, pa2, o[7], 0, 0, 0); SBAR(); \
        TRRD(jl3, vb, 26624); TRRD(jh3, vb, 30720); LGKM_WAIT(8); SBAR(); o[0] = __builtin_amdgcn_mfma_f32_32x32x16_bf16((bf16x8){jl4[0], jl4[1], jl4[2], jl4[3], jh4[0], jh4[1], jh4[2], jh4[3]}, pa3, o[0], 0, 0, 0); SBAR(); \
        TRRD(jl4, vb, 27136); TRRD(jh4, vb, 31232); LGKM_WAIT(8); SBAR(); o[1] = __builtin_amdgcn_mfma_f32_32x32x16_bf16((bf16x8){jl0[0], jl0[1], jl0[2], jl0[3], jh0[0], jh0[1], jh0[2], jh0[3]}, pa3, o[1], 0, 0, 0); SBAR(); \
        TRRD(jl0, vb, 27648); TRRD(jh0, vb, 31744); LGKM_WAIT(8); SBAR(); o[2] = __builtin_amdgcn_mfma_f32_32x32x16_bf16((bf16x8){jl1[0], jl1[1], jl1[2], jl1[3], jh1[0], jh1[1], jh1[2], jh1[3]}, pa3, o[2], 0, 0, 0); SBAR(); \
        TRRD(jl1, vb, 28160); TRRD(jh1, vb, 32256); LGKM_WAIT(8); SBAR(); o[3] = __builtin_amdgcn_mfma_f32_32x32x16_bf16((bf16x8){jl2[0], jl2[1], jl2[2], jl2[3], jh2[0], jh2[1], jh2[2], jh2[3]}, pa3, o[3], 0, 0, 0); SBAR(); \
        LGKM_WAIT(6); SBAR(); o[4] = __builtin_amdgcn_mfma_f32_32x32x16_bf16((bf16x8){jl3[0], jl3[1], jl3[2], jl3[3], jh3[0], jh3[1], jh3[2], jh3[3]}, pa3, o[4], 0, 0, 0); SBAR(); \
        LGKM_WAIT(4); SBAR(); o[5] = __builtin_amdgcn_mfma_f32_32x32x16_bf16((bf16x8){jl4[0], jl4[1], jl4[2], jl4[3], jh4[0], jh4[1], jh4[2], jh4[3]}, pa3, o[5], 0, 0, 0); SBAR(); \
        LGKM_WAIT(2); SBAR(); o[6] = __builtin_amdgcn_mfma_f32_32x32x16_bf16((bf16x8){jl0[0], jl0[1], jl0[2], jl0[3], jh0[0], jh0[1], jh0[2], jh0[3]}, pa3, o[6], 0, 0, 0); SBAR(); \
        LGKM_WAIT(0); SBAR(); o[7] = __builtin_amdgcn_mfma_f32_32x32x16_bf16((bf16x8){jl1[0], jl1[1], jl1[2], jl1[3], jh1[0], jh1[1], jh1[2], jh1[3]}, pa3, o[7], 0, 0, 0); SBAR(); \
    } while (0)
DI void store_pair16(bf16_t* p, float a0, float a1, float a2, float a3, float b0, float b1, float b2, float b3) {
    unsigned gx = cvt_pk_bf16_a(a0, a1), gy = cvt_pk_bf16_a(a2, a3), hx = cvt_pk_bf16_a(b0, b1), hy = cvt_pk_bf16_a(b2, b3);
    asm volatile("s_nop 1" : "+v"(gx), "+v"(gy), "+v"(hx), "+v"(hy));
    auto rx = __builtin_amdgcn_permlane32_swap(gx, hx, false, false); auto ry = __builtin_amdgcn_permlane32_swap(gy, hy, false, false);
    u32x4 w = {rx[0], ry[0], rx[1], ry[1]};
    *(u32x4*)p = w;
}
struct CoopArgs {
    const bf16_t* q;
    const bf16_t* k0; const bf16_t* k1; const bf16_t* v;
    int rsq, rsk, nt;
};
DI void stage_k(LAS char* st, const CoopArgs& a, int kb0, int wid, int lane) {
    const int l16 = lane & 15, lr = lane >> 4;
#pragma unroll
    for (int i = 0; i < 2; ++i) { const int piece = 2 * wid + i, row = piece * 4 + lr, ch = l16 ^ (row & 7);
        const size_t go = (size_t)(kb0 + row) * a.rsk + ch * 8;
        __builtin_amdgcn_global_load_lds((const unsigned*)(a.k0 + go), (LAS unsigned*)(st + piece * 1024), 16, 0, 0);
        __builtin_amdgcn_global_load_lds((const unsigned*)(a.k1 + go), (LAS unsigned*)(st + SHM_K + piece * 1024), 16, 0, 0); }
}
DI void stage_v(LAS char* st, const CoopArgs& a, int kb0, int wid, int lane) {
    const int sub = lane >> 5, kr = (lane & 31) >> 2, ch4 = lane & 3; const int key = swap23(8 * wid + kr);
    const bf16_t* vp = a.v + (size_t)(kb0 + key) * a.rsk + sub * 32 + ch4 * 8;
#pragma unroll
    for (int j = 0; j < 4; ++j)
        __builtin_amdgcn_global_load_lds((const unsigned*)(vp + j * 64), (LAS unsigned*)(st + 2 * SHM_K + wid * 4096 + j * 1024), 16, 0, 0);
}
}
namespace att {
struct DiffOut { bf16_t* ob; const float* subln; float lam; };
template <int MODE>
DI void coop_unit(LAS char* lds, const CoopArgs& a, int qpos0  , const float C2, const float SCALE,
                  bf16_t* orow  , int ors, const DiffOut& dout) {
    const int tid = threadIdx.x, wid = __builtin_amdgcn_readfirstlane(tid >> 6), lane = tid & 63, r32 = lane & 31, hi = lane >> 5;
    const int c = wid >> 2, wq = wid & 3;
    constexpr int NQ = MODE == 0 ? 8 : 16, NO = MODE == 0 ? 8 : 4;
    bf16x8 qr[NQ];
    { const bf16_t* qp = a.q + (MODE == 0 ? c * 128 : 0) + (size_t)(wq * 32 + r32) * a.rsq + hi * 8;
#pragma unroll
      for (int d0 = 0; d0 < NQ; ++d0) qr[d0] = *(const bf16x8*)(qp + d0 * 16); }
    f32x16 o[NO];
#pragma unroll
    for (int d = 0; d < NO; ++d)
#pragma unroll
        for (int r = 0; r < 16; ++r) o[d][r] = 0.f;
    float m_reg = -1e30f, l_reg = 0.f;
    const int NT = a.nt;
    const int qlo = qpos0 + wq * 32;
    stage_k(lds, a, 0, wid, lane); stage_v(lds, a, 0, wid, lane);
    for (int t = 0; t < NT; ++t) {
        VM_WAIT(); __syncthreads();
        LAS char* st = lds + (t & 1) * STG;
        if (t + 1 < NT) { stage_k(lds + ((t + 1) & 1) * STG, a, (t + 1) * 64, wid, lane); stage_v(lds + ((t + 1) & 1) * STG, a, (t + 1) * 64, wid, lane); }
        const int kb0 = t * 64;
        if (MODE == 1 || kb0 <= qlo + 31) {
            f32x16 p0, p1;
#pragma unroll
            for (int r = 0; r < 16; ++r) { p0[r] = 0.f; p1[r] = 0.f; }
            if (MODE == 0) qkt(p0, p1, st + c * SHM_K, r32, hi, qr);
            else { qkt(p0, p1, st, r32, hi, qr); qkt(p0, p1, st + SHM_K, r32, hi, qr + 8); }
            if (MODE == 0 && kb0 + 63 > qlo) mask_causal(p0, p1, qlo + r32 - kb0 - 4 * hi);
            float alpha;
            partialSM<2>(p0, p1, m_reg, alpha, C2, SCALE);
            if (__any(alpha < 1.f)) {
#pragma unroll
                for (int d = 0; d < NO; ++d)
#pragma unroll
                    for (int r = 0; r < 16; ++r) o[d][r] *= alpha; }
            bf16x8 pa0, pa1, pa2, pa3;
            finishSM<2>(p0, p1, alpha, l_reg, pa0, pa1, pa2, pa3);
            const int vb = (int)(uintptr_t)(st + 2 * SHM_K) + v_rd_base(lane) + (MODE == 1 ? c * 4 * 512 : 0);
            if constexpr (MODE == 0) { PV_JOUTER_64_DIFF(o, vb); }
            else { PV_DECL();
                TR8_64(fA, vb, 0 * 512, 8);
                PV_STEP(o[0], fA, fB, vb, 1 * 512, 8); PV_STEP(o[1], fB, fA, vb, 2 * 512, 8); PV_STEP(o[2], fA, fB, vb, 3 * 512, 8); PV_LAST(o[3], fB); }
        }
    }
    const float il = __builtin_amdgcn_rcpf(l_reg);
    if constexpr (MODE == 1) {
        bf16_t* op = orow + (size_t)(wq * 32 + r32) * ors + c * 128 + 8 * hi;
#pragma unroll
        for (int d = 0; d < 4; ++d)
#pragma unroll
            for (int g = 0; g < 4; g += 2)
                store_pair16(op + d * 32 + 8 * g, o[d][4 * g] * il, o[d][4 * g + 1] * il, o[d][4 * g + 2] * il, o[d][4 * g + 3] * il,
                             o[d][4 * g + 4] * il, o[d][4 * g + 5] * il, o[d][4 * g + 6] * il, o[d][4 * g + 7] * il);
        __syncthreads();
    } else {
        __syncthreads();
        LAS float* X = (LAS float*)lds + wq * 8192 + lane;
        if (c == 1) { const float sc = il * dout.lam;
#pragma unroll
            for (int d = 0; d < 8; ++d)
#pragma unroll
                for (int r = 0; r < 16; ++r) X[(d * 16 + r) * 64] = o[d][r] * sc; }
        __syncthreads();
        if (c == 0) {
            float ss = 0.f;
#pragma unroll
            for (int d = 0; d < 8; ++d)
#pragma unroll
                for (int r = 0; r < 16; ++r) { const float v = o[d][r] * il - X[(d * 16 + r) * 64]; o[d][r] = v; ss += v * v; }
            { auto rr = __builtin_amdgcn_permlane32_swap(__float_as_uint(ss), __float_as_uint(ss), false, false); ss = __uint_as_float(rr[0]) + __uint_as_float(rr[1]); }
            const float rs = __builtin_amdgcn_rsqf(ss * (1.f / 256.f) + EPS) * (1.f - LAM_INIT);
            bf16_t* op = orow + (size_t)(wq * 32 + r32) * ors + 8 * hi;
#pragma unroll
            for (int d = 0; d < 8; ++d)
#pragma unroll
                for (int g = 0; g < 4; g += 2) { const f32x4 ga = *(const f32x4*)(dout.subln + d * 32 + 8 * g + 4 * hi), gb = *(const f32x4*)(dout.subln + d * 32 + 8 * g + 8 + 4 * hi);
                    store_pair16(op + d * 32 + 8 * g, o[d][4 * g] * rs * ga[0], o[d][4 * g + 1] * rs * ga[1], o[d][4 * g + 2] * rs * ga[2], o[d][4 * g + 3] * rs * ga[3],
                                 o[d][4 * g + 4] * rs * gb[0], o[d][4 * g + 5] * rs * gb[1], o[d][4 * g + 6] * rs * gb[2], o[d][4 * g + 7] * rs * gb[3]); }
        }
        __syncthreads();
    }
}

DI void dil_wave_unit(LAS char* wl  , const bf16_t* proj, bf16_t* ob, int wu, int lane) {
    const int r32 = lane & 31, hi = lane >> 5;
    const int bh = wu >> 8, j = wu & 255, b = bh >> 3, h = bh & 7;
    const int tq0 = (j >> 3) * 256 + ((j >> 2) & 1) * 128 + (j & 3);
    const int tq = tq0 + 4 * r32;
    const size_t rowb = (size_t)b * SEQ;
    constexpr float SCALE = 0.08838834764831845f, C2 = 1.4426950408889634f * SCALE;
    bf16x8 qr[8];
    { const bf16_t* qp = proj + (rowb + tq) * INC + C_LQ + h * 128 + hi * 8;
#pragma unroll
      for (int d0 = 0; d0 < 8; ++d0) qr[d0] = *(const bf16x8*)(qp + d0 * 16); }
    f32x16 o[4];
#pragma unroll
    for (int d = 0; d < 4; ++d)
#pragma unroll
        for (int r = 0; r < 16; ++r) o[d][r] = 0.f;
    float m_reg = -1e30f, l_reg = 0.f;
    const bf16_t* kcol = proj + C_LK + h * 128 + hi * 8;
    const bf16_t* vcol = proj + C_LV + h * 128 + (lane >> 5) * 32 + (lane & 3) * 8;
    const int kr = (lane & 31) >> 2;
    for (int tau = 0; tau < 30; ++tau) {
        int ks, dmask, W, kbase;
        if (tau < 5) { ks = 4; dmask = 3; W = 512; kbase = tq0 - 512 + 128 * tau; }
        else if (tau < 22) { ks = 4; dmask = 15; W = 2048; kbase = tq0 - 2048 + 128 * (tau - 5); }
        else { ks = 1; dmask = 0; W = 128; kbase = tq0 - 128 + 32 * (tau - 22); }
        if (kbase + 31 * ks < 0) continue;
        int kp = kbase + ks * r32; kp = kp < 0 ? 0 : (kp > SEQ - 1 ? SEQ - 1 : kp);
        const bf16_t* krow = kcol + (rowb + kp) * INC;
        bf16x8 kf[8];
#pragma unroll
        for (int d0 = 0; d0 < 8; ++d0) kf[d0] = *(const bf16x8*)(krow + d0 * 16);
#pragma unroll
        for (int kg = 0; kg < 4; ++kg) { int vp = kbase + ks * swap23(8 * kg + kr); vp = vp < 0 ? 0 : (vp > SEQ - 1 ? SEQ - 1 : vp);
            const bf16_t* vr = vcol + (rowb + vp) * INC;
            __builtin_amdgcn_global_load_lds((const unsigned*)vr, (LAS unsigned*)(wl + (2 * kg) * 1024), 16, 0, 0);
            __builtin_amdgcn_global_load_lds((const unsigned*)(vr + 64), (LAS unsigned*)(wl + (2 * kg + 1) * 1024), 16, 0, 0); }
        VM_WAIT();
        f32x16 p0, p1;
#pragma unroll
        for (int r = 0; r < 16; ++r) p0[r] = 0.f;
#pragma unroll
        for (int d0 = 0; d0 < 8; ++d0) p0 = __builtin_amdgcn_mfma_f32_32x32x16_bf16(kf[d0], qr[d0], p0, 0, 0, 0);
        { const float NEG = -__builtin_inff(); const int lim = W < tq ? W : tq;
          const int d0v = tq - kbase - ks * 4 * hi;
#pragma unroll
          for (int r = 0; r < 16; ++r) { const int delta = d0v - ks * ((r & 3) + 8 * (r >> 2));
              if ((unsigned)delta > (unsigned)lim || (delta & dmask) != 0) p0[r] = NEG; } }
        float alpha;
        partialSM<1>(p0, p1, m_reg, alpha, C2, SCALE);
        if (__any(alpha < 1.f)) {
#pragma unroll
            for (int d = 0; d < 4; ++d)
#pragma unroll
                for (int r = 0; r < 16; ++r) o[d][r] *= alpha; }
        bf16x8 pa0, pa1, pa2, pa3;
        finishSM<1>(p0, p1, alpha, l_reg, pa0, pa1, pa2, pa3);
        const int vb = (int)(uintptr_t)wl + v_rd_base(lane);
        PV_D0_32(o[0], vb, 0 * 512, 4); PV_D0_32(o[1], vb, 1 * 512, 4); PV_D0_32(o[2], vb, 2 * 512, 4); PV_D0_32(o[3], vb, 3 * 512, 4);
    }
    const float il = __builtin_amdgcn_rcpf(l_reg);
    bf16_t* op = ob + (rowb + tq) * 4096 + 2048 + h * 128 + 8 * hi;
#pragma unroll
    for (int d = 0; d < 4; ++d)
#pragma unroll
        for (int g = 0; g < 4; g += 2)
            store_pair16(op + d * 32 + 8 * g, o[d][4 * g] * il, o[d][4 * g + 1] * il, o[d][4 * g + 2] * il, o[d][4 * g + 3] * il,
                         o[d][4 * g + 4] * il, o[d][4 * g + 5] * il, o[d][4 * g + 6] * il, o[d][4 * g + 7] * il);
}
}
constexpr size_t MiB = 1u << 20;
constexpr size_t WS_CTL = 0, CTL_ZERO_BYTES = 1 * MiB;
constexpr size_t WS_SCAL = 1 * MiB, WS_SLOTA = 116 * MiB, WS_SLOTW = 118 * MiB, WS_CS = 8 * MiB, WS_WR2 = 10 * MiB;
constexpr size_t WS_WIN = 16 * MiB, WS_WMKV = 80 * MiB, WS_WBR = 88 * MiB, WS_WOUT = 104 * MiB, WS_MN = 112 * MiB, WS_KVM = 114 * MiB;
constexpr size_t WS_XN = 128 * MiB, WS_OB = 192 * MiB, WS_MERGED = 320 * MiB, WS_PROJ = 384 * MiB, WS_WGU = 896 * MiB, WS_WD = 1152 * MiB;
constexpr size_t WS_YBUF = 1280 * MiB, WS_XG = 1536 * MiB, WS_ACT = 2560 * MiB, WS_XN8 = 3584 * MiB  , WS_WING8 = 3616 * MiB  , WS_X1B = 3648 * MiB  , WS_END = 3712 * MiB;
constexpr int CW_QDIFF = 8192, CW_QDIL = 8192 + 512, CW_QMEM = 8192 + 1024  , CW_CNT = 256  , CW_BAR = 4096, CW_JUNK = 3700, CW_KVM = 12288  , CW_QCONV = 12352  ;

#define XB_TMO      128
#define XB_XCNT(j)  (256  + 64 * (j))
#define XB_XSUB(j)  (1280 + 64 * (j))
#define XB_XGEN(j)  (2304 + 64 * (j))
#define XB_TOP      3328
#define XB_TOPGEN   3392
#define XCD_BAR_WORDS 3456
#define XB_SPIN_CAP (1u << 23)
DI unsigned xb_ld(unsigned* p)              { return __hip_atomic_load(p, __ATOMIC_RELAXED, __HIP_MEMORY_SCOPE_AGENT); }
DI unsigned xb_add(unsigned* p, unsigned v) { return __hip_atomic_fetch_add(p, v, __ATOMIC_RELAXED, __HIP_MEMORY_SCOPE_AGENT); }
DI unsigned xb_xcc_id() { return (unsigned)__builtin_amdgcn_s_getreg((3 << 11) | 20) & 0xFu; }
#define XB_SPIN(cond, bar) do { unsigned _sp = 0; while (cond) { __builtin_amdgcn_s_sleep(1); \
    if ((++_sp & 255u) == 0u) { if (xb_ld(&(bar)[XB_TMO])) break; if (_sp > XB_SPIN_CAP) { atomicAdd(&(bar)[XB_TMO], 1u); break; } } } } while (0)
struct XcdBarrier { unsigned* bar; unsigned x; volatile LAS unsigned* st; };
DI XcdBarrier xcd_barrier_post(unsigned* bar, volatile LAS unsigned* st) {
    XcdBarrier b; b.bar = bar; b.x = xb_xcc_id(); b.st = st;
    if (threadIdx.x == 0) (void)xb_add(&bar[XB_XCNT(b.x)], 1u);
    return b;
}
DI void xcd_barrier_complete(unsigned* bar, unsigned x, unsigned& nloc, unsigned& nx) {
    const unsigned G = gridDim.x * gridDim.y * gridDim.z;
    unsigned sum, cnt, mine, sp = 0u;
    for (;;) {
        sum = 0u; cnt = 0u; mine = 0u;
#pragma unroll
        for (unsigned j = 0; j < 16; ++j) { const unsigned c = xb_ld(&bar[XB_XCNT(j)]); sum += c; cnt += (c > 0u) ? 1u : 0u; mine = (j == x) ? c : mine; }
        if (sum == G) break;
        __builtin_amdgcn_s_sleep(1);
        if ((++sp & 255u) == 0u) { if (xb_ld(&bar[XB_TMO])) break; if (sp > XB_SPIN_CAP) { atomicAdd(&bar[XB_TMO], 1u); break; } }
    }
    nloc = mine > 0u ? mine : 1u; nx = cnt > 0u ? cnt : 1u;
}
DI void xcd_barrier(const XcdBarrier& b) {
    asm volatile("s_waitcnt vmcnt(0)" ::: "memory");
    __syncthreads();
    if (threadIdx.x == 0) {
        unsigned* bar = b.bar;
        __builtin_amdgcn_s_waitcnt(0);
        unsigned nloc = b.st[0], nx = b.st[1];
        if (nloc == 0u) { xcd_barrier_complete(bar, b.x, nloc, nx); b.st[0] = nloc; b.st[1] = nx; }
        const unsigned old = xb_add(&bar[XB_XSUB(b.x)], 1u);
        const unsigned gen = old / nloc;
        if (old + 1u == (gen + 1u) * nloc) {
            __builtin_amdgcn_fence(__ATOMIC_RELEASE, "agent");
            asm volatile("s_waitcnt vmcnt(0)" ::: "memory");
            const unsigned og = xb_add(&bar[XB_TOP], 1u);
            const unsigned tg = og / nx;
            if (og + 1u == (tg + 1u) * nx) xb_add(&bar[XB_TOPGEN], 1u);
            else XB_SPIN(xb_ld(&bar[XB_TOPGEN]) == tg, bar);
            __builtin_amdgcn_fence(__ATOMIC_ACQUIRE, "agent");
            xb_add(&bar[XB_XGEN(b.x)], 1u);
            asm volatile("s_waitcnt vmcnt(0)" ::: "memory");
        } else {
            XB_SPIN(xb_ld(&bar[XB_XGEN(b.x)]) == gen, bar);
            __builtin_amdgcn_fence(__ATOMIC_ACQUIRE, "agent");
            asm volatile("s_waitcnt vmcnt(0)" ::: "memory");
        }
    }
    __syncthreads();
}

__device__ const double ROPE_REV[16] = {0.15915494309189535, 0.0700865215877985, 0.03086376340470123, 0.013591370636193905, 0.005985185712713705, 0.002635675898667414, 0.001160663641240061, 0.0005111175045375439, 0.00022507907903927653, 9.911730936901935e-05, 4.364795279280289e-05, 1.9221100684944863e-05, 8.464330808241401e-06, 3.727408601915352e-06, 1.6414262627950345e-06, 7.228293068832865e-07};

DI void t16_load(f32x4 (&v)[16], const float* src, int ldw) {
#pragma unroll
    for (int j = 0; j < 16; ++j) v[j] = __builtin_nontemporal_load((const f32x4*)(src + (size_t)(8 * (j >> 1) + (j & 1)) * ldw));
}
DI void t16_store(const f32x4 (&v)[16], bf16_t* dst, int ldt, LAS unsigned* scr, int lane) {
    const int l15 = lane & 15, l4 = lane >> 4;
#pragma unroll
    for (int jj = 0; jj < 8; ++jj) { const int kp = 4 * jj + l4;
#pragma unroll
        for (int i = 0; i < 4; ++i) scr[(4 * l15 + i) * 33 + kp] = cvt_pk_bf16(v[2 * jj][i], v[2 * jj + 1][i]); }
    LDS_WAIT(); asm volatile("" ::: "memory");
    const int ch = lane & 7, nr = lane >> 3;
#pragma unroll
    for (int i = 0; i < 8; ++i) { const int n = 8 * i + nr; const LAS unsigned* s = scr + n * 33 + 4 * ch; u32x4 w; w.x = s[0]; w.y = s[1]; w.z = s[2]; w.w = s[3];
        *(u32x4*)(dst + (size_t)n * ldt + 8 * ch) = w; }
    LDS_WAIT(); asm volatile("" ::: "memory");
}
DI void f8_decode(int r, const float* wgu, const float* wd, const float* wing, unsigned char* WguT, unsigned char* WdT, unsigned char* WinG8, int lane, const float*& src, unsigned char*& dst, int& ldw) {
    const int l7 = lane & 7, l8 = lane >> 3;
    if (r >= 98304) { r -= 98304; const int k0 = (r / 288) * 128, g = r % 288; ldw = INC;
        const int n0 = g < 64 ? C_DV + 32 * g : (g < 96 ? C_LV + 32 * (g - 64) : C_G + 32 * (g - 96));
        src = wing + (size_t)(k0 + 4 * l8) * INC + n0 + 4 * l7; dst = WinG8 + (size_t)n0 * 2048 + k0; }
    else if (r < 65536) { const int e = r >> 11, q = r & 2047, k0 = (q >> 7) * 128, n0 = (q & 127) * 32; ldw = 4096;
        src = wgu + (size_t)e * 2048 * 4096 + (size_t)(k0 + 4 * l8) * 4096 + n0 + 4 * l7; dst = WguT + (size_t)e * 4096 * 2048 + (size_t)n0 * 2048 + k0; }
    else { r -= 65536; const int e = r >> 10, q = r & 1023, k0 = (q >> 6) * 128, n0 = (q & 63) * 32; ldw = 2048;
        src = wd + (size_t)e * 2048 * 2048 + (size_t)(k0 + 4 * l8) * 2048 + n0 + 4 * l7; dst = WdT + (size_t)e * 2048 * 2048 + (size_t)n0 * 2048 + k0; }
}
DI void f8_load(f32x4 (&v)[16], const float* src, int ldw) {
#pragma unroll
    for (int j = 0; j < 16; ++j) v[j] = __builtin_nontemporal_load((const f32x4*)(src + (size_t)(32 * (j >> 2) + (j & 3)) * ldw));
}
DI void f8_store(const f32x4 (&v)[16], unsigned char* dst, LAS unsigned* scr, int lane) {
    const int l7 = lane & 7, l8 = lane >> 3; constexpr float SC = (float)(1 << pg8::WSH);
#pragma unroll
    for (int jj = 0; jj < 4; ++jj) { const int kq = 8 * jj + l8;
#pragma unroll
        for (int i = 0; i < 4; ++i) scr[(4 * l7 + i) * 33 + kq] = pack4_fp8(v[4 * jj][i] * SC, v[4 * jj + 1][i] * SC, v[4 * jj + 2][i] * SC, v[4 * jj + 3][i] * SC); }
    LDS_WAIT(); asm volatile("" ::: "memory");
    const int ch = lane & 7, nr = lane >> 3;
#pragma unroll
    for (int i = 0; i < 4; ++i) { const int n = 8 * i + nr; const LAS unsigned* s = scr + n * 33 + 4 * ch; u32x4 w; w.x = s[0]; w.y = s[1]; w.z = s[2]; w.w = s[3];
        __builtin_nontemporal_store(w, (u32x4*)(dst + (size_t)n * 2048 + 16 * ch)); }
    LDS_WAIT(); asm volatile("" ::: "memory");
}
template <int NR, bool F8 = false>
DI void rms_rows_to_bf16(const float* xrow, size_t rs, const float* gain, bf16_t* orow, size_t os, int lane, unsigned char* orow8 = nullptr) {
    const f32x4* gr = (const f32x4*)gain + lane;
    f32x4 v[NR][8];
#pragma unroll
    for (int q = 0; q < NR; ++q) { const f32x4* xr = (const f32x4*)(xrow + q * rs) + lane;
#pragma unroll
        for (int j = 0; j < 8; ++j) v[q][j] = __builtin_nontemporal_load(xr + 64 * j); }
#pragma unroll
    for (int q = 0; q < NR; ++q) { float s = 0.f;
#pragma unroll
        for (int j = 0; j < 8; ++j) s += (v[q][j][0] * v[q][j][0] + v[q][j][1] * v[q][j][1]) + (v[q][j][2] * v[q][j][2] + v[q][j][3] * v[q][j][3]);
        const float rstd = __builtin_amdgcn_rsqf(wave_sum(s) * (1.f / 2048.f) + EPS);
        u32x2* o8 = (u32x2*)(orow + q * os) + lane;
#pragma unroll
        for (int j = 0; j < 8; ++j) { const f32x4 g = gr[64 * j]; const float a = v[q][j][0] * rstd * g[0], b = v[q][j][1] * rstd * g[1], c = v[q][j][2] * rstd * g[2], d = v[q][j][3] * rstd * g[3];
            u32x2 w; w.x = cvt_pk_bf16(a, b); w.y = cvt_pk_bf16(c, d); o8[64 * j] = w;
            if (F8) ((unsigned*)(orow8 + q * os) + lane)[64 * j] = pack4_fp8(a, b, c, d); } }
}
enum { I_X = 0, I_MEM, I_POS, I_GMIX, I_WIN, I_BGATE, I_DQN, I_DKN, I_DLAM, I_SUBLN, I_LQN, I_LKN, I_GMEM, I_WMKV, I_MQN, I_MKN, I_WBD, I_WBL, I_WBM, I_WOUT, I_GFFN, I_WR, I_BR, I_WGU, I_BGU, I_WD, I_BD, N_IN };
constexpr int N_PHASES = 9;
struct Args { const void* in[N_IN]; float* out; unsigned char* ws; int ph_lo, ph_hi; int use_bar, pad; };

DI int moe_tables(const unsigned* ctl, LAS int* tab  , int tid) {
    if (tid < 64) { const int e = tid & 31; const unsigned c = __hip_atomic_load(ctl + CW_CNT + 64 * e, __ATOMIC_RELAXED, __HIP_MEMORY_SCOPE_AGENT); int n = (int)((c + 255u) >> 8), s = n;
#pragma unroll
        for (int o = 1; o < 32; o <<= 1) { const int t = __shfl_up(s, o, 32); if ((tid & 31) >= o) s += t; }
        if (tid < 32) { tab[300 + tid + 1] = s; tab[340 + tid] = (int)c; if (tid == 0) tab[300] = 0; } }
    __syncthreads();
    const int nrb = tab[332];
    for (int rb = tid; rb < nrb; rb += NTHR) { int e = 0;
#pragma unroll 1
        for (int k = 1; k < 32; ++k) if (rb >= tab[300 + k]) e = k;
        tab[rb] = e; }
    __syncthreads();
    return nrb;
}

__global__ void __launch_bounds__(NTHR, 2) fwd(Args args) {
    extern __shared__ __attribute__((aligned(16))) unsigned char lds_raw[];
    LAS unsigned char* lds = (LAS unsigned char*)lds_raw;
    volatile LAS unsigned* MISC = (volatile LAS unsigned*)(lds + MISC_OFF);
    const int G = gridDim.x, bx = blockIdx.x, NGW = G * NWAVES;
#define LANE_CONSTS() int tid_ = threadIdx.x; asm volatile("" : "+v"(tid_)); const int tid = tid_, lane = tid & 63, wave = __builtin_amdgcn_readfirstlane(tid >> 6), gw = bx * NWAVES + wave; (void)lane; (void)gw
    unsigned char* ws = args.ws;
    unsigned* ctl = (unsigned*)(ws + WS_CTL);
    if (threadIdx.x < 32) MISC[threadIdx.x] = 0u;
    __syncthreads();
    XcdBarrier bar; bar.bar = ctl + CW_BAR; bar.x = 0; bar.st = nullptr;
    if (args.use_bar) bar = xcd_barrier_post(ctl + CW_BAR, MISC + 8);
    const int lo = args.ph_lo, hi = args.ph_hi;
#ifndef PHASE_MASK
#define PHASE_MASK 0x1ff
#endif
#define IN(k) (((PHASE_MASK >> (k)) & 1) && lo <= (k) && (k) < hi)
#define SEAM(k) do { if (IN(k) && IN((k) + 1)) xcd_barrier(bar); } while (0)

    const float* x = (const float*)args.in[I_X];
    bf16_t* WinT = (bf16_t*)(ws + WS_WIN); bf16_t* WmkvT = (bf16_t*)(ws + WS_WMKV); bf16_t* WbrT = (bf16_t*)(ws + WS_WBR); bf16_t* WoutT = (bf16_t*)(ws + WS_WOUT);
    unsigned char* WguT = ws + WS_WGU; unsigned char* WdT = ws + WS_WD;
    unsigned char* XN8 = ws + WS_XN8; unsigned char* WinG8 = ws + WS_WING8;
    bf16_t* XN = (bf16_t*)(ws + WS_XN); bf16_t* MN = (bf16_t*)(ws + WS_MN); bf16_t* KVM = (bf16_t*)(ws + WS_KVM); bf16_t* PROJ = (bf16_t*)(ws + WS_PROJ);
    bf16_t* OB = (bf16_t*)(ws + WS_OB); bf16_t* MERGED = (bf16_t*)(ws + WS_MERGED); unsigned char* XG = ws + WS_XG; unsigned char* ACT = ws + WS_ACT;
    bf16_t* YBUF = (bf16_t*)(ws + WS_YBUF);
    float* CS = (float*)(ws + WS_CS); float* WR2 = (float*)(ws + WS_WR2); float* SCAL = (float*)(ws + WS_SCAL);
    int* SLOTA = (int*)(ws + WS_SLOTA); float* SLOTW = (float*)(ws + WS_SLOTW);
    bf16_t* X1 = (bf16_t*)(ws + WS_X1B);

    if (IN(0)) { LANE_CONSTS();
        LAS unsigned* scr = (LAS unsigned*)(lds + RING_OFF + wave * 16384);
        constexpr int I_IN = 32 * 112  , I_MKV = 32 * 32, I_BD = 32 * 32, I_BL = 16 * 32, I_BM = 16 * 32, I_OUT = 32 * 32, I_GU = 32 * 32 * 64, I_DN = 32 * 32 * 32;
        constexpr int NITEMS = I_IN + I_MKV + I_BD + I_BL + I_BM + I_OUT;
        {
            auto dec = [&](int r, const float*& src, int& ldw, bf16_t*& dst, int& ldt) {
                const float* W; bf16_t* WT; int k0, n0, ko = 0;
                if (r < I_IN) { W = (const float*)args.in[I_WIN]; ldw = INC; WT = WinT; ldt = DM; k0 = (r / 112) * 64; const int j = r % 112; n0 = j < 64 ? 64 * j : (j < 96 ? C_LQ + 64 * (j - 64) : C_MQ + 64 * (j - 96)); }
                else { r -= I_IN; k0 = ((r & 1023) >> 5) * 64; n0 = (r & 31) * 64; ldw = 2048;
                    if (r < 1024) { W = (const float*)args.in[I_WMKV]; WT = WmkvT; ldt = DM; }
                    else if (r < 2048) { W = (const float*)args.in[I_WBD]; WT = WbrT; ldt = 4096; }
                    else if (r < 2560) { W = (const float*)args.in[I_WBL]; WT = WbrT; ldt = 4096; ko = 2048; }
                    else if (r < 3072) { W = (const float*)args.in[I_WBM]; WT = WbrT; ldt = 4096; ko = 3072; k0 = (((r - 2560) & 511) >> 5) * 64; }
                    else { W = (const float*)args.in[I_WOUT]; WT = WoutT; ldt = DM; } }
                src = W + (size_t)(k0 + 2 * (lane >> 4)) * ldw + n0 + 4 * (lane & 15); dst = WT + (size_t)n0 * ldt + ko + k0; };
            f32x4 va[16], vb[16]; const float* s; int ldw, lta = 0, ltb = 0; bf16_t* da = nullptr; bf16_t* db = nullptr;
            int r = gw;
            if (r < NITEMS) { dec(r, s, ldw, da, lta); t16_load(va, s, ldw); }
            if (r + NGW < NITEMS) { dec(r + NGW, s, ldw, db, ltb); t16_load(vb, s, ldw); }
            while (r < NITEMS) {
                t16_store(va, da, lta, scr, lane);
                if (r + 2 * NGW < NITEMS) { dec(r + 2 * NGW, s, ldw, da, lta); t16_load(va, s, ldw); }
                if (r + NGW >= NITEMS) break;
                t16_store(vb, db, ltb, scr, lane);
                if (r + 3 * NGW < NITEMS) { dec(r + 3 * NGW, s, ldw, db, ltb); t16_load(vb, s, ldw); }
                r += 2 * NGW;
            }
        }
        {
            const float* wgu = (const float*)args.in[I_WGU]; const float* wd = (const float*)args.in[I_WD];
            constexpr int F8_LO = I_GU + I_DN, NF8 = I_GU + I_DN + 16 * 288;
            const float* wing = (const float*)args.in[I_WIN];
            f32x4 va[16], vb[16]; const float* s; int ldw; unsigned char* da = nullptr; unsigned char* db = nullptr;
            int r = F8_LO + gw;
            if (r < NF8) { f8_decode(r, wgu, wd, wing, WguT, WdT, WinG8, lane, s, da, ldw); f8_load(va, s, ldw); }
            if (r + NGW < NF8) { f8_decode(r + NGW, wgu, wd, wing, WguT, WdT, WinG8, lane, s, db, ldw); f8_load(vb, s, ldw); }
            while (r < NF8) {
                f8_store(va, da, scr, lane);
                if (r + 2 * NGW < NF8) { f8_decode(r + 2 * NGW, wgu, wd, wing, WguT, WdT, WinG8, lane, s, da, ldw); f8_load(va, s, ldw); }
                if (r + NGW >= NF8) break;
                f8_store(vb, db, scr, lane);
                if (r + 3 * NGW < NF8) { f8_decode(r + 3 * NGW, wgu, wd, wing, WguT, WdT, WinG8, lane, s, db, ldw); f8_load(vb, s, ldw); }
                r += 2 * NGW;
            }
        }
        for (int m = gw; m < T; m += 2 * NGW) {
            if (m + NGW < T) rms_rows_to_bf16<2, true>(x + (size_t)m * DM, (size_t)NGW * DM, (const float*)args.in[I_GMIX], XN + (size_t)m * DM, (size_t)NGW * DM, lane, XN8 + (size_t)m * DM);
            else rms_rows_to_bf16<1, true>(x + (size_t)m * DM, 0, (const float*)args.in[I_GMIX], XN + (size_t)m * DM, 0, lane, XN8 + (size_t)m * DM); }
        for (int m = gw; m < TM; m += NGW) rms_rows_to_bf16<1>((const float*)args.in[I_MEM] + (size_t)m * DM, 0, (const float*)args.in[I_GMEM], MN + (size_t)m * DM, 0, lane);
        { const int* pos = (const int*)args.in[I_POS];
          for (int i = bx * NTHR + tid; i < T * 16; i += G * NTHR) { const int tok = i >> 4, f = i & 15; const double rev = (double)pos[tok] * ROPE_REV[f]; const float fr_ = (float)(rev - __builtin_floor(rev));
              CS[(size_t)tok * 32 + f] = __builtin_amdgcn_cosf(fr_); CS[(size_t)tok * 32 + 16 + f] = __builtin_amdgcn_sinf(fr_); } }
        for (int i = bx * NTHR + tid; i < PSLOTS; i += G * NTHR) SLOTA[i] = -1;
        { const float* wr = (const float*)args.in[I_WR]; const float* gf = (const float*)args.in[I_GFFN];
          bf16_t* WRH = (bf16_t*)WR2; bf16_t* WRL = WRH + 32 * 2048;
          for (int i = bx * NTHR + tid; i < 2048 * 32; i += G * NTHR) { const int k = i >> 5, e = i & 31; const float w = wr[i] * gf[k];
              const unsigned hi = cvt_pk_bf16(w, 0.f) & 0xffffu; const float rest = w - __uint_as_float(hi << 16);
              WRH[e * 2048 + k] = (bf16_t)hi; WRL[e * 2048 + k] = (bf16_t)(cvt_pk_bf16(rest, 0.f) & 0xffffu); } }
        if (bx == 1 && tid < 128) { SCAL[1024 + tid] = ((const float*)args.in[I_DQN])[tid]; SCAL[1024 + 128 + tid] = ((const float*)args.in[I_DKN])[tid];
            SCAL[1024 + 256 + tid] = ((const float*)args.in[I_LQN])[tid]; SCAL[1024 + 384 + tid] = ((const float*)args.in[I_LKN])[tid]; }
        if (bx == 0 && wave == 0) { const float* lp = (const float*)args.in[I_DLAM];
            const float s1 = wave_sum(lp[lane] * lp[128 + lane] + lp[64 + lane] * lp[192 + lane]), s2 = wave_sum(lp[256 + lane] * lp[384 + lane] + lp[320 + lane] * lp[448 + lane]);
            if (lane == 0) SCAL[0] = __expf(s1) - __expf(s2) + LAM_INIT; }
    }
    SEAM(0);

    if (IN(1)) {
        EpiProj<1> E1; E1.out = PROJ; E1.ldc = INC; E1.memkv = 0; E1.gt = SCAL + 1024;
        E1.gmq = (const float*)args.in[I_MQN]; E1.gmk = (const float*)args.in[I_MKN]; E1.bgate = (const float*)args.in[I_BGATE]; E1.cs = CS; E1.P = (LAS float*)(lds + EPIP_OFF);
        SchedGrid S; S.A = (const char*)XN; S.B = (const char*)WinT; S.nM = 64; S.nt = 32; S.G = G; S.c = bx; S.astep = (size_t)256 * DM * 2; S.bstep = (size_t)256 * DM * 2;
        S.nN = 24; S.pn_a = 16; S.pn_skip = 8; S.pn0 = 0;
        pg8::gemm_phase<EpiProj<1>, SchedGrid>(lds + RING_OFF, DM, DM, (size_t)128 * DM * 2, S, E1);
        EpiProj<0> E0; E0.out = PROJ; E0.ldc = INC; E0.memkv = 0; E0.gt = E1.gt; E0.gmq = E1.gmq; E0.gmk = E1.gmk; E0.bgate = E1.bgate; E0.cs = CS; E0.P = E1.P;
        S.nN = 12; S.pn_a = 8; S.pn_skip = 8; S.pn0 = 16;
        { SchedGrid S8 = S; S8.A = (const char*)XN8; S8.B = (const char*)WinG8; S8.nt = 16; S8.astep = (size_t)256 * DM; S8.bstep = (size_t)256 * DM;
          pg8::gemm_phase<EpiProj<0>, SchedGrid, true>(lds + RING_OFF, DM / 2, DM / 2, (size_t)128 * DM, S8, E0); }
        EpiProj<2> E2; E2.out = PROJ; E2.ldc = INC; E2.memkv = 0; E2.gt = E1.gt; E2.gmq = E1.gmq; E2.gmk = E1.gmk; E2.bgate = E1.bgate; E2.cs = CS; E2.P = E1.P;
        S.nN = 4; S.pn_a = 4; S.pn_skip = 0; S.pn0 = 36;
        pg8::gemm_phase<EpiProj<2>, SchedGrid>(lds + RING_OFF, DM, DM, (size_t)128 * DM * 2, S, E2);
        EpiProj<3> E3; E3.out = PROJ; E3.ldc = INC; E3.memkv = 0; E3.gt = E1.gt; E3.gmq = E1.gmq; E3.gmk = E1.gmk; E3.bgate = E1.bgate; E3.cs = CS; E3.P = E1.P;
        S.nN = 24; S.pn_a = 24; S.pn_skip = 0; S.pn0 = 40;
        { SchedGrid S8 = S; S8.A = (const char*)XN8; S8.B = (const char*)WinG8; S8.nt = 16; S8.astep = (size_t)256 * DM; S8.bstep = (size_t)256 * DM;
          pg8::gemm_phase<EpiProj<3>, SchedGrid, true>(lds + RING_OFF, DM / 2, DM / 2, (size_t)128 * DM, S8, E3); }
    }
    SEAM(1);

    if (IN(2)) { LANE_CONSTS(); constexpr int qo = 0;
        const float lam = SCAL[0];
        att::DiffOut dout; dout.ob = OB; dout.subln = (const float*)args.in[I_SUBLN]; dout.lam = lam;
        for (int mu = bx; mu < 16; mu += G) {
            SchedGrid S2; S2.A = (const char*)MN; S2.B = (const char*)WmkvT; S2.nM = 2; S2.nN = 4; S2.nt = 32; S2.G = 1 << 20; S2.c = mu & 7; S2.astep = (size_t)256 * DM * 2; S2.bstep = (size_t)256 * DM * 2;
            S2.pn_a = 4; S2.pn_skip = 0; S2.pn0 = mu < 8 ? 0 : 4;
            if (mu < 8) { EpiProj<2> E2; E2.out = KVM; E2.ldc = 2048; E2.memkv = 1; E2.gt = SCAL + 1024; E2.gmq = (const float*)args.in[I_MQN]; E2.gmk = (const float*)args.in[I_MKN]; E2.bgate = (const float*)args.in[I_BGATE];
                E2.cs = CS; E2.P = (LAS float*)(lds + EPIP_OFF);
                pg8::gemm_phase<EpiProj<2>, SchedGrid>(lds + RING_OFF, DM, DM, (size_t)128 * DM * 2, S2, E2); }
            else { EpiProj<0> E0; E0.out = KVM; E0.ldc = 2048; E0.memkv = 1; E0.gt = SCAL + 1024; E0.gmq = (const float*)args.in[I_MQN]; E0.gmk = (const float*)args.in[I_MKN]; E0.bgate = (const float*)args.in[I_BGATE];
                E0.cs = CS; E0.P = (LAS float*)(lds + EPIP_OFF);
                pg8::gemm_phase<EpiProj<0>, SchedGrid>(lds + RING_OFF, DM, DM, (size_t)128 * DM * 2, S2, E0); }
            if (threadIdx.x == 0) { __builtin_amdgcn_fence(__ATOMIC_RELEASE, "agent"); asm volatile("s_waitcnt vmcnt(0)" ::: "memory"); (void)xb_add(ctl + CW_KVM + qo, 1u); }
        }
        const int xcc = (int)(xb_xcc_id() & 7u);
        auto diff_units = [&]() __attribute__((always_inline)) {
            int t_ = threadIdx.x; asm volatile("" : "+v"(t_)); const int tid = t_, lane = t_ & 63, wave = __builtin_amdgcn_readfirstlane(t_ >> 6); (void)tid; (void)lane; (void)wave;
        for (;;) {
            if (tid == 0) { int u = -1;
                for (int kq = 0; kq < 8 && u < 0; ++kq) { const int q = (xcc + kq) & 7; const unsigned v = xb_add(ctl + CW_QDIFF + qo + 64 * q, 1u); if (v < 128u) u = q * 128 + (int)v; }
                MISC[16] = (unsigned)u; }
            __syncthreads(); const int u = (int)MISC[16]; __syncthreads();
            if (u < 0) break;
            const int q = u >> 7, v = u & 127, bh = 2 * q + (v & 1), qb = 63 - (v >> 1), b = bh >> 3, h = bh & 7, s0 = qb * 128;
            att::CoopArgs a; a.q = PROJ + ((size_t)b * SEQ + s0) * INC + C_DQ + h * 256; a.k0 = PROJ + (size_t)b * SEQ * INC + C_DK + h * 256; a.k1 = a.k0 + 128;
            a.v = PROJ + (size_t)b * SEQ * INC + C_DV + h * 256; a.rsq = INC; a.rsk = INC; a.nt = 2 * (qb + 1);
            att::coop_unit<0>((LAS char*)(lds + RING_OFF), a, s0, 1.4426950408889634f * 0.08838834764831845f, 0.08838834764831845f, OB + ((size_t)b * SEQ + s0) * 4096 + h * 256, 4096, dout);
        }
        };
        auto mem_units = [&](int maxn) __attribute__((always_inline)) {
            int t_ = threadIdx.x; asm volatile("" : "+v"(t_)); const int tid = t_, lane = t_ & 63, wave = __builtin_amdgcn_readfirstlane(t_ >> 6); (void)tid; (void)lane; (void)wave;
            if (tid == 0) { XB_SPIN(xb_ld(ctl + CW_KVM + qo) < 16u, ctl + CW_BAR); __builtin_amdgcn_fence(__ATOMIC_ACQUIRE, "agent"); asm volatile("s_waitcnt vmcnt(0)" ::: "memory"); }
            __syncthreads();
            for (int n = 0; n < maxn; ++n) {
                if (tid == 0) { int u = -1;
                    for (int kq = 0; kq < 8 && u < 0; ++kq) { const int q = (xcc + kq) & 7; const unsigned v = xb_add(ctl + CW_QMEM + qo + 64 * q, 1u); if (v < 64u) u = q * 64 + (int)v; }
                    MISC[16] = (unsigned)u; }
                __syncthreads(); const int u = (int)MISC[16]; __syncthreads();
                if (u < 0) break;
                const int q = u >> 6, b = q >> 2, hm = q & 3, qg = b * 64 + (u & 63);
                att::CoopArgs a; a.q = PROJ + (size_t)qg * 128 * INC + C_MQ + hm * 256; a.k0 = KVM + (size_t)b * MEML * 2048 + hm * 256; a.k1 = a.k0 + 128;
                a.v = KVM + (size_t)b * MEML * 2048 + 1024 + hm * 256; a.rsq = INC; a.rsk = 2048; a.nt = 4;
                att::coop_unit<1>((LAS char*)(lds + RING_OFF), a, 0, 1.4426950408889634f * 0.0625f, 0.0625f, OB + (size_t)qg * 128 * 4096 + 3072 + hm * 256, 4096, dout);
            }
        };
        auto stretch = [&]() __attribute__((always_inline)) {
            int t_ = threadIdx.x; asm volatile("" : "+v"(t_)); const int tid = t_, lane = t_ & 63, wave = __builtin_amdgcn_readfirstlane(t_ >> 6); (void)tid; (void)lane; (void)wave;
        {
            const float* wgu = (const float*)args.in[I_WGU]; const float* wd = (const float*)args.in[I_WD];
            LAS unsigned* scr = (LAS unsigned*)(lds + RING_OFF + wave * 16384);
            constexpr int CBN = 16, NBATCH = (32 * 32 * 64 + 32 * 32 * 32) / CBN;
            bool dil_left = true, conv_left = true;
            auto mix_round = [&]() __attribute__((always_inline)) {
                int t_ = threadIdx.x; asm volatile("" : "+v"(t_)); const int lane = t_ & 63; (void)lane;
                if (dil_left) { int wu = -1;
                    if (lane == 0) { for (int kq = 0; kq < 8 && wu < 0; ++kq) { const int q = (xcc + kq) & 7; const unsigned v = xb_add(ctl + CW_QDIL + qo + 64 * q, 1u); if (v < 512u) wu = (2 * q + (int)(v & 1u)) * 256 + (int)(v >> 1); } }
                    wu = __builtin_amdgcn_readfirstlane(wu);
                    if (wu < 0) dil_left = false; else att::dil_wave_unit((LAS char*)scr, PROJ, OB, wu, lane); }
                for (int rep = 0; rep < 2 && conv_left; ++rep) {
                    int cb = 0; if (lane == 0) cb = (int)xb_add(ctl + CW_QCONV + qo, 1u);
                    cb = __builtin_amdgcn_readfirstlane(cb);
                    if (cb >= NBATCH) { conv_left = false; break; }
                    f32x4 va[16], vb[16]; const float* s; int ldw; unsigned char* da = nullptr; unsigned char* db = nullptr;
                    int r = cb * CBN; const int rend = r + CBN;
                    f8_decode(r, wgu, wd, nullptr, WguT, WdT, nullptr, lane, s, da, ldw); f8_load(va, s, ldw);
                    f8_decode(r + 1, wgu, wd, nullptr, WguT, WdT, nullptr, lane, s, db, ldw); f8_load(vb, s, ldw);
                    while (r < rend) {
                        f8_store(va, da, scr, lane);
                        if (r + 2 < rend) { f8_decode(r + 2, wgu, wd, nullptr, WguT, WdT, nullptr, lane, s, da, ldw); f8_load(va, s, ldw); }
                        f8_store(vb, db, scr, lane);
                        if (r + 3 < rend) { f8_decode(r + 3, wgu, wd, nullptr, WguT, WdT, nullptr, lane, s, db, ldw); f8_load(vb, s, ldw); }
                        r += 2;
                    }
                }
            };
#pragma unroll 1
            for (int it = 0; it < 4; ++it) {
                mix_round();
                if (it == (bx & 3)) { __syncthreads(); mem_units(2); __syncthreads(); }
            }
            while (dil_left || conv_left) mix_round();
        }
        __syncthreads();
        mem_units(1 << 30);
        __syncthreads();
        };
        const bool stretch_first = ((bx >> 3) & 3) == 0;
        if (stretch_first) { stretch(); diff_units(); } else { diff_units(); stretch(); }
    }
    SEAM(2);

    if (IN(3)) {
        EpiBranch E; E.proj = PROJ; E.merged = MERGED;
        SchedBranch S; S.A = (const char*)OB; S.B = (const char*)WbrT; S.G = G; S.c = bx;
        pg8::gemm_phase<EpiBranch, SchedBranch>(lds + RING_OFF, 4096, 4096, (size_t)128 * 4096 * 2, S, E);
    }
    SEAM(3);

    if (IN(4)) {
        EpiOut E; E.x = x; E.x1 = X1;
        SchedGrid S; S.A = (const char*)MERGED; S.B = (const char*)WoutT; S.nM = 64; S.nN = 8; S.nt = 32; S.G = G; S.c = bx; S.astep = (size_t)256 * DM * 2; S.bstep = (size_t)256 * DM * 2; S.pn_a = 8; S.pn_skip = 0; S.pn0 = 0;
        pg8::gemm_phase<EpiOut, SchedGrid>(lds + RING_OFF, DM, DM, (size_t)128 * DM * 2, S, E);
    }
    SEAM(4);

    if (IN(5)) { LANE_CONSTS();
        LAS float* part = (LAS float*)(lds + RING_OFF);
        LAS float* ssp = part + 8 * 32 * 33;
        LAS float* rsd = ssp + 8 * 32;
        LAS unsigned* asl = (LAS unsigned*)(rsd + 32);
        const float* brt = (const float*)args.in[I_BR];
        for (int tt = bx; tt < T / 32; tt += G) {
            const int m = lane & 31, kh = lane >> 5; const size_t tok = (size_t)tt * 32 + m;
            const bf16_t* xr = X1 + tok * DM + wave * 256 + 8 * kh;
            const bf16_t* wh = (const bf16_t*)WR2 + (size_t)m * 2048 + wave * 256 + 8 * kh; const bf16_t* wl = wh + 32 * 2048;
            f32x16 acc;
#pragma unroll
            for (int r = 0; r < 16; ++r) acc[r] = 0.f;
            float ss = 0.f;
            bf16x8 xa[16];
#pragma unroll
            for (int c = 0; c < 16; ++c) xa[c] = *(const bf16x8*)(xr + 16 * c);
#pragma unroll
            for (int c = 0; c < 16; ++c) { const bf16x8 bh = *(const bf16x8*)(wh + 16 * c), bl = *(const bf16x8*)(wl + 16 * c);
#pragma unroll
                for (int q = 0; q < 8; ++q) { const float v = __uint_as_float((unsigned)(unsigned short)xa[c][q] << 16); ss = fmaf(v, v, ss); }
                acc = __builtin_amdgcn_mfma_f32_32x32x16_bf16(xa[c], bh, acc, 0, 0, 0); acc = __builtin_amdgcn_mfma_f32_32x32x16_bf16(xa[c], bl, acc, 0, 0, 0); }
            ss += __shfl_xor(ss, 32);
#pragma unroll
            for (int r = 0; r < 16; ++r) part[(wave * 32 + (r & 3) + 8 * (r >> 2) + 4 * kh) * 33 + m] = acc[r];
            if (lane < 32) ssp[wave * 32 + m] = ss;
            __syncthreads();
            if (lane < 4) {
                const int tl = wave * 4 + lane; const size_t tk = (size_t)tt * 32 + tl;
                float s2 = 0.f;
#pragma unroll
                for (int w8 = 0; w8 < 8; ++w8) s2 += ssp[w8 * 32 + tl];
                const float rstd = __builtin_amdgcn_rsqf(s2 * (1.f / 2048.f) + EPS);
                float lg[32];
#pragma unroll
                for (int e = 0; e < 32; ++e) { float a = 0.f;
#pragma unroll
                    for (int w8 = 0; w8 < 8; ++w8) a += part[(w8 * 32 + tl) * 33 + e];
                    lg[e] = a * rstd + brt[e]; }
                unsigned chosen = 0u; float tv[4]; int te[4];
#pragma unroll
                for (int kk = 0; kk < 4; ++kk) { float best = -__builtin_inff(); int bi = 0;
#pragma unroll
                    for (int e = 0; e < 32; ++e) { const float v = ((chosen >> e) & 1u) ? -__builtin_inff() : lg[e]; if (v > best) { best = v; bi = e; } }
                    chosen |= 1u << bi; tv[kk] = best; te[kk] = bi; }
                const float e1 = __expf(tv[1] - tv[0]), e2 = __expf(tv[2] - tv[0]), e3 = __expf(tv[3] - tv[0]); const float inv = 1.f / (1.f + e1 + e2 + e3);
                const float wv[4] = {inv, e1 * inv, e2 * inv, e3 * inv};
                rsd[tl] = rstd;
#pragma unroll
                for (int kk = 0; kk < 4; ++kk) { const unsigned pos = xb_add(ctl + CW_CNT + 64 * te[kk], 1u); const unsigned slot = (unsigned)te[kk] * ECAP + pos;
                    SLOTA[slot] = (int)(tk * 4 + kk); SLOTW[slot] = wv[kk]; asl[tl * 4 + kk] = slot; }
            }
            LDS_WAIT(); asm volatile("" ::: "memory");
            {
                const f32x4* gr = (const f32x4*)args.in[I_GFFN] + lane;
#pragma unroll 1
                for (int q = 0; q < 4; ++q) { const int tl = wave * 4 + q; const size_t tk = (size_t)tt * 32 + tl; const float rstd = rsd[tl];
                    const u32x2* xq = (const u32x2*)(X1 + tk * DM) + lane; unsigned w8[8];
#pragma unroll
                    for (int j = 0; j < 8; ++j) { const u32x2 xw = xq[64 * j]; const f32x4 v = {bf_lo(xw.x), bf_hi(xw.x), bf_lo(xw.y), bf_hi(xw.y)}, g = gr[64 * j]; w8[j] = pack4_fp8(v[0] * rstd * g[0], v[1] * rstd * g[1], v[2] * rstd * g[2], v[3] * rstd * g[3]); }
#pragma unroll
                    for (int kk = 0; kk < 4; ++kk) { unsigned* o4 = (unsigned*)(XG + (size_t)asl[tl * 4 + kk] * DM) + lane;
#pragma unroll
                        for (int j = 0; j < 8; ++j) o4[64 * j] = w8[j]; } }
            }
            __syncthreads();
        }
    }
    SEAM(5);

    if (IN(6)) { LANE_CONSTS();
        LAS int* tab = (LAS int*)(lds + TAB_OFF);
        const int nrb = moe_tables(ctl, tab, tid);
        EpiSwiglu E; E.bgu = (const float*)args.in[I_BGU]; E.act = ACT;
        SchedMoE S; S.A = (const char*)XG; S.B = (const char*)WguT; S.rb2e = tab; S.nrb = nrb; S.NPN = 16; S.G = G; S.c = bx; S.nt = 16; S.apan = (size_t)256 * 2048; S.bexp = (size_t)4096 * 2048; S.bpn = (size_t)128 * 2048;
        pg8::gemm_phase<EpiSwiglu, SchedMoE, true>(lds + RING_OFF, 1024, 1024, (size_t)2048 * 2048, S, E);
    }
    SEAM(6);

    if (IN(7)) { LANE_CONSTS();
        LAS int* tab = (LAS int*)(lds + TAB_OFF);
        const int nrb = moe_tables(ctl, tab, tid);
        EpiDown E; E.bd = (const float*)args.in[I_BD]; E.slot_asg = SLOTA; E.slot_w = SLOTW; E.ybuf = YBUF;
        SchedMoE S; S.A = (const char*)ACT; S.B = (const char*)WdT; S.rb2e = tab; S.nrb = nrb; S.NPN = 8; S.G = G; S.c = bx; S.nt = 16; S.apan = (size_t)256 * 2048; S.bexp = (size_t)2048 * 2048; S.bpn = (size_t)256 * 2048;
        pg8::gemm_phase<EpiDown, SchedMoE, true>(lds + RING_OFF, 1024, 1024, (size_t)128 * 2048, S, E);
    }
    SEAM(7);

    if (IN(8)) { LANE_CONSTS();
        for (size_t i = (size_t)bx * NTHR + tid; i < (size_t)T * 256; i += (size_t)G * NTHR) {
            const size_t t = i >> 8; const int c8 = (int)(i & 255) * 8;
            const u32x4 xw = *(const u32x4*)(X1 + t * DM + c8); f32x4 a0 = {bf_lo(xw.x), bf_hi(xw.x), bf_lo(xw.y), bf_hi(xw.y)}, a1 = {bf_lo(xw.z), bf_hi(xw.z), bf_lo(xw.w), bf_hi(xw.w)};
#pragma unroll
            for (int k = 0; k < 4; ++k)
            { const u32x4 y = *(const u32x4*)(YBUF + (t * 4 + k) * DM + c8);
                a0[0] += bf_lo(y.x); a0[1] += bf_hi(y.x); a0[2] += bf_lo(y.y); a0[3] += bf_hi(y.y); a1[0] += bf_lo(y.z); a1[1] += bf_hi(y.z); a1[2] += bf_lo(y.w); a1[3] += bf_hi(y.w); }
            *(f32x4*)(args.out + t * DM + c8) = a0; *(f32x4*)(args.out + t * DM + c8 + 4) = a1;
        }
    }
#undef IN
#undef SEAM
}

#ifndef MK_N_LAUNCHES
#define MK_N_LAUNCHES 1
#endif
extern "C" void kernel_launch(void* const* d_in, const int* in_sizes, int n_in, void* d_out, int out_size, void* d_ws, size_t ws_size, hipStream_t stream) {
    static int grid = 0;
    if (grid == 0) {
        if (n_in != N_IN || out_size != T * DM || ws_size < WS_END) { fprintf(stderr, "kernel_launch: unexpected shapes (n_in %d, out %d, ws %zu)\n", n_in, out_size, ws_size); grid = -1; return; }
        int dev = 0, cus = 0, per_cu = 0;
        if (hipGetDevice(&dev) != hipSuccess || hipDeviceGetAttribute(&cus, hipDeviceAttributeMultiprocessorCount, dev) != hipSuccess) { grid = -1; return; }
        if (hipFuncSetAttribute((const void*)fwd, hipFuncAttributeMaxDynamicSharedMemorySize, LDS_BYTES) != hipSuccess) { fprintf(stderr, "kernel_launch: hipFuncSetAttribute failed\n"); grid = -1; return; }
        if (hipOccupancyMaxActiveBlocksPerMultiprocessor(&per_cu, (const void*)fwd, NTHR, LDS_BYTES) != hipSuccess || per_cu < 1) { fprintf(stderr, "kernel_launch: occupancy query reports %d\n", per_cu); }
        (void)hipGetLastError();
        grid = cus;
    }
    if (grid < 0) return;
    if (hipMemsetAsync((char*)d_ws + WS_CTL, 0, CTL_ZERO_BYTES, stream) != hipSuccess) return;
    Args a{};
    for (int i = 0; i < N_IN; ++i) a.in[i] = d_in[i];
    a.out = (float*)d_out; a.ws = (unsigned char*)d_ws; a.pad = 0;
#if MK_N_LAUNCHES == 1
    a.ph_lo = 0; a.ph_hi = N_PHASES; a.use_bar = 1;
    hipLaunchKernelGGL(fwd, dim3(grid), dim3(NTHR), LDS_BYTES, stream, a);
#else
    for (int p = 0; p < N_PHASES; ++p) { a.ph_lo = p; a.ph_hi = p + 1; a.use_bar = 0; hipLaunchKernelGGL(fwd, dim3(grid), dim3(NTHR), LDS_BYTES, stream, a); }
#endif
}
```
